# Optimizing an MI355X kernel written in HIP

```python
import jax, jax.numpy as jnp
from jax import lax
import numpy as np

D_MODEL = 1024
BATCH = 4
SEQ = 4096
DEPTH = 2

CTX_LEN = 256
GRID_W = 64
EPS = 1e-6
MIX_WIDTH = 2 * D_MODEL
SSD_WIDTH = MIX_WIDTH // 2
SSD_HEAD_DIM = 64
SSD_HEADS = SSD_WIDTH // SSD_HEAD_DIM
SSD_GROUPS = 2
SSD_HPG = SSD_HEADS // SSD_GROUPS
SSD_STATE = 128
SSD_CHUNK = 128
SSD_CONV = 3
SSD_XBC = SSD_WIDTH + 2 * SSD_GROUPS * SSD_STATE
SSD_COLS = SSD_WIDTH + SSD_XBC + 2 * SSD_HEADS
SC_WIDTH = MIX_WIDTH // 4
SC_CONV = 3
SC_COLS = 4 * SC_WIDTH
ATTN_HEAD_DIM = 64
ATTN_WIDTH = MIX_WIDTH // 4
ATTN_HEADS = ATTN_WIDTH // ATTN_HEAD_DIM
ATTN_KV_HEADS = 2
ATTN_REP = ATTN_HEADS // ATTN_KV_HEADS
ATTN_WINDOW = 128
ATTN_BLOCK = 128
ROPE_BASE = 10000.0
ATTN_COLS = 2 * ATTN_WIDTH + 2 * ATTN_KV_HEADS * ATTN_HEAD_DIM
IN_COLS = SSD_COLS + SC_COLS + ATTN_COLS
NEG_INF = -1e30

kernel_name = "hybrid_ssd_shortconv_swa_dit_block"


def rmsnorm(t, w):
    t32 = t.astype(jnp.float32)
    t32 = t32 * lax.rsqrt(jnp.mean(t32 * t32, axis=-1, keepdims=True) + EPS)
    return (t32 * w.astype(jnp.float32)).astype(t.dtype)


def dwconv(u, w):
    k, ch = w.shape
    return lax.conv_general_dilated(
        u, w[:, None, :].astype(u.dtype), window_strides=(1,), padding=[(k // 2, k // 2)],
        dimension_numbers=("NWC", "WIO", "NWC"), feature_group_count=ch)


def segsum(a):
    t = a.shape[-1]
    cs = jnp.cumsum(a, axis=-1)
    diff = cs[..., :, None] - cs[..., None, :]
    mask = jnp.tril(jnp.ones((t, t), dtype=bool))
    return jnp.where(mask, diff, -jnp.inf)


def ssd_scan(xs, da, bm, cm, init, with_y):
    b, l, g, r, p = xs.shape
    n = bm.shape[-1]
    nc = l // SSD_CHUNK
    xs = xs.reshape(b, nc, SSD_CHUNK, g, r, p)
    bm = bm.reshape(b, nc, SSD_CHUNK, g, n)
    cm = cm.reshape(b, nc, SSD_CHUNK, g, n)
    da = da.reshape(b, nc, SSD_CHUNK, g, r).transpose(0, 3, 4, 1, 2)
    a_cum = jnp.cumsum(da, axis=-1)
    decay_states = jnp.exp(a_cum[..., -1:] - a_cum)
    states = jnp.einsum("bclgn,bgrcl,bclgrp->bcgrpn", bm, decay_states, xs)
    chunk_tot = jnp.pad(a_cum[..., -1], ((0, 0), (0, 0), (0, 0), (1, 0)))
    decay_chunk = jnp.exp(segsum(chunk_tot))
    states = jnp.concatenate([init[:, None], states], axis=1)
    new_states = jnp.einsum("bgrzc,bcgrpn->bzgrpn", decay_chunk, states)
    final = new_states[:, -1]
    if not with_y:
        return None, final
    states = new_states[:, :-1]
    lmat = jnp.exp(segsum(da))
    cb = jnp.einsum("bclgn,bcsgn->bgcls", cm, bm)
    y_diag = jnp.einsum("bgcls,bgrcls,bcsgrp->bclgrp", cb, lmat, xs)
    y_off = jnp.einsum("bclgn,bcgrpn,bgrcl->bclgrp", cm, states, jnp.exp(a_cum))
    return (y_diag + y_off).reshape(b, l, g, r, p), final


def _flip(t, direction):
    return t[:, ::-1] if direction == 1 else t


def ssd_branch(pc, pl, conv_w, conv_b, dt_bias, a_log, d_skip, norm_w, with_ctx):
    def prep(p):
        b, l, _ = p.shape
        z, xbc, dt = jnp.split(p, [SSD_WIDTH, SSD_WIDTH + SSD_XBC], axis=-1)
        xbc = jax.nn.silu(dwconv(xbc, conv_w) + conv_b.astype(xbc.dtype))
        xs, bm, cm = jnp.split(xbc, [SSD_WIDTH, SSD_WIDTH + SSD_GROUPS * SSD_STATE], axis=-1)
        return (z, xs.reshape(b, l, SSD_GROUPS, SSD_HPG, SSD_HEAD_DIM),
                bm.reshape(b, l, SSD_GROUPS, SSD_STATE), cm.reshape(b, l, SSD_GROUPS, SSD_STATE), dt)

    zc, xc, bc, cc, dtc = prep(pc)
    zl, xl, bl, cl, dtl = prep(pl)
    b = pl.shape[0]
    dsk = d_skip.astype(jnp.float32).reshape(SSD_GROUPS, SSD_HPG, 1)
    y_l = xl.astype(jnp.float32) * dsk
    y_c = xc.astype(jnp.float32) * dsk
    for d in range(2):
        a = -jnp.exp(a_log[d].astype(jnp.float32)).reshape(SSD_GROUPS, SSD_HPG)

        def disc(dt_raw):
            dt = jax.nn.softplus(dt_raw[..., d * SSD_HEADS:(d + 1) * SSD_HEADS].astype(jnp.float32)
                                 + dt_bias[d].astype(jnp.float32))
            return dt.reshape(dt.shape[0], dt.shape[1], SSD_GROUPS, SSD_HPG)

        dt_c, dt_l = disc(dtc), disc(dtl)
        init = jnp.zeros((b, SSD_GROUPS, SSD_HPG, SSD_HEAD_DIM, SSD_STATE), jnp.float32)
        yc_d, s_ctx = ssd_scan(_flip(xc * dt_c[..., None], d), _flip(dt_c * a, d),
                               _flip(bc, d), _flip(cc, d), init, with_ctx)
        yl_d, _ = ssd_scan(_flip(xl * dt_l[..., None], d), _flip(dt_l * a, d),
                           _flip(bl, d), _flip(cl, d), s_ctx, True)
        y_l = y_l + _flip(yl_d, d)
        if with_ctx:
            y_c = y_c + _flip(yc_d, d)

    def gated_norm(y, z):
        bb, l = y.shape[:2]
        g = y.reshape(bb, l, SSD_GROUPS, -1) * jax.nn.silu(z.astype(jnp.float32)).reshape(bb, l, SSD_GROUPS, -1)
        g = g * lax.rsqrt(jnp.mean(g * g, axis=-1, keepdims=True) + EPS)
        return (g.reshape(bb, l, SSD_WIDTH) * norm_w.astype(jnp.float32)).astype(z.dtype)

    out_c = gated_norm(y_c, zc) if with_ctx else None
    return out_c, gated_norm(y_l, zl)


def shortconv_branch(pc, pl, conv_w, with_ctx):
    def run(p):
        v, cg, bg, z = jnp.split(p, 4, axis=-1)
        return bg * dwconv(cg * v, conv_w) * jax.nn.silu(z)
    return (run(pc) if with_ctx else None), run(pl)


def rope_tables(n_lat):
    n_rows = n_lat // GRID_W
    rows = jnp.repeat(jnp.arange(n_rows, dtype=jnp.int32), GRID_W).astype(jnp.float32)
    cols = jnp.tile(jnp.arange(GRID_W, dtype=jnp.int32), n_rows).astype(jnp.float32)
    axis_dim = ATTN_HEAD_DIM // 2
    inv_freq = ROPE_BASE ** (-jnp.arange(0, axis_dim, 2, dtype=jnp.float32) / axis_dim)
    ang = jnp.concatenate([rows[:, None] * inv_freq, cols[:, None] * inv_freq], axis=-1)
    return jnp.cos(ang), jnp.sin(ang)


def apply_rope(t, cos, sin):
    b, l, h, d = t.shape
    q = d // 4
    t = t.reshape(b, l, h, 2, 2, q)
    x1, x2 = t[..., 0, :], t[..., 1, :]
    c = cos.reshape(l, 1, 2, q).astype(t.dtype)
    s = sin.reshape(l, 1, 2, q).astype(t.dtype)
    return jnp.stack([x1 * c - x2 * s, x1 * s + x2 * c], axis=-2).reshape(b, l, h, d)


def attn_branch(pc, pl, sink, cos, sin, with_ctx):
    scale = ATTN_HEAD_DIM ** -0.5

    def split(p):
        b, l, _ = p.shape
        q, k, v, z = jnp.split(p, [ATTN_WIDTH, ATTN_WIDTH + ATTN_KV_HEADS * ATTN_HEAD_DIM,
                                   ATTN_WIDTH + 2 * ATTN_KV_HEADS * ATTN_HEAD_DIM], axis=-1)
        return (q.reshape(b, l, ATTN_HEADS, ATTN_HEAD_DIM), k.reshape(b, l, ATTN_KV_HEADS, ATTN_HEAD_DIM),
                v.reshape(b, l, ATTN_KV_HEADS, ATTN_HEAD_DIM), z)

    qc, kc, vc, zc = split(pc)
    ql, kl, vl, zl = split(pl)
    ql, kl = apply_rope(ql, cos, sin), apply_rope(kl, cos, sin)
    b, n_lat = pl.shape[:2]
    nb = n_lat // ATTN_BLOCK
    sink32 = sink.astype(jnp.float32).reshape(ATTN_KV_HEADS, ATTN_REP)

    qb = ql.reshape(b, nb, ATTN_BLOCK, ATTN_KV_HEADS, ATTN_REP, ATTN_HEAD_DIM)

    def windows(t):
        tp = jnp.pad(t.reshape(b, nb, ATTN_BLOCK, ATTN_KV_HEADS, ATTN_HEAD_DIM),
                     ((0, 0), (1, 1), (0, 0), (0, 0), (0, 0)))
        return jnp.concatenate([tp[:, :-2], tp[:, 1:-1], tp[:, 2:]], axis=2)

    kw, vw = windows(kl), windows(vl)
    s_band = jnp.einsum("bnqkrd,bnskd->bnkrqs", qb, kw).astype(jnp.float32) * scale
    qpos = jnp.arange(nb)[:, None] * ATTN_BLOCK + jnp.arange(ATTN_BLOCK)[None, :]
    kpos = (jnp.arange(nb)[:, None] - 1) * ATTN_BLOCK + jnp.arange(3 * ATTN_BLOCK)[None, :]
    valid = ((jnp.abs(qpos[:, :, None] - kpos[:, None, :]) <= ATTN_WINDOW)
             & (kpos[:, None, :] >= 0) & (kpos[:, None, :] < n_lat))
    s_band = jnp.where(valid[None, :, None, None], s_band, NEG_INF)
    s_ctx = jnp.einsum("bnqkrd,bskd->bnkrqs", qb, kc).astype(jnp.float32) * scale
    s_sink = jnp.broadcast_to(sink32[None, None, :, :, None, None], s_band.shape[:-1] + (1,))
    probs = jax.nn.softmax(jnp.concatenate([s_band, s_ctx, s_sink], axis=-1), axis=-1)
    p_band = probs[..., :3 * ATTN_BLOCK].astype(vl.dtype)
    p_ctx = probs[..., 3 * ATTN_BLOCK:3 * ATTN_BLOCK + kc.shape[1]].astype(vl.dtype)
    o = (jnp.einsum("bnkrqs,bnskd->bnqkrd", p_band, vw)
         + jnp.einsum("bnkrqs,bskd->bnqkrd", p_ctx, vc))
    out_l = o.reshape(b, n_lat, ATTN_WIDTH) * jax.nn.silu(zl)

    out_c = None
    if with_ctx:
        n_ctx = pc.shape[1]
        qcg = qc.reshape(b, n_ctx, ATTN_KV_HEADS, ATTN_REP, ATTN_HEAD_DIM)
        sc = jnp.einsum("bqkrd,bskd->bkrqs", qcg, kc).astype(jnp.float32) * scale
        ssk = jnp.broadcast_to(sink32[None, :, :, None, None], sc.shape[:-1] + (1,))
        pcp = jax.nn.softmax(jnp.concatenate([sc, ssk], axis=-1), axis=-1)[..., :n_ctx].astype(vc.dtype)
        oc = jnp.einsum("bkrqs,bskd->bqkrd", pcp, vc)
        out_c = oc.reshape(b, n_ctx, ATTN_WIDTH) * jax.nn.silu(zc)
    return out_c, out_l


def hybrid_layer(x, ctx, silu_c, silu_cc, cos, sin, norm_w, w_mod, b_mod, w_in, ssd_conv_w, ssd_conv_b,
                 ssd_dt_bias, ssd_a_log, ssd_d, ssd_norm_w, sc_conv_w, attn_sink, w_out, with_ctx):
    shift, scale, gate = jnp.split(silu_c @ w_mod + b_mod, 3, axis=-1)
    shift_c, scale_c, gate_c = jnp.split(silu_cc @ w_mod + b_mod, 3, axis=-1)
    h = rmsnorm(x, norm_w) * (1 + scale[:, None]) + shift[:, None]
    hc = rmsnorm(ctx, norm_w) * (1 + scale_c) + shift_c
    pl, pc = h @ w_in, hc @ w_in
    ssd_l, sc_l, at_l = jnp.split(pl, [SSD_COLS, SSD_COLS + SC_COLS], axis=-1)
    ssd_c, sc_c, at_c = jnp.split(pc, [SSD_COLS, SSD_COLS + SC_COLS], axis=-1)
    ys_c, ys_l = ssd_branch(ssd_c, ssd_l, ssd_conv_w, ssd_conv_b, ssd_dt_bias, ssd_a_log, ssd_d,
                            ssd_norm_w, with_ctx)
    yc_c, yc_l = shortconv_branch(sc_c, sc_l, sc_conv_w, with_ctx)
    ya_c, ya_l = attn_branch(at_c, at_l, attn_sink, cos, sin, with_ctx)
    x = x + gate[:, None] * (jnp.concatenate([ys_l, yc_l, ya_l], axis=-1) @ w_out)
    if with_ctx:
        ctx = ctx + gate_c * (jnp.concatenate([ys_c, yc_c, ya_c], axis=-1) @ w_out)
    return x, ctx


def setup_inputs(seed: int = 0) -> dict:
    key = jax.random.key(seed)
    ks = jax.random.split(key, 20)
    nrm = jax.random.normal
    f32 = jnp.float32
    dt0 = jnp.exp(jax.random.uniform(ks[9], (DEPTH, 2, SSD_HEADS), f32, np.log(1e-3), np.log(1e-1)))
    return {
        "x": nrm(ks[0], (BATCH, SEQ, D_MODEL), f32),
        "c": nrm(ks[1], (BATCH, D_MODEL), f32),
        "ctx": nrm(ks[2], (BATCH, CTX_LEN, D_MODEL), f32),
        "c_ctx": nrm(ks[3], (D_MODEL,), f32),
        "norm_w": 1.0 + 0.02 * nrm(ks[4], (DEPTH, D_MODEL), f32),
        "w_mod": 0.5 * D_MODEL ** -0.5 * nrm(ks[5], (DEPTH, D_MODEL, 3 * D_MODEL), f32),
        "b_mod": 0.02 * nrm(ks[6], (DEPTH, 3 * D_MODEL), f32),
        "w_in": D_MODEL ** -0.5 * nrm(ks[7], (DEPTH, D_MODEL, IN_COLS), f32),
        "ssd_conv_w": SSD_CONV ** -0.5 * nrm(ks[8], (DEPTH, SSD_CONV, SSD_XBC), f32),
        "ssd_conv_b": 0.02 * nrm(ks[10], (DEPTH, SSD_XBC), f32),
        "ssd_dt_bias": dt0 + jnp.log(-jnp.expm1(-dt0)),
        "ssd_a_log": jnp.log(jax.random.uniform(ks[11], (DEPTH, 2, SSD_HEADS), f32, 1.0, 16.0)),
        "ssd_d": 1.0 + 0.02 * nrm(ks[12], (DEPTH, SSD_HEADS), f32),
        "ssd_norm_w": 1.0 + 0.02 * nrm(ks[13], (DEPTH, SSD_WIDTH), f32),
        "sc_conv_w": SC_CONV ** -0.5 * nrm(ks[14], (DEPTH, SC_CONV, SC_WIDTH), f32),
        "attn_sink": 0.5 * nrm(ks[15], (DEPTH, ATTN_HEADS), f32),
        "w_out": MIX_WIDTH ** -0.5 * nrm(ks[16], (DEPTH, MIX_WIDTH, D_MODEL), f32),
        "final_norm_w": 1.0 + 0.02 * nrm(ks[17], (D_MODEL,), f32),
    }


def reference(x, c, ctx, c_ctx, norm_w, w_mod, b_mod, w_in, ssd_conv_w, ssd_conv_b, ssd_dt_bias,
              ssd_a_log, ssd_d, ssd_norm_w, sc_conv_w, attn_sink, w_out, final_norm_w):
    cos, sin = rope_tables(x.shape[1])
    silu_c, silu_cc = jax.nn.silu(c), jax.nn.silu(c_ctx)
    for l in range(DEPTH):
        x, ctx = hybrid_layer(x, ctx, silu_c, silu_cc, cos, sin, norm_w[l], w_mod[l], b_mod[l], w_in[l],
                              ssd_conv_w[l], ssd_conv_b[l], ssd_dt_bias[l], ssd_a_log[l], ssd_d[l],
                              ssd_norm_w[l], sc_conv_w[l], attn_sink[l], w_out[l],
                              with_ctx=(l < DEPTH - 1))
    return rmsnorm(x, final_norm_w)
```

```cpp
#include <hip/hip_runtime.h>
#include <hip/hip_cooperative_groups.h>
#include <cstdio>
#include <type_traits>
namespace cg = cooperative_groups;

typedef unsigned short bf16_t;
typedef __attribute__((ext_vector_type(8))) short bf16x8;
typedef __attribute__((ext_vector_type(4))) short bf16x4;
typedef __attribute__((ext_vector_type(4))) float f32x4;
typedef __attribute__((ext_vector_type(16))) float f32x16;

constexpr int D = 1024, SEQ = 4096, CTXL = 256;
constexpr int NB = 2;
constexpr int NPASS = 2;
constexpr int NTL = NB * SEQ;
constexpr int NTC = NB * CTXL;
constexpr int NT = NTL + NTC;
constexpr int NCH = NT / 128;
constexpr int NWIN = 6016;
constexpr float EPS = 1e-6f;

constexpr int ST_NORM = 0, ST_GIN = 1, ST_PREP = 2, ST_MIX = 3, ST_S2 = 4, ST_S3 = 5, ST_GOUT = 6;
constexpr int NSTEP = 1 + NPASS * 2 * 7 + 1;

struct Params {
  const float *x, *c, *ctx, *c_ctx, *norm_w, *w_mod, *b_mod, *w_in, *ssd_conv_w, *ssd_conv_b, *ssd_dt_bias,
      *ssd_a_log, *ssd_d, *ssd_norm_w, *sc_conv_w, *attn_sink, *w_out, *final_norm_w;
  float* out;
  bf16_t *WinT, *WoutT, *H, *PXBC, *PSC, *PZ, *PATT, *XT, *BR, *CR, *BT, *QR, *KR, *VT, *Y, *SIN;
  float *MOD, *CTX1, *DTRAW, *CUMT, *VV, *EC, *WW, *SSQ, *LST, *ROPE, *PART;
  unsigned* bar;
};

__device__ __forceinline__ int opq_tid() { int t = threadIdx.x; asm volatile("" : "+v"(t)); return t; }
__device__ __forceinline__ int opq_bid() { int b = blockIdx.x; asm volatile("" : "+s"(b)); return b; }
typedef __attribute__((ext_vector_type(2))) __bf16 bfv2;
typedef __attribute__((ext_vector_type(2))) float f32x2;
typedef __attribute__((ext_vector_type(4))) unsigned u32x4;
__device__ __forceinline__ unsigned pk2(float a, float b) {
  f32x2 v = {a, b};
  bfv2 r = __builtin_convertvector(v, bfv2);
  return *(unsigned*)&r;
}
__device__ __forceinline__ bf16_t f2bf(float f) { return (bf16_t)(pk2(f, 0.f) & 0xffffu); }
__device__ __forceinline__ bf16x8 pack8(f32x4 a, f32x4 b) {
  u32x4 u = {pk2(a[0], a[1]), pk2(a[2], a[3]), pk2(b[0], b[1]), pk2(b[2], b[3])};
  return *(bf16x8*)&u;
}
__device__ __forceinline__ float bf2f(bf16_t h) { return __uint_as_float(((unsigned)h) << 16); }
__device__ __forceinline__ float silu_f(float v) { return v * __builtin_amdgcn_rcpf(1.f + __expf(-v)); }
__device__ __forceinline__ float wave_sum(float v) {
#pragma unroll
  for (int o = 32; o > 0; o >>= 1) v += __shfl_xor(v, o);
  return v;
}

#define XB_TMO      128
#define XB_XCNT(j)  (256  + 64 * (j))
#define XB_XSUB(j)  (1280 + 64 * (j))
#define XB_XGEN(j)  (2304 + 64 * (j))
#define XB_TOP      3328
#define XB_TOPGEN   3392
#define XCD_BAR_WORDS 3456
#define XB_SPIN_CAP (1u << 18)
#define LAS __attribute__((address_space(3)))

__device__ __forceinline__ unsigned xb_ld(unsigned* p)              { return __hip_atomic_load(p, __ATOMIC_RELAXED, __HIP_MEMORY_SCOPE_AGENT); }
__device__ __forceinline__ unsigned xb_add(unsigned* p, unsigned v) { return __hip_atomic_fetch_add(p, v, __ATOMIC_RELAXED, __HIP_MEMORY_SCOPE_AGENT); }
__device__ __forceinline__ unsigned xb_xcc_id() { return (unsigned)__builtin_amdgcn_s_getreg((3 << 11) | 20) & 0xFu; }
#define XB_SPIN(cond, bar) do { unsigned _sp = 0; while (cond) { __builtin_amdgcn_s_sleep(1); \
    if ((++_sp & 255u) == 0u) { if (xb_ld(&(bar)[XB_TMO])) break; if (_sp > XB_SPIN_CAP) { atomicAdd(&(bar)[XB_TMO], 1u); break; } } } } while (0)

struct XcdBarrier {
    unsigned* bar; unsigned x;
    volatile LAS unsigned* st;
};

__device__ __forceinline__ XcdBarrier xcd_barrier_post(unsigned* bar, volatile LAS unsigned* st) {
    XcdBarrier b; b.bar = bar; b.x = xb_xcc_id(); b.st = st;
    if (threadIdx.x == 0) (void)xb_add(&bar[XB_XCNT(b.x)], 1u);
    return b;
}
__device__ __forceinline__ void xcd_barrier_complete(unsigned* bar, unsigned x, unsigned& nloc, unsigned& nx) {
    const unsigned G = gridDim.x * gridDim.y * gridDim.z;
    unsigned sum, cnt, mine, sp = 0u;
    for (;;) {
        sum = 0u; cnt = 0u; mine = 0u;
#pragma unroll
        for (unsigned j = 0; j < 16; ++j) { const unsigned c = xb_ld(&bar[XB_XCNT(j)]); sum += c; cnt += (c > 0u) ? 1u : 0u; mine = (j == x) ? c : mine; }
        if (sum == G) break;
        __builtin_amdgcn_s_sleep(1);
        if ((++sp & 255u) == 0u) { if (xb_ld(&bar[XB_TMO])) break; if (sp > XB_SPIN_CAP) { atomicAdd(&bar[XB_TMO], 1u); break; } }
    }
    nloc = mine > 0u ? mine : 1u; nx = cnt > 0u ? cnt : 1u;
}

__device__ __forceinline__ void xcd_barrier(const XcdBarrier& b) {
    asm volatile("s_waitcnt vmcnt(0)" ::: "memory");
    __syncthreads();
    if (threadIdx.x == 0) {
        unsigned* bar = b.bar;
        __builtin_amdgcn_s_waitcnt(0);
        unsigned nloc = b.st[0], nx = b.st[1];
        if (nloc == 0u) { xcd_barrier_complete(bar, b.x, nloc, nx); b.st[0] = nloc; b.st[1] = nx; }
        const unsigned old = xb_add(&bar[XB_XSUB(b.x)], 1u);
        const unsigned gen = old / nloc;
        if (old + 1u == (gen + 1u) * nloc) {
            __builtin_amdgcn_fence(__ATOMIC_RELEASE, "agent");
            asm volatile("s_waitcnt vmcnt(0)" ::: "memory");
            const unsigned og = xb_add(&bar[XB_TOP], 1u);
            const unsigned tg = og / nx;
            if (og + 1u == (tg + 1u) * nx) xb_add(&bar[XB_TOPGEN], 1u);
            else XB_SPIN(xb_ld(&bar[XB_TOPGEN]) == tg, bar);
            __builtin_amdgcn_fence(__ATOMIC_ACQUIRE, "agent");
            xb_add(&bar[XB_XGEN(b.x)], 1u);
            asm volatile("s_waitcnt vmcnt(0)" ::: "memory");
        } else {
            XB_SPIN(xb_ld(&bar[XB_XGEN(b.x)]) == gen, bar);
            __builtin_amdgcn_fence(__ATOMIC_ACQUIRE, "agent");
            asm volatile("s_waitcnt vmcnt(0)" ::: "memory");
        }
    }
    __syncthreads();
}


__device__ void phase_weights(const Params& p, float* smem) {
  const int tid = opq_tid();
  const int NW1 = 2 * 94 * 16, NW2 = 2 * 16 * 32, NM = 192;
  for (int it = opq_bid(); it < NW1 + NW2 + NM; it += gridDim.x) {
    if (it < NW1) {
      int l = it / (94 * 16), r = it % (94 * 16), nt = r / 16, kt = r % 16;
      for (int e = tid; e < 4096; e += 256) {
        int kk = e >> 6, nn = e & 63;
        int n = nt * 64 + nn;
        int oc = (n < 2560) ? n : (n < 5888 ? n + 32 : (n < 5920 ? n - 5888 + 2560 : -1));
        float v = 0.f;
        if (oc >= 0) v = p.w_in[((size_t)l * 1024 + kt * 64 + kk) * 5920 + oc];
        smem[kk * 65 + nn] = v;
      }
      __syncthreads();
      for (int e = tid; e < 4096; e += 256) {
        int nn = e >> 6, kk = e & 63;
        p.WinT[((size_t)l * NWIN + nt * 64 + nn) * 1024 + kt * 64 + kk] = f2bf(smem[kk * 65 + nn]);
      }
      __syncthreads();
    } else if (it < NW1 + NW2) {
      int i2 = it - NW1;
      int l = i2 / 512, r = i2 % 512, nt = r / 32, kt = r % 32;
      for (int e = tid; e < 4096; e += 256) {
        int kk = e >> 6, nn = e & 63;
        int k = kt * 64 + kk;
        float v = p.w_out[((size_t)l * 2048 + k) * 1024 + nt * 64 + nn];
        if (k < 1024) v *= p.ssd_norm_w[l * 1024 + k];
        smem[kk * 65 + nn] = v;
      }
      __syncthreads();
      for (int e = tid; e < 4096; e += 256) {
        int nn = e >> 6, kk = e & 63;
        p.WoutT[((size_t)l * 1024 + nt * 64 + nn) * 2048 + kt * 64 + kk] = f2bf(smem[kk * 65 + nn]);
      }
      __syncthreads();
    } else {
      int i3 = it - NW1 - NW2;
      int l = i3 / 96, jb = i3 % 96;
      float* sc = smem;
      float* part = smem + 5120;
      for (int e = tid; e < 5120; e += 256) {
        int r = e >> 10, k = e & 1023;
        float v = (r < 4) ? p.c[r * 1024 + k] : p.c_ctx[k];
        sc[e] = silu_f(v);
      }
      __syncthreads();
      int col = tid & 31, kg = tid >> 5;
      float a0 = 0, a1 = 0, a2 = 0, a3 = 0, a4 = 0;
      const float* wp = p.w_mod + ((size_t)l * 1024 + kg * 128) * 3072 + jb * 32 + col;
      for (int k0 = 0; k0 < 128; k0 += 16) {
        float wv[16];
#pragma unroll
        for (int j = 0; j < 16; ++j) wv[j] = wp[(size_t)(k0 + j) * 3072];
#pragma unroll
        for (int j = 0; j < 16; ++j) {
          int k = kg * 128 + k0 + j;
          a0 += sc[k] * wv[j]; a1 += sc[1024 + k] * wv[j]; a2 += sc[2048 + k] * wv[j]; a3 += sc[3072 + k] * wv[j]; a4 += sc[4096 + k] * wv[j];
        }
      }
      part[(kg * 5 + 0) * 32 + col] = a0; part[(kg * 5 + 1) * 32 + col] = a1; part[(kg * 5 + 2) * 32 + col] = a2;
      part[(kg * 5 + 3) * 32 + col] = a3; part[(kg * 5 + 4) * 32 + col] = a4;
      __syncthreads();
      if (tid < 160) {
        int r = tid >> 5, cc = tid & 31;
        float s = 0.f;
#pragma unroll
        for (int g8 = 0; g8 < 8; ++g8) s += part[(g8 * 5 + r) * 32 + cc];
        p.MOD[((size_t)l * 5 + r) * 3072 + jb * 32 + cc] = s + p.b_mod[l * 3072 + jb * 32 + cc];
      }
      if (i3 == 0) {
        for (int e = tid; e < 1024; e += 256) {
          int pos = e >> 4, i = e & 15;
          float inv = powf(10000.f, -(float)i * (1.f / 16.f));
          float ang = (float)pos * inv;
          p.ROPE[2 * e] = cosf(ang); p.ROPE[2 * e + 1] = sinf(ang);
        }
      }
      __syncthreads();
    }
  }
}

__device__ void phase_norm(const Params& p, int layer, int pass) {
  const int lane = opq_tid() & 63;
  const int gw = opq_bid() * 4 + (opq_tid() >> 6), nw = gridDim.x * 4;
  const int b0 = pass * NB;
  for (int row = gw; row < NT; row += nw) {
    const float* src; int mrow;
    if (row < NTL) { src = (layer == 0 ? p.x : p.out) + ((size_t)b0 * SEQ + row) * D; mrow = b0 + row / SEQ; }
    else { src = (layer == 0 ? p.ctx : p.CTX1) + ((size_t)b0 * CTXL + (row - NTL)) * D; mrow = 4; }
    const float* mod = p.MOD + ((size_t)layer * 5 + mrow) * 3072;
    float4 v[4]; float ss = 0.f;
    const bool from_parts = (layer == 1 && row >= NTL);
    if (from_parts) src = p.ctx + ((size_t)b0 * CTXL + (row - NTL)) * D;
#pragma unroll
    for (int i = 0; i < 4; ++i) {
      v[i] = *(const float4*)(src + (i * 64 + lane) * 4);
      if (from_parts) {
        int k = (i * 64 + lane) * 4;
        float4 a = {0.f, 0.f, 0.f, 0.f};
#pragma unroll
        for (int ks = 0; ks < 8; ++ks) {
          float4 q = *(const float4*)(p.PART + ((size_t)ks * NTC + (row - NTL)) * D + k);
          a.x += q.x; a.y += q.y; a.z += q.z; a.w += q.w;
        }
        float4 gt = *(const float4*)(p.MOD + ((size_t)0 * 5 + 4) * 3072 + 2048 + k);
        v[i].x += gt.x * a.x; v[i].y += gt.y * a.y; v[i].z += gt.z * a.z; v[i].w += gt.w * a.w;
      }
      ss += v[i].x * v[i].x + v[i].y * v[i].y + v[i].z * v[i].z + v[i].w * v[i].w;
    }
    ss = wave_sum(ss);
    float rstd = rsqrtf(ss * (1.f / D) + EPS);
#pragma unroll
    for (int i = 0; i < 4; ++i) {
      int k = (i * 64 + lane) * 4;
      float4 nwv = *(const float4*)(p.norm_w + layer * D + k);
      float4 sh = *(const float4*)(mod + k);
      float4 scl = *(const float4*)(mod + 1024 + k);
      bf16x4 o;
      o[0] = (short)f2bf(v[i].x * rstd * nwv.x * (1.f + scl.x) + sh.x);
      o[1] = (short)f2bf(v[i].y * rstd * nwv.y * (1.f + scl.y) + sh.y);
      o[2] = (short)f2bf(v[i].z * rstd * nwv.z * (1.f + scl.z) + sh.z);
      o[3] = (short)f2bf(v[i].w * rstd * nwv.w * (1.f + scl.w) + sh.w);
      *(bf16x4*)(p.H + (size_t)row * D + k) = o;
    }
  }
}

__device__ __forceinline__ void epi_store(const Params& p, int mode, int layer, int pass, int m, int n, float v) {
  if (mode == 0) {
    if (n < 1024) p.PZ[(size_t)m * 1024 + n] = f2bf(v);
    else if (n < 2560) p.PXBC[(size_t)m * 1536 + (n - 1024)] = f2bf(v);
    else if (n < 4608) p.PSC[(size_t)m * 2048 + (n - 2560)] = f2bf(v);
    else if (n < 5888) p.PATT[(size_t)m * 1280 + (n - 4608)] = f2bf(v);
    else if (n < 5920) p.DTRAW[(size_t)m * 32 + (n - 5888)] = v;
  } else {
    const int b0 = pass * NB;
    if (m < NTL) {
      int b = b0 + m / SEQ;
      float g = p.MOD[((size_t)layer * 5 + b) * 3072 + 2048 + n];
      size_t idx = ((size_t)b0 * SEQ + m) * D + n;
      float xo = (layer == 0) ? p.x[idx] : p.out[idx];
      p.out[idx] = xo + g * v;
    } else {
      float g = p.MOD[((size_t)layer * 5 + 4) * 3072 + 2048 + n];
      size_t idx = ((size_t)b0 * CTXL + (m - NTL)) * D + n;
      p.CTX1[idx] = p.ctx[idx] + g * v;
    }
  }
}

__device__ void phase_gemm_naive(const Params& p, int mode, int layer, int pass, float* smem) {
  const int M = (mode == 0) ? NT : (layer == 0 ? NT : NTL);
  const int N = (mode == 0) ? NWIN : 1024;
  const int K = (mode == 0) ? 1024 : 2048;
  const bf16_t* A = (mode == 0) ? p.H : p.Y;
  const bf16_t* Bt = (mode == 0) ? p.WinT + (size_t)layer * NWIN * 1024 : p.WoutT + (size_t)layer * 1024 * 2048;
  const int tm = M / 64, tn = N / 64;
  const int tid = opq_tid(), tx = tid & 15, ty = tid >> 4;
  float* As = smem;
  float* Bs = smem + 16 * 68;
  for (int t = opq_bid(); t < tm * tn; t += gridDim.x) {
    int m0 = (t / tn) * 64, n0 = (t % tn) * 64;
    float acc[4][4];
#pragma unroll
    for (int i = 0; i < 4; ++i)
#pragma unroll
      for (int j = 0; j < 4; ++j) acc[i][j] = 0.f;
    int lr = tid >> 2, kq = (tid & 3) * 4;
    for (int k0 = 0; k0 < K; k0 += 16) {
      bf16x4 av = *(const bf16x4*)(A + (size_t)(m0 + lr) * K + k0 + kq);
      bf16x4 bv = *(const bf16x4*)(Bt + (size_t)(n0 + lr) * K + k0 + kq);
#pragma unroll
      for (int j = 0; j < 4; ++j) {
        As[(kq + j) * 68 + lr] = bf2f((bf16_t)av[j]);
        Bs[(kq + j) * 68 + lr] = bf2f((bf16_t)bv[j]);
      }
      __syncthreads();
#pragma unroll
      for (int kk = 0; kk < 16; ++kk) {
        float4 a4 = *(const float4*)(As + kk * 68 + ty * 4);
        float4 b4 = *(const float4*)(Bs + kk * 68 + tx * 4);
        float a[4] = {a4.x, a4.y, a4.z, a4.w}, b[4] = {b4.x, b4.y, b4.z, b4.w};
#pragma unroll
        for (int i = 0; i < 4; ++i)
#pragma unroll
          for (int j = 0; j < 4; ++j) acc[i][j] += a[i] * b[j];
      }
      __syncthreads();
    }
#pragma unroll
    for (int i = 0; i < 4; ++i)
#pragma unroll
      for (int j = 0; j < 4; ++j) epi_store(p, mode, layer, pass, m0 + ty * 4 + i, n0 + tx * 4 + j, acc[i][j]);
  }
}

__device__ void phase_gemm_mfma(const Params& p, int mode, int layer, int pass, bf16_t* smem) {
  const bool do_split = (mode == 1 && layer == 0);
  const bool ctx_sparse = (mode == 0 && layer == 1);
  const int M = (mode == 0 && !ctx_sparse) ? NT : NTL;
  const int N = (mode == 0) ? NWIN : 1024;
  const int K = (mode == 0) ? 1024 : 2048;
  const bf16_t* A = (mode == 0) ? p.H : p.Y;
  const bf16_t* Bt = (mode == 0) ? p.WinT + (size_t)layer * NWIN * 1024 : p.WoutT + (size_t)layer * 1024 * 2048;
  const int tm = M / 128, tn = N / 128, T_main = tm * tn, T = T_main + (ctx_sparse ? 60 : 0);
  const int tid = opq_tid(), lane = tid & 63, wid = tid >> 6, wm = wid >> 1, wn = wid & 1;
  const int lr = lane & 31, lh = lane >> 5;
  bf16_t* As = smem;
  bf16_t* Bs = smem + 128 * 72;
  float* rsS = (float*)(smem + 2 * 128 * 72);
  const int bid = opq_bid();
  int tstart = 0, tend = T, lb = bid, nbx = gridDim.x;
  if ((gridDim.x & 7) == 0) {
    int xcd = bid & 7; lb = bid >> 3; nbx = gridDim.x >> 3;
    tstart = (int)((long)T * xcd / 8); tend = (int)((long)T * (xcd + 1) / 8);
  }
  const int ng_full = tn / 8, rem = tn % 8, per_group = tm * 8;
  const int nk = K / 64;
  const int sr = tid >> 3, sc = (tid & 7) * 8;
  const int b0 = pass * NB;
  auto tile = [&](const int mi, const int ni, auto split_tag, const int ks) __attribute__((always_inline)) {
    constexpr bool SPLIT = decltype(split_tag)::value;
    const int kt0 = SPLIT ? ks * 4 : 0;
    const int kt1 = SPLIT ? kt0 + 4 : nk;
    const int m0 = mi * 128, n0 = ni * 128;
    f32x16 acc[2][2];
#pragma unroll
    for (int i = 0; i < 2; ++i)
#pragma unroll
      for (int j = 0; j < 2; ++j)
#pragma unroll
        for (int r = 0; r < 16; ++r) acc[i][j][r] = 0.f;
    const bf16_t* ga = A + (size_t)(m0 + sr) * K + sc + kt0 * 64;
    const bf16_t* gb = Bt + (size_t)(n0 + sr) * K + sc + kt0 * 64;
    bf16x8 ra[4], rb[4];
#pragma unroll
    for (int i = 0; i < 4; ++i) { ra[i] = *(const bf16x8*)(ga + (size_t)i * 32 * K); rb[i] = *(const bf16x8*)(gb + (size_t)i * 32 * K); }
    if (mode == 1) {
      int row = m0 + (tid >> 1), grp = tid & 1;
      const float* sp = p.SSQ + (size_t)row * 16 + grp * 8;
      f32x4 s0 = *(const f32x4*)sp, s1 = *(const f32x4*)(sp + 4);
      float ss = s0[0] + s0[1] + s0[2] + s0[3] + s1[0] + s1[1] + s1[2] + s1[3];
      rsS[tid] = rsqrtf(ss * (1.f / 512.f) + EPS);
    }
    if (mode == 1 && !SPLIT) {
      bf16x8 ra2[4], rb2[4];
#pragma unroll
      for (int i = 0; i < 4; ++i) {
        ra2[i] = *(const bf16x8*)(ga + (size_t)i * 32 * K + 64);
        rb2[i] = *(const bf16x8*)(gb + (size_t)i * 32 * K + 64);
      }
      auto mma4 = [&]() __attribute__((always_inline)) {
#pragma unroll
        for (int kk = 0; kk < 4; ++kk) {
          bf16x8 a0 = *(const bf16x8*)(As + (wm * 64 + lr) * 72 + kk * 16 + lh * 8);
          bf16x8 a1 = *(const bf16x8*)(As + (wm * 64 + 32 + lr) * 72 + kk * 16 + lh * 8);
          bf16x8 b0v = *(const bf16x8*)(Bs + (wn * 64 + lr) * 72 + kk * 16 + lh * 8);
          bf16x8 b1v = *(const bf16x8*)(Bs + (wn * 64 + 32 + lr) * 72 + kk * 16 + lh * 8);
          acc[0][0] = __builtin_amdgcn_mfma_f32_32x32x16_bf16(a0, b0v, acc[0][0], 0, 0, 0);
          acc[0][1] = __builtin_amdgcn_mfma_f32_32x32x16_bf16(a0, b1v, acc[0][1], 0, 0, 0);
          acc[1][0] = __builtin_amdgcn_mfma_f32_32x32x16_bf16(a1, b0v, acc[1][0], 0, 0, 0);
          acc[1][1] = __builtin_amdgcn_mfma_f32_32x32x16_bf16(a1, b1v, acc[1][1], 0, 0, 0);
        }
      };
      for (int kt = 0; kt < 32; kt += 2) {
        __syncthreads();
#pragma unroll
        for (int i = 0; i < 4; ++i) {
          *(bf16x8*)(As + (sr + i * 32) * 72 + sc) = ra[i];
          *(bf16x8*)(Bs + (sr + i * 32) * 72 + sc) = rb[i];
        }
        __syncthreads();
        if (kt + 2 < 32) {
#pragma unroll
          for (int i = 0; i < 4; ++i) {
            ra[i] = *(const bf16x8*)(ga + (size_t)i * 32 * K + (kt + 2) * 64);
            rb[i] = *(const bf16x8*)(gb + (size_t)i * 32 * K + (kt + 2) * 64);
          }
        }
        mma4();
        __syncthreads();
#pragma unroll
        for (int i = 0; i < 4; ++i) {
          *(bf16x8*)(As + (sr + i * 32) * 72 + sc) = ra2[i];
          *(bf16x8*)(Bs + (sr + i * 32) * 72 + sc) = rb2[i];
        }
        __syncthreads();
        if (kt + 3 < 32) {
#pragma unroll
          for (int i = 0; i < 4; ++i) {
            ra2[i] = *(const bf16x8*)(ga + (size_t)i * 32 * K + (kt + 3) * 64);
            rb2[i] = *(const bf16x8*)(gb + (size_t)i * 32 * K + (kt + 3) * 64);
          }
        }
        mma4();
        if (kt == 6 || kt == 14) {
#pragma unroll
          for (int i = 0; i < 2; ++i)
#pragma unroll
            for (int r = 0; r < 16; ++r) {
              int lrow = wm * 64 + i * 32 + (r & 3) + 8 * (r >> 2) + 4 * lh;
              float r0 = rsS[lrow * 2], r1 = rsS[lrow * 2 + 1];
              float f = (kt == 6) ? r0 * __builtin_amdgcn_rcpf(r1) : r1;
              acc[i][0][r] *= f; acc[i][1][r] *= f;
            }
        }
      }
    } else
    for (int kt = kt0; kt < kt1; ++kt) {
      __syncthreads();
#pragma unroll
      for (int i = 0; i < 4; ++i) {
        *(bf16x8*)(As + (sr + i * 32) * 72 + sc) = ra[i];
        *(bf16x8*)(Bs + (sr + i * 32) * 72 + sc) = rb[i];
      }
      __syncthreads();
      if (kt + 1 < kt1) {
#pragma unroll
        for (int i = 0; i < 4; ++i) {
          ra[i] = *(const bf16x8*)(ga + (size_t)i * 32 * K + (kt + 1 - kt0) * 64);
          rb[i] = *(const bf16x8*)(gb + (size_t)i * 32 * K + (kt + 1 - kt0) * 64);
        }
      }
#pragma unroll
      for (int kk = 0; kk < 4; ++kk) {
        bf16x8 a0 = *(const bf16x8*)(As + (wm * 64 + lr) * 72 + kk * 16 + lh * 8);
        bf16x8 a1 = *(const bf16x8*)(As + (wm * 64 + 32 + lr) * 72 + kk * 16 + lh * 8);
        bf16x8 b0v = *(const bf16x8*)(Bs + (wn * 64 + lr) * 72 + kk * 16 + lh * 8);
        bf16x8 b1v = *(const bf16x8*)(Bs + (wn * 64 + 32 + lr) * 72 + kk * 16 + lh * 8);
        acc[0][0] = __builtin_amdgcn_mfma_f32_32x32x16_bf16(a0, b0v, acc[0][0], 0, 0, 0);
        acc[0][1] = __builtin_amdgcn_mfma_f32_32x32x16_bf16(a0, b1v, acc[0][1], 0, 0, 0);
        acc[1][0] = __builtin_amdgcn_mfma_f32_32x32x16_bf16(a1, b0v, acc[1][0], 0, 0, 0);
        acc[1][1] = __builtin_amdgcn_mfma_f32_32x32x16_bf16(a1, b1v, acc[1][1], 0, 0, 0);
      }
      if (mode == 1 && !SPLIT && (kt == 7 || kt == 15)) {
#pragma unroll
        for (int i = 0; i < 2; ++i)
#pragma unroll
          for (int r = 0; r < 16; ++r) {
            int lrow = wm * 64 + i * 32 + (r & 3) + 8 * (r >> 2) + 4 * lh;
            float r0 = rsS[lrow * 2], r1 = rsS[lrow * 2 + 1];
            float f = (kt == 7) ? r0 * __builtin_amdgcn_rcpf(r1) : r1;
            acc[i][0][r] *= f; acc[i][1][r] *= f;
          }
      }
    }
    if (mode == 0) {
      if (ni < 46) {
        bf16_t* dst; int ld, cb;
        if (ni < 8) { dst = p.PZ; ld = 1024; cb = ni * 128; }
        else if (ni < 20) { dst = p.PXBC; ld = 1536; cb = (ni - 8) * 128; }
        else if (ni < 36) { dst = p.PSC; ld = 2048; cb = (ni - 20) * 128; }
        else { dst = p.PATT; ld = 1280; cb = (ni - 36) * 128; }
#pragma unroll
        for (int i = 0; i < 2; ++i)
#pragma unroll
          for (int j = 0; j < 2; ++j)
#pragma unroll
            for (int r = 0; r < 16; ++r) {
              int row = m0 + wm * 64 + i * 32 + (r & 3) + 8 * (r >> 2) + 4 * lh;
              int col = cb + wn * 64 + j * 32 + lr;
              dst[(size_t)row * ld + col] = f2bf(acc[i][j][r]);
            }
      } else if (wn == 0) {
#pragma unroll
        for (int i = 0; i < 2; ++i)
#pragma unroll
          for (int r = 0; r < 16; ++r) {
            int row = m0 + wm * 64 + i * 32 + (r & 3) + 8 * (r >> 2) + 4 * lh;
            p.DTRAW[(size_t)row * 32 + lr] = acc[i][0][r];
          }
      }
    } else if (!SPLIT) {
      float* Os = (float*)smem;
      const int ocol4 = (tid & 31) * 4, orow = tid >> 5;
      const int b = b0 + m0 / SEQ;
      const float4 g4 = *(const float4*)(p.MOD + ((size_t)layer * 5 + b) * 3072 + 2048 + n0 + ocol4);
      __syncthreads();
#pragma unroll
      for (int half = 0; half < 2; ++half) {
        if (wm == half) {
#pragma unroll
          for (int i = 0; i < 2; ++i)
#pragma unroll
            for (int j = 0; j < 2; ++j)
#pragma unroll
              for (int r = 0; r < 16; ++r)
                Os[(i * 32 + (r & 3) + 8 * (r >> 2) + 4 * lh) * 132 + wn * 64 + j * 32 + lr] = acc[i][j][r];
        }
        __syncthreads();
#pragma unroll 4
        for (int k = 0; k < 8; ++k) {
          int row = orow + 8 * k;
          float4 v = *(const float4*)(Os + row * 132 + ocol4);
          size_t idx = ((size_t)b0 * SEQ + m0 + half * 64 + row) * D + n0 + ocol4;
          float4 x4 = (layer == 0) ? *(const float4*)(p.x + idx) : *(const float4*)(p.out + idx);
          float4 o = {x4.x + g4.x * v.x, x4.y + g4.y * v.y, x4.z + g4.z * v.z, x4.w + g4.w * v.w};
          *(float4*)(p.out + idx) = o;
        }
        __syncthreads();
      }
    } else {
#pragma unroll
      for (int i = 0; i < 2; ++i)
#pragma unroll
        for (int j = 0; j < 2; ++j)
#pragma unroll
          for (int r = 0; r < 16; ++r) {
            int row = m0 + wm * 64 + i * 32 + (r & 3) + 8 * (r >> 2) + 4 * lh;
            int col = n0 + wn * 64 + j * 32 + lr;
            int lrow = row - m0;
            float f = (ks < 4) ? rsS[lrow * 2 + (ks >> 1)] : 1.f;
            p.PART[((size_t)ks * NTC + (row - NTL)) * D + col] = acc[i][j][r] * f;
          }
    }
  };
  for (int t = tstart + lb; t < tend; t += nbx) {
    int mi, ni;
    if (t >= T_main) { int e = t - T_main, j = e % 15; mi = 64 + e / 15; ni = (j < 12) ? 8 + j : ((j < 14) ? 28 + j : 46); }
    else if (t < ng_full * per_group) { int ng = t / per_group, r = t % per_group; mi = r >> 3; ni = ng * 8 + (r & 7); }
    else { int r = t - ng_full * per_group; mi = r / rem; ni = ng_full * 8 + r % rem; }
    tile(mi, ni, std::integral_constant<bool, false>{}, -1);
  }
  if (do_split) {
    for (int s = bid; s < 256; s += gridDim.x) {
      int ct = s >> 3, ks = s & 7;
      tile(64 + (ct >> 3), ct & 7, std::integral_constant<bool, true>{}, ks);
    }
  }
}

__device__ void phase_gemm_in256(const Params& p, int layer, int pass, bf16_t* smem) {
  constexpr int K = 1024, nk = 16;
  const bf16_t* A = p.H;
  const bf16_t* Bt = p.WinT + (size_t)layer * NWIN * 1024;
  const bool ctx_sparse = (layer == 1);
  const int tm = (ctx_sparse ? NTL : NT) / 256, tn = NWIN / 128, T_main = tm * tn, T = T_main + (ctx_sparse ? 30 : 0);
  const int tid = opq_tid(), lane = tid & 63, wid = tid >> 6, wm = wid >> 1, wn = wid & 1;
  const int lr = lane & 31, lh = lane >> 5;
  bf16_t* As = smem;
  bf16_t* Bs = smem + 256 * 72;
  const int bid = opq_bid();
  int tstart = 0, tend = T, lb = bid, nbx = gridDim.x;
  if ((gridDim.x & 7) == 0) {
    int xcd = bid & 7; lb = bid >> 3; nbx = gridDim.x >> 3;
    tstart = (int)((long)T * xcd / 8); tend = (int)((long)T * (xcd + 1) / 8);
  }
  const int ng_full = tn / 8, rem = tn % 8, per_group = tm * 8;
  const int sr = tid >> 3, sc = (tid & 7) * 8;
  for (int t = tstart + lb; t < tend; t += nbx) {
    int mi, ni;
    if (t >= T_main) { int e = t - T_main, j = e % 15; mi = 32 + e / 15; ni = (j < 12) ? 8 + j : ((j < 14) ? 28 + j : 46); }
    else if (t < ng_full * per_group) { int ng = t / per_group, r = t % per_group; mi = r >> 3; ni = ng * 8 + (r & 7); }
    else { int r = t - ng_full * per_group; mi = r / rem; ni = ng_full * 8 + r % rem; }
    const int m0 = mi * 256, n0 = ni * 128;
    f32x16 acc[4][2];
#pragma unroll
    for (int i = 0; i < 4; ++i)
#pragma unroll
      for (int j = 0; j < 2; ++j)
#pragma unroll
        for (int r = 0; r < 16; ++r) acc[i][j][r] = 0.f;
    const bf16_t* ga = A + (size_t)(m0 + sr) * K + sc;
    const bf16_t* gb = Bt + (size_t)(n0 + sr) * K + sc;
    bf16x8 ra[8], rb[4];
#pragma unroll
    for (int i = 0; i < 8; ++i) ra[i] = *(const bf16x8*)(ga + (size_t)i * 32 * K);
#pragma unroll
    for (int i = 0; i < 4; ++i) rb[i] = *(const bf16x8*)(gb + (size_t)i * 32 * K);
    for (int kt = 0; kt < nk; ++kt) {
      __syncthreads();
#pragma unroll
      for (int i = 0; i < 8; ++i) *(bf16x8*)(As + (sr + i * 32) * 72 + sc) = ra[i];
#pragma unroll
      for (int i = 0; i < 4; ++i) *(bf16x8*)(Bs + (sr + i * 32) * 72 + sc) = rb[i];
      __syncthreads();
      if (kt + 1 < nk) {
#pragma unroll
        for (int i = 0; i < 8; ++i) ra[i] = *(const bf16x8*)(ga + (size_t)i * 32 * K + (kt + 1) * 64);
#pragma unroll
        for (int i = 0; i < 4; ++i) rb[i] = *(const bf16x8*)(gb + (size_t)i * 32 * K + (kt + 1) * 64);
      }
#pragma unroll
      for (int kk = 0; kk < 4; ++kk) {
        bf16x8 b0v = *(const bf16x8*)(Bs + (wn * 64 + lr) * 72 + kk * 16 + lh * 8);
        bf16x8 b1v = *(const bf16x8*)(Bs + (wn * 64 + 32 + lr) * 72 + kk * 16 + lh * 8);
#pragma unroll
        for (int i = 0; i < 4; ++i) {
          bf16x8 av = *(const bf16x8*)(As + (wm * 128 + i * 32 + lr) * 72 + kk * 16 + lh * 8);
          acc[i][0] = __builtin_amdgcn_mfma_f32_32x32x16_bf16(av, b0v, acc[i][0], 0, 0, 0);
          acc[i][1] = __builtin_amdgcn_mfma_f32_32x32x16_bf16(av, b1v, acc[i][1], 0, 0, 0);
        }
      }
    }
    if (ni < 46) {
      bf16_t* dst; int ld, cb;
      if (ni < 8) { dst = p.PZ; ld = 1024; cb = ni * 128; }
      else if (ni < 20) { dst = p.PXBC; ld = 1536; cb = (ni - 8) * 128; }
      else if (ni < 36) { dst = p.PSC; ld = 2048; cb = (ni - 20) * 128; }
      else { dst = p.PATT; ld = 1280; cb = (ni - 36) * 128; }
      bf16_t* Os = smem;
      __syncthreads();
#pragma unroll
      for (int half = 0; half < 2; ++half) {
        if (wm == half) {
          bf16_t* q = Os + (4 * lh) * 136 + wn * 64 + lr;
#pragma unroll
          for (int i = 0; i < 4; ++i)
#pragma unroll
            for (int j = 0; j < 2; ++j)
#pragma unroll
              for (int r = 0; r < 16; ++r) q[(i * 32 + (r & 3) + 8 * (r >> 2)) * 136 + j * 32] = f2bf(acc[i][j][r]);
        }
        __syncthreads();
        {
          const int orow = tid >> 4, ocol = (tid & 15) * 8;
          bf16_t* gd = dst + (size_t)(m0 + half * 128 + orow) * ld + cb + ocol;
#pragma unroll
          for (int k = 0; k < 8; ++k) {
            bf16x8 v = *(const bf16x8*)(Os + (orow + 16 * k) * 136 + ocol);
            *(bf16x8*)(gd + (size_t)(16 * k) * ld) = v;
          }
        }
        __syncthreads();
      }
    } else if (wn == 0) {
#pragma unroll
      for (int i = 0; i < 4; ++i)
#pragma unroll
        for (int r = 0; r < 16; ++r) {
          int row = m0 + wm * 128 + i * 32 + (r & 3) + 8 * (r >> 2) + 4 * lh;
          p.DTRAW[(size_t)row * 32 + lr] = acc[i][0][r];
        }
    }
  }
}

__device__ void phase_prep(const Params& p, int layer, int pass, float* smem) {
  const int tid = opq_tid(), lane = tid & 63;
  const int gw = opq_bid() * 4 + (tid >> 6), nw = gridDim.x * 4;
  const int nchc = (layer == 0) ? NCH : 64;
  const int Nb = NCH * 4 * 24, Nc = nchc * 16, Nd = (NT * 40) / 64, Ne = NCH * 16 * 2;
  const int Na = NCH * 4;
  for (int uu0 = gw; uu0 < Na + Nb + Nc + Nd + Ne; uu0 += nw) {
  const int uu = uu0 - Na;
  if (uu0 < Na) {
    const int q = uu0 & 3, gc = uu0 >> 2;
    const int dh = q * 8 + (lane & 7), seg = lane >> 3;
    const bool fwd = (q < 2);
    const float bias = p.ssd_dt_bias[layer * 32 + dh];
    const float A = -expf(p.ssd_a_log[layer * 32 + dh]);
    float dtv[16], loc[16];
#pragma unroll
    for (int j = 0; j < 16; ++j) {
      float raw = p.DTRAW[((size_t)gc * 128 + seg * 16 + j) * 32 + dh] + bias;
      dtv[j] = raw > 20.f ? raw : log1pf(expf(raw));
    }
    float s = 0.f;
    if (fwd) {
#pragma unroll
      for (int j = 0; j < 16; ++j) { s += dtv[j] * A; loc[j] = s; }
    } else {
#pragma unroll
      for (int j = 15; j >= 0; --j) { s += dtv[j] * A; loc[j] = s; }
    }
    float off = 0.f, tot = 0.f;
#pragma unroll
    for (int k = 0; k < 8; ++k) {
      float sk = __shfl(s, (lane & 7) + 8 * k);
      tot += sk;
      if (fwd ? (k < seg) : (k > seg)) off += sk;
    }
    const size_t base = ((size_t)gc * 32 + dh) * 128 + seg * 16;
#pragma unroll
    for (int g4 = 0; g4 < 4; ++g4) {
      f32x4 c4, v4, e4, w4;
#pragma unroll
      for (int t = 0; t < 4; ++t) {
        float cum = loc[g4 * 4 + t] + off, dt = dtv[g4 * 4 + t];
        c4[t] = cum; v4[t] = cum - logf(fmaxf(dt, 1e-30f)); e4[t] = expf(cum); w4[t] = dt * expf(tot - cum);
      }
      *(f32x4*)(p.CUMT + base + g4 * 4) = c4;
      *(f32x4*)(p.VV + base + g4 * 4) = v4;
      *(f32x4*)(p.EC + base + g4 * 4) = e4;
      *(f32x4*)(p.WW + base + g4 * 4) = w4;
    }
  } else if (uu < Nb) {
    const int u = uu;
    int cblk = u % 24, l32 = (u / 24) & 3, gc = u / (24 * 4);
    int c = cblk * 64 + lane;
    bool first, last;
    if (gc < 64) { first = (gc % 32 == 0) && l32 == 0; last = (gc % 32 == 31) && l32 == 3; }
    else { first = ((gc - 64) % 2 == 0) && l32 == 0; last = ((gc - 64) % 2 == 1) && l32 == 3; }
    int t0 = gc * 128 + l32 * 32;
    float w0 = p.ssd_conv_w[((size_t)layer * 3 + 0) * 1536 + c], w1 = p.ssd_conv_w[((size_t)layer * 3 + 1) * 1536 + c],
          w2 = p.ssd_conv_w[((size_t)layer * 3 + 2) * 1536 + c], bs = p.ssd_conv_b[layer * 1536 + c];
    bf16_t raw[34];
#pragma unroll
    for (int i = 0; i < 34; ++i) {
      bool ok = !((i == 0 && first) || (i == 33 && last));
      raw[i] = ok ? p.PXBC[(size_t)(t0 + i - 1) * 1536 + c] : (bf16_t)0;
    }
    bf16x8 o[4];
#pragma unroll
    for (int j = 0; j < 32; ++j)
      o[j >> 3][j & 7] = (short)f2bf(silu_f(w0 * bf2f(raw[j]) + w1 * bf2f(raw[j + 1]) + w2 * bf2f(raw[j + 2]) + bs));
    if (c < 1024) {
#pragma unroll
      for (int k = 0; k < 4; ++k) *(bf16x8*)(p.XT + ((size_t)gc * 1024 + c) * 128 + l32 * 32 + k * 8) = o[k];
    } else if (c < 1280) {
      int n = c - 1024;
#pragma unroll
      for (int k = 0; k < 4; ++k) *(bf16x8*)(p.BT + ((size_t)gc * 256 + n) * 128 + l32 * 32 + k * 8) = o[k];
#pragma unroll
      for (int j = 0; j < 32; ++j) p.BR[(size_t)(t0 + j) * 256 + n] = (bf16_t)o[j >> 3][j & 7];
    } else {
      int n = c - 1280;
#pragma unroll
      for (int j = 0; j < 32; ++j) p.CR[(size_t)(t0 + j) * 256 + n] = (bf16_t)o[j >> 3][j & 7];
    }
  } else if (uu < Nb + Nc) {
    {
      const int u = uu - Nb;
      const int l8 = u & 15, gc = u >> 4;
      const int c0 = lane * 8;
      bool first, last;
      if (gc < 64) { first = (gc % 32 == 0) && l8 == 0; last = (gc % 32 == 31) && l8 == 15; }
      else { first = ((gc - 64) % 2 == 0) && l8 == 0; last = ((gc - 64) % 2 == 1) && l8 == 15; }
      const int t0 = gc * 128 + l8 * 8;
      float w0[8], w1[8], w2[8];
      {
        const float* wp = p.sc_conv_w + (size_t)layer * 3 * 512 + c0;
        f32x4 a0 = *(const f32x4*)wp, a1 = *(const f32x4*)(wp + 4);
        f32x4 b0 = *(const f32x4*)(wp + 512), b1 = *(const f32x4*)(wp + 516);
        f32x4 d0 = *(const f32x4*)(wp + 1024), d1 = *(const f32x4*)(wp + 1028);
#pragma unroll
        for (int k = 0; k < 4; ++k) { w0[k] = a0[k]; w0[4 + k] = a1[k]; w1[k] = b0[k]; w1[4 + k] = b1[k]; w2[k] = d0[k]; w2[4 + k] = d1[k]; }
      }
      float up[10][8];
#pragma unroll
      for (int i = 0; i < 10; ++i) {
        bool ok = !((i == 0 && first) || (i == 9 && last));
        const bf16_t* r = p.PSC + (size_t)(t0 + i - 1) * 2048 + c0;
        bf16x8 v8 = ok ? *(const bf16x8*)r : bf16x8{0, 0, 0, 0, 0, 0, 0, 0};
        bf16x8 g8 = ok ? *(const bf16x8*)(r + 512) : bf16x8{0, 0, 0, 0, 0, 0, 0, 0};
#pragma unroll
        for (int k = 0; k < 8; ++k) up[i][k] = bf2f((bf16_t)v8[k]) * bf2f((bf16_t)g8[k]);
      }
#pragma unroll
      for (int j = 0; j < 8; ++j) {
        const bf16_t* r = p.PSC + (size_t)(t0 + j) * 2048 + c0;
        bf16x8 b8 = *(const bf16x8*)(r + 1024), z8 = *(const bf16x8*)(r + 1536);
        f32x4 lo, hi;
#pragma unroll
        for (int k = 0; k < 8; ++k) {
          float cv = w0[k] * up[j][k] + w1[k] * up[j + 1][k] + w2[k] * up[j + 2][k];
          float o = bf2f((bf16_t)b8[k]) * cv * silu_f(bf2f((bf16_t)z8[k]));
          if (k < 4) lo[k] = o; else hi[k - 4] = o;
        }
        *(bf16x8*)(p.Y + (size_t)(t0 + j) * 2048 + 1024 + c0) = pack8(lo, hi);
      }
    }
  } else if (uu < Nb + Nc + Nd) {
    {
      const int idx = (uu - Nb - Nc) * 64 + lane;
      int row = idx / 40, r = idx % 40;
      int slot = r >> 2, a = (r >> 1) & 1, i0 = (r & 1) * 8;
      const bf16_t* src = p.PATT + (size_t)row * 1280 + (slot < 8 ? slot * 64 : 512 + (slot - 8) * 64) + a * 32 + i0;
      bf16x8 x1 = *(const bf16x8*)src, x2 = *(const bf16x8*)(src + 16);
      bf16x8 o1, o2;
      if (row < NTL) {
        int t = row & (SEQ - 1);
        int pos = (a == 0) ? (t >> 6) : (t & 63);
        const float* tb = p.ROPE + (pos * 16 + i0) * 2;
#pragma unroll
        for (int j = 0; j < 8; ++j) {
          float cs = tb[2 * j], sn = tb[2 * j + 1];
          float a1 = bf2f((bf16_t)x1[j]), a2 = bf2f((bf16_t)x2[j]);
          o1[j] = (short)f2bf(a1 * cs - a2 * sn);
          o2[j] = (short)f2bf(a1 * sn + a2 * cs);
        }
      } else { o1 = x1; o2 = x2; }
      bf16_t* dst = (slot < 8) ? p.QR + (size_t)row * 512 + slot * 64 + a * 32 + i0
                               : p.KR + (size_t)row * 128 + (slot - 8) * 64 + a * 32 + i0;
      *(bf16x8*)dst = o1; *(bf16x8*)(dst + 16) = o2;
    }
  } else {
    const int u = uu - Nb - Nc - Nd;
    int half = u & 1, l8 = (u >> 1) & 15, gc = u >> 5;
    int c = half * 64 + lane;
    int t0 = gc * 128 + l8 * 8;
    bf16x8 o;
#pragma unroll
    for (int j = 0; j < 8; ++j) o[j] = (short)p.PATT[(size_t)(t0 + j) * 1280 + 640 + c];
    *(bf16x8*)(p.VT + ((size_t)gc * 128 + c) * 128 + l8 * 8) = o;
  }
  }
}

__device__ void phase_attn_naive(const Params& p, int layer, int pass) {
  const int lane = opq_tid() & 63;
  const int gw = opq_bid() * 4 + (opq_tid() >> 6), nw = gridDim.x * 4;
  const int nrows = (layer == 0) ? NT : NTL;
  for (int u = gw; u < nrows * 8; u += nw) {
    int h = u & 7, row = u >> 3, kvh = h >> 2;
    float q = bf2f(p.QR[(size_t)row * 512 + h * 64 + lane]);
    float m = p.attn_sink[layer * 8 + h], l = 1.f, o = 0.f;
    int bl, k0 = 0, k1 = 0;
    if (row < NTL) {
      bl = row / SEQ; int t = row % SEQ;
      int lo = t - 128 < 0 ? 0 : t - 128, hi = t + 128 > SEQ - 1 ? SEQ - 1 : t + 128;
      k0 = bl * SEQ + lo; k1 = bl * SEQ + hi + 1;
    } else bl = (row - NTL) / CTXL;
    int nband = k1 - k0;
    for (int kk = 0; kk < nband + CTXL; ++kk) {
      int kr = (kk < nband) ? k0 + kk : NTL + bl * CTXL + (kk - nband);
      float kv = bf2f(p.KR[(size_t)kr * 128 + kvh * 64 + lane]);
      float vv = bf2f(p.VT[((size_t)(kr >> 7) * 128 + kvh * 64 + lane) * 128 + (kr & 127)]);
      float s = wave_sum(q * kv) * 0.125f;
      float mn = fmaxf(m, s);
      float corr = expf(m - mn), pe = expf(s - mn);
      l = l * corr + pe; o = o * corr + pe * vv; m = mn;
    }
    float z = bf2f(p.PATT[(size_t)row * 1280 + 768 + h * 64 + lane]);
    p.Y[(size_t)row * 2048 + 1536 + h * 64 + lane] = f2bf(o / l * silu_f(z));
  }
}

__device__ void phase_attn(const Params& p, int layer, int pass, bf16_t* smem) {
  const int tid = opq_tid(), lane = tid & 63, wid = tid >> 6, lr = lane & 31, lh = lane >> 5;
  const int nqt = ((layer == 0) ? NT : NTL) / 32;
  const int srow = tid >> 3, scol = (tid & 7) * 8;
  for (int u = (opq_bid() + (int)gridDim.x - 64) % (int)gridDim.x; u < nqt * 2; u += gridDim.x) {
    const int kvh = u & 1, qt = u >> 1, h = kvh * 4 + wid;
    const int q0 = qt * 32;
    int bl, nband = 0, tb0 = 0, t0 = 0;
    if (q0 < NTL) {
      bl = q0 >> 12; t0 = q0 & 4095;
      tb0 = (t0 - 128 < 0) ? 0 : ((t0 - 128) >> 6);
      int tb1 = (t0 + 159) >> 6; if (tb1 > 63) tb1 = 63;
      nband = tb1 - tb0 + 1;
    } else bl = (q0 - NTL) >> 8;
    const int ntile = nband + 4;
    bf16x8 qf[4];
    {
      const bf16_t* qp = p.QR + (size_t)(q0 + lr) * 512 + h * 64 + lh * 8;
#pragma unroll
      for (int kk = 0; kk < 4; ++kk) qf[kk] = *(const bf16x8*)(qp + kk * 16);
    }
    float m = p.attn_sink[layer * 8 + h], l = 1.f;
    f32x16 o[2];
#pragma unroll
    for (int r = 0; r < 16; ++r) { o[0][r] = 0.f; o[1][r] = 0.f; }
    const int qpos = t0 + lr;
    bf16x8 rk[2], rv[2];
    auto fetch = [&](int ti) __attribute__((always_inline)) {
      const int kr0 = (ti < nband) ? bl * 4096 + (tb0 + ti) * 64 : NTL + bl * 256 + (ti - nband) * 64;
      const bf16_t* kp = p.KR + (size_t)(kr0 + srow) * 128 + kvh * 64 + scol;
      const bf16_t* vp = p.VT + ((size_t)(kr0 >> 7) * 128 + kvh * 64 + srow) * 128 + (kr0 & 127) + scol;
      rk[0] = *(const bf16x8*)kp; rk[1] = *(const bf16x8*)(kp + 32 * 128);
      rv[0] = *(const bf16x8*)vp; rv[1] = *(const bf16x8*)(vp + 32 * 128);
    };
    auto stash = [&](bf16_t* buf) __attribute__((always_inline)) {
      *(bf16x8*)(buf + srow * 72 + scol) = rk[0];
      *(bf16x8*)(buf + (srow + 32) * 72 + scol) = rk[1];
      *(bf16x8*)(buf + 4608 + srow * 72 + scol) = rv[0];
      *(bf16x8*)(buf + 4608 + (srow + 32) * 72 + scol) = rv[1];
    };
    fetch(0);
    __syncthreads();
    stash(smem);
    if (1 < ntile) fetch(1);
    __syncthreads();
    for (int ti = 0; ti < ntile; ++ti) {
      const bf16_t* Kc = smem + (ti & 1) * 9216;
      const bf16_t* Vc = Kc + 4608;
      if (ti + 1 < ntile) {
        stash(smem + ((ti + 1) & 1) * 9216);
        if (ti + 2 < ntile) fetch(ti + 2);
      }
      f32x16 st[2];
#pragma unroll
      for (int r = 0; r < 16; ++r) { st[0][r] = 0.f; st[1][r] = 0.f; }
#pragma unroll
      for (int kk = 0; kk < 4; ++kk) {
        bf16x8 kf0 = *(const bf16x8*)(Kc + lr * 72 + kk * 16 + lh * 8);
        bf16x8 kf1 = *(const bf16x8*)(Kc + (32 + lr) * 72 + kk * 16 + lh * 8);
        st[0] = __builtin_amdgcn_mfma_f32_32x32x16_bf16(kf0, qf[kk], st[0], 0, 0, 0);
        st[1] = __builtin_amdgcn_mfma_f32_32x32x16_bf16(kf1, qf[kk], st[1], 0, 0, 0);
      }
      float mx = -3.0e38f;
      const bool band = ti < nband;
      const int kbase = (tb0 + ti) * 64 + 4 * lh;
#pragma unroll
      for (int hh = 0; hh < 2; ++hh)
#pragma unroll
        for (int r = 0; r < 16; ++r) {
          float s = st[hh][r] * 0.125f;
          if (band) {
            int dd = qpos - (kbase + hh * 32 + (r & 3) + 8 * (r >> 2));
            if (dd > 128 || dd < -128) s = -1e30f;
          }
          st[hh][r] = s; mx = fmaxf(mx, s);
        }
      mx = fmaxf(mx, __shfl_xor(mx, 32));
      const float mn = fmaxf(m, mx);
      const float corr = __expf(m - mn);
      m = mn;
      float ls = 0.f;
#pragma unroll
      for (int hh = 0; hh < 2; ++hh)
#pragma unroll
        for (int r = 0; r < 16; ++r) { st[hh][r] = __expf(st[hh][r] - mn); ls += st[hh][r]; }
      ls += __shfl_xor(ls, 32);
      l = l * corr + ls;
#pragma unroll
      for (int r = 0; r < 16; ++r) { o[0][r] *= corr; o[1][r] *= corr; }
#pragma unroll
      for (int hh = 0; hh < 2; ++hh)
#pragma unroll
        for (int s2 = 0; s2 < 2; ++s2) {
          f32x4 pa = {st[hh][8 * s2 + 0], st[hh][8 * s2 + 1], st[hh][8 * s2 + 2], st[hh][8 * s2 + 3]};
          f32x4 pb = {st[hh][8 * s2 + 4], st[hh][8 * s2 + 5], st[hh][8 * s2 + 6], st[hh][8 * s2 + 7]};
          bf16x8 pf = pack8(pa, pb);
#pragma unroll
          for (int mt = 0; mt < 2; ++mt) {
            const bf16_t* vp = Vc + (mt * 32 + lr) * 72 + hh * 32 + 16 * s2 + 4 * lh;
            bf16x4 x0 = *(const bf16x4*)vp, x1 = *(const bf16x4*)(vp + 8);
            bf16x8 vfr = {x0[0], x0[1], x0[2], x0[3], x1[0], x1[1], x1[2], x1[3]};
            o[mt] = __builtin_amdgcn_mfma_f32_32x32x16_bf16(vfr, pf, o[mt], 0, 0, 0);
          }
        }
      __syncthreads();
    }
    const float inv = 1.f / l;
    {
      bf16_t* Zw = smem + 2 * 9216 + wid * (32 * 72);
      const int er = lane >> 3, ec = (lane & 7) * 8;
      const bf16_t* zg = p.PATT + (size_t)(q0 + er) * 1280 + 768 + h * 64 + ec;
      bf16x8 zr[4];
#pragma unroll
      for (int i = 0; i < 4; ++i) zr[i] = *(const bf16x8*)(zg + (size_t)i * 8 * 1280);
#pragma unroll
      for (int i = 0; i < 4; ++i) *(bf16x8*)(Zw + (er + 8 * i) * 72 + ec) = zr[i];
#pragma unroll
      for (int mt = 0; mt < 2; ++mt)
#pragma unroll
        for (int qq = 0; qq < 4; ++qq) {
          int d0 = mt * 32 + 8 * qq + 4 * lh;
          bf16x4 z4 = *(const bf16x4*)(Zw + lr * 72 + d0);
          bf16x4 o4;
#pragma unroll
          for (int t = 0; t < 4; ++t) o4[t] = (short)f2bf(o[mt][qq * 4 + t] * inv * silu_f(bf2f((bf16_t)z4[t])));
          *(bf16x4*)(Zw + lr * 72 + d0) = o4;
        }
      bf16_t* yg = p.Y + (size_t)(q0 + er) * 2048 + 1536 + h * 64 + ec;
#pragma unroll
      for (int i = 0; i < 4; ++i) *(bf16x8*)(yg + (size_t)i * 8 * 2048) = *(const bf16x8*)(Zw + (er + 8 * i) * 72 + ec);
    }
  }
}

__device__ void phase_s1(const Params& p, int layer, int pass) {
  const int tid = opq_tid(), lane = tid & 63, lr = lane & 31, lh = lane >> 5;
  const int gw = opq_bid() * 4 + (tid >> 6), nw = gridDim.x * 4;
  for (int u = gw; u < NCH * 64; u += nw) {
    int nt = u & 3, h = (u >> 2) & 15, gc = u >> 6, g = h >> 3;
    f32x16 acc[2][2];
#pragma unroll
    for (int d = 0; d < 2; ++d)
#pragma unroll
      for (int mt = 0; mt < 2; ++mt)
#pragma unroll
        for (int r = 0; r < 16; ++r) acc[d][mt][r] = 0.f;
    const bf16_t* brow = p.BT + ((size_t)gc * 256 + g * 128 + nt * 32 + lr) * 128 + lh * 8;
    const bf16_t* xrow = p.XT + ((size_t)gc * 1024 + h * 64 + lr) * 128 + lh * 8;
    const float* w0 = p.WW + ((size_t)gc * 32 + h) * 128 + lh * 8;
    const float* w1 = p.WW + ((size_t)gc * 32 + 16 + h) * 128 + lh * 8;
#pragma unroll
    for (int kk = 0; kk < 8; ++kk) {
      bf16x8 bfr = *(const bf16x8*)(brow + kk * 16);
      bf16x8 x0 = *(const bf16x8*)(xrow + kk * 16);
      bf16x8 x1 = *(const bf16x8*)(xrow + 32 * 128 + kk * 16);
#pragma unroll
      for (int d = 0; d < 2; ++d) {
        const float* wp = (d == 0 ? w0 : w1) + kk * 16;
        f32x4 wa = *(const f32x4*)wp, wb = *(const f32x4*)(wp + 4);
        f32x4 a0, a1, c0, c1;
#pragma unroll
        for (int j = 0; j < 4; ++j) {
          a0[j] = bf2f((bf16_t)x0[j]) * wa[j]; a1[j] = bf2f((bf16_t)x0[4 + j]) * wb[j];
          c0[j] = bf2f((bf16_t)x1[j]) * wa[j]; c1[j] = bf2f((bf16_t)x1[4 + j]) * wb[j];
        }
        acc[d][0] = __builtin_amdgcn_mfma_f32_32x32x16_bf16(pack8(a0, a1), bfr, acc[d][0], 0, 0, 0);
        acc[d][1] = __builtin_amdgcn_mfma_f32_32x32x16_bf16(pack8(c0, c1), bfr, acc[d][1], 0, 0, 0);
      }
    }
#pragma unroll
    for (int d = 0; d < 2; ++d)
#pragma unroll
      for (int mt = 0; mt < 2; ++mt)
#pragma unroll
        for (int r = 0; r < 16; ++r) {
          int pp = mt * 32 + (r & 3) + 8 * (r >> 2) + 4 * lh;
          p.LST[((((size_t)gc * 16 + h) * 2 + d) * 64 + pp) * 128 + nt * 32 + lr] = acc[d][mt][r];
        }
  }
}

__device__ __forceinline__ int scan_chunk(int ci, int bl, int d) {
  if (ci < 2) return 64 + bl * 2 + (d == 0 ? ci : 1 - ci);
  int cc = ci - 2;
  return bl * 32 + (d == 0 ? cc : 31 - cc);
}
__device__ void phase_s2(const Params& p, int layer, int pass) {
  const int nth = gridDim.x * 256;
  for (int e = opq_bid() * 256 + opq_tid(); e < 64 * 2048; e += nth) {
    int seq = e >> 11, q = e & 2047, pp = q >> 5, n4 = (q & 31) * 4;
    int d = seq & 1, h = (seq >> 1) & 15, bl = seq >> 5;
    f32x4 s = {0.f, 0.f, 0.f, 0.f};
    const size_t eoff = ((size_t)h * 2 + d) * 8192 + (size_t)pp * 128 + n4;
    const int toff = (d == 0) ? h * 128 + 127 : (16 + h) * 128;
#pragma unroll
    for (int half = 0; half < 2; ++half) {
      f32x4 loc[17]; float tot[17];
#pragma unroll
      for (int i = 0; i < 17; ++i) {
        int gc = scan_chunk(half * 17 + i, bl, d);
        loc[i] = *(const f32x4*)(p.LST + (size_t)gc * 262144 + eoff);
        tot[i] = p.CUMT[(size_t)gc * 4096 + toff];
      }
#pragma unroll
      for (int i = 0; i < 17; ++i) {
        int gc = scan_chunk(half * 17 + i, bl, d);
        uint2 o; o.x = pk2(s[0], s[1]); o.y = pk2(s[2], s[3]);
        *(uint2*)(p.SIN + (size_t)gc * 262144 + eoff) = o;
        float dec = expf(tot[i]);
        s = s * dec + loc[i];
      }
    }
  }
}

__device__ void phase_s3(const Params& p, int layer, int pass, bf16_t* smem) {
  const int tid = opq_tid(), lane = tid & 63, w = tid >> 6, lr = lane & 31, lh = lane >> 5;
  const int nch = (layer == 0) ? NCH : 64;
  constexpr int RS = 136;
  bf16_t* Ss = smem;
  bf16_t* Bs = smem;
  bf16_t* Xs = smem + 128 * RS;
  float* Vs = (float*)(smem + 192 * RS);
  bf16_t* Zs = smem + 192 * RS + 1536;
  bf16_t* Os = smem;
  const int srow = tid >> 4, scol = (tid & 15) * 8;
  for (int u = opq_bid(); u < nch * 16; u += gridDim.x) {
    const int h = u & 15, gc = u >> 4, g = h >> 3;
    const int i_own = 32 * w + lr;
    bf16x8 rs[8];
    {
      const bf16_t* Sg = p.SIN + ((size_t)gc * 16 + h) * 16384 + srow * 128 + scol;
#pragma unroll
      for (int i = 0; i < 8; ++i) rs[i] = *(const bf16x8*)(Sg + i * 2048);
    }
    bf16x8 cf[8];
    {
      const bf16_t* crow = p.CR + ((size_t)gc * 128 + i_own) * 256 + g * 128 + lh * 8;
#pragma unroll
      for (int kk = 0; kk < 8; ++kk) cf[kk] = *(const bf16x8*)(crow + kk * 16);
    }
    bf16x8 rz[4];
    {
      const bf16_t* Zg = p.PZ + ((size_t)gc * 128 + (tid >> 3)) * 1024 + h * 64 + (tid & 7) * 8;
#pragma unroll
      for (int i = 0; i < 4; ++i) rz[i] = *(const bf16x8*)(Zg + (size_t)i * 32 * 1024);
    }
    const size_t vidx = ((size_t)gc * 32 + (tid >> 7) * 16 + h) * 128 + (tid & 127);
    const float v_vv = p.VV[vidx], v_ec = p.EC[vidx], v_cu = p.CUMT[vidx];
    __syncthreads();
#pragma unroll
    for (int i = 0; i < 8; ++i) *(bf16x8*)(Ss + (srow + 16 * i) * RS + scol) = rs[i];
    Vs[tid] = v_vv; Vs[256 + tid] = v_ec; Vs[512 + tid] = v_cu;
#pragma unroll
    for (int i = 0; i < 4; ++i) *(bf16x8*)(Zs + ((tid >> 3) + 32 * i) * 72 + (tid & 7) * 8) = rz[i];
    bf16x8 rb[8], rx[4];
    {
      const bf16_t* Bg = p.BR + ((size_t)gc * 128 + srow) * 256 + g * 128 + scol;
#pragma unroll
      for (int i = 0; i < 8; ++i) rb[i] = *(const bf16x8*)(Bg + i * 16 * 256);
      const bf16_t* Xg = p.XT + ((size_t)gc * 1024 + h * 64 + srow) * 128 + scol;
#pragma unroll
      for (int i = 0; i < 4; ++i) rx[i] = *(const bf16x8*)(Xg + i * 2048);
    }
    __syncthreads();
    f32x16 y[2];
#pragma unroll
    for (int r = 0; r < 16; ++r) { y[0][r] = 0.f; y[1][r] = 0.f; }
#pragma unroll
    for (int d = 0; d < 2; ++d) {
      const float* ec = Vs + 256 + d * 128 + 32 * w + 4 * lh;
#pragma unroll
      for (int pt = 0; pt < 2; ++pt) {
        f32x16 tmp;
#pragma unroll
        for (int r = 0; r < 16; ++r) tmp[r] = 0.f;
        const bf16_t* sl = Ss + (d * 64 + pt * 32 + lr) * RS + lh * 8;
#pragma unroll
        for (int kk = 0; kk < 8; ++kk) {
          bf16x8 sf = *(const bf16x8*)(sl + kk * 16);
          tmp = __builtin_amdgcn_mfma_f32_32x32x16_bf16(cf[kk], sf, tmp, 0, 0, 0);
        }
#pragma unroll
        for (int q = 0; q < 4; ++q) {
          f32x4 e4 = *(const f32x4*)(ec + 8 * q);
#pragma unroll
          for (int t = 0; t < 4; ++t) y[pt][q * 4 + t] += tmp[q * 4 + t] * e4[t];
        }
      }
    }
    __syncthreads();
#pragma unroll
    for (int i = 0; i < 8; ++i) *(bf16x8*)(Bs + (srow + 16 * i) * RS + scol) = rb[i];
#pragma unroll
    for (int i = 0; i < 4; ++i) *(bf16x8*)(Xs + (srow + 16 * i) * RS + scol) = rx[i];
    __syncthreads();
    const float cum_f = Vs[512 + i_own];
    const float cum_b = Vs[512 + 128 + i_own];
#pragma unroll 1
    for (int jt = 0; jt < 4; ++jt) {
      f32x16 cb;
#pragma unroll
      for (int r = 0; r < 16; ++r) cb[r] = 0.f;
      const bf16_t* bl_ = Bs + (jt * 32 + lr) * RS + lh * 8;
#pragma unroll
      for (int kk = 0; kk < 8; ++kk) {
        bf16x8 bfr = *(const bf16x8*)(bl_ + kk * 16);
        cb = __builtin_amdgcn_mfma_f32_32x32x16_bf16(bfr, cf[kk], cb, 0, 0, 0);
      }
      bf16x8 xb[2][2];
#pragma unroll
      for (int s = 0; s < 2; ++s)
#pragma unroll
        for (int pt = 0; pt < 2; ++pt) {
          const bf16_t* xp = Xs + (pt * 32 + lr) * RS + jt * 32 + 16 * s + 4 * lh;
          bf16x4 x0 = *(const bf16x4*)xp, x1 = *(const bf16x4*)(xp + 8);
          bf16x8 t8 = {x0[0], x0[1], x0[2], x0[3], x1[0], x1[1], x1[2], x1[3]};
          xb[s][pt] = t8;
        }
#pragma unroll
      for (int d = 0; d < 2; ++d) {
        bool need = (d == 0) ? (jt <= w) : (jt >= w);
        if (!need) continue;
        const float* vv = Vs + d * 128 + jt * 32 + 4 * lh;
        const float ci = (d == 0) ? cum_f : cum_b;
        f32x16 gq;
#pragma unroll
        for (int q = 0; q < 4; ++q) {
          f32x4 v4 = *(const f32x4*)(vv + 8 * q);
#pragma unroll
          for (int t = 0; t < 4; ++t) {
            int j = jt * 32 + 8 * q + 4 * lh + t;
            float val = cb[q * 4 + t] * __expf(ci - v4[t]);
            bool ok = (jt != w) || ((d == 0) ? (j <= i_own) : (j >= i_own));
            gq[q * 4 + t] = ok ? val : 0.f;
          }
        }
#pragma unroll
        for (int s = 0; s < 2; ++s) {
          f32x4 ga = {gq[8 * s + 0], gq[8 * s + 1], gq[8 * s + 2], gq[8 * s + 3]};
          f32x4 gb = {gq[8 * s + 4], gq[8 * s + 5], gq[8 * s + 6], gq[8 * s + 7]};
          bf16x8 afr = pack8(ga, gb);
          y[0] = __builtin_amdgcn_mfma_f32_32x32x16_bf16(afr, xb[s][0], y[0], 0, 0, 0);
          y[1] = __builtin_amdgcn_mfma_f32_32x32x16_bf16(afr, xb[s][1], y[1], 0, 0, 0);
        }
      }
    }
    const float Dh = p.ssd_d[layer * 16 + h];
    float ssq[16];
#pragma unroll
    for (int r = 0; r < 16; ++r) ssq[r] = 0.f;
    __syncthreads();
#pragma unroll
    for (int pt = 0; pt < 2; ++pt)
#pragma unroll
      for (int q = 0; q < 4; ++q) {
        bf16x4 x4 = *(const bf16x4*)(Xs + (pt * 32 + lr) * RS + 32 * w + 8 * q + 4 * lh);
#pragma unroll
        for (int t = 0; t < 4; ++t) {
          int li = 32 * w + 8 * q + 4 * lh + t;
          float yv = y[pt][q * 4 + t] + Dh * bf2f((bf16_t)x4[t]);
          float z = bf2f(Zs[li * 72 + pt * 32 + lr]);
          float gv = yv * silu_f(z);
          ssq[q * 4 + t] += gv * gv;
          Os[li * 72 + pt * 32 + lr] = f2bf(gv);
        }
      }
    __syncthreads();
    {
      bf16_t* Yg = p.Y + ((size_t)gc * 128 + (tid >> 3)) * 2048 + h * 64 + (tid & 7) * 8;
#pragma unroll
      for (int i = 0; i < 4; ++i)
        *(bf16x8*)(Yg + (size_t)i * 32 * 2048) = *(const bf16x8*)(Os + ((tid >> 3) + 32 * i) * 72 + (tid & 7) * 8);
    }
#pragma unroll
    for (int r = 0; r < 16; ++r) {
      float v = ssq[r];
      v += __shfl_xor(v, 1); v += __shfl_xor(v, 2); v += __shfl_xor(v, 4); v += __shfl_xor(v, 8); v += __shfl_xor(v, 16);
      ssq[r] = v;
    }
    if (lr == 0) {
#pragma unroll
      for (int r = 0; r < 16; ++r) {
        int row = gc * 128 + 32 * w + (r & 3) + 8 * (r >> 2) + 4 * lh;
        p.SSQ[(size_t)row * 16 + h] = ssq[r];
      }
    }
  }
}

__device__ void phase_final(const Params& p) {
  const int lane = opq_tid() & 63;
  const int gw = opq_bid() * 4 + (opq_tid() >> 6), nw = gridDim.x * 4;
  for (int row = gw; row < 4 * SEQ; row += nw) {
    float* src = p.out + (size_t)row * D;
    float4 v[4]; float ss = 0.f;
#pragma unroll
    for (int i = 0; i < 4; ++i) {
      v[i] = *(const float4*)(src + (i * 64 + lane) * 4);
      ss += v[i].x * v[i].x + v[i].y * v[i].y + v[i].z * v[i].z + v[i].w * v[i].w;
    }
    ss = wave_sum(ss);
    float rstd = rsqrtf(ss * (1.f / D) + EPS);
#pragma unroll
    for (int i = 0; i < 4; ++i) {
      int k = (i * 64 + lane) * 4;
      float4 w = *(const float4*)(p.final_norm_w + k);
      float4 o = {v[i].x * rstd * w.x, v[i].y * rstd * w.y, v[i].z * rstd * w.z, v[i].w * rstd * w.w};
      *(float4*)(src + k) = o;
    }
  }
}

#ifndef REP_W
#define REP_W 1
#endif
#ifndef REP_GOUT0
#define REP_GOUT0 1
#endif
#ifndef REP_NORM
#define REP_NORM 1
#endif
#ifndef REP_GIN
#define REP_GIN 1
#endif
#ifndef REP_PREP
#define REP_PREP 1
#endif
#ifndef REP_S1
#define REP_S1 1
#endif
#ifndef REP_ATTN
#define REP_ATTN 1
#endif
#ifndef REP_S3
#define REP_S3 1
#endif
__global__ void __launch_bounds__(256, 2) mega(Params p, int lo, int hi) {
  __shared__ __attribute__((aligned(16))) float smem[18432];
  __shared__ uint4 xb_words;
  if (threadIdx.x == 0) xb_words = make_uint4(0u, 0u, 0u, 0u);
  __syncthreads();
  XcdBarrier xb = xcd_barrier_post(p.bar, (volatile LAS unsigned*)&xb_words);
  if (lo < 0) cg::this_grid().sync();
  for (int step = lo; step < hi; ++step) {
    if (step == 0) { for (int rp = 0; rp < REP_W; ++rp) phase_weights(p, smem); }
    else if (step == NSTEP - 1) phase_final(p);
    else {
      int s = step - 1;
      int pass = s / 14, r = s % 14, layer = r / 7, ph = r % 7;
      switch (ph) {
        case ST_NORM: for (int rp = 0; rp < REP_NORM; ++rp) phase_norm(p, layer, pass); break;
        case ST_GIN: for (int rp = 0; rp < REP_GIN; ++rp) phase_gemm_in256(p, layer, pass, (bf16_t*)smem); break;
        case ST_PREP: for (int rp = 0; rp < REP_PREP; ++rp) phase_prep(p, layer, pass, smem); break;
        case ST_MIX:
          for (int rp = 0; rp < REP_S1; ++rp) phase_s1(p, layer, pass);
          for (int rp = 0; rp < REP_ATTN; ++rp) phase_attn(p, layer, pass, (bf16_t*)smem);
          break;
        case ST_S2: phase_s2(p, layer, pass); break;
        case ST_S3: for (int rp = 0; rp < REP_S3; ++rp) phase_s3(p, layer, pass, (bf16_t*)smem); break;
        case ST_GOUT: for (int rp = 0; rp < (layer == 0 ? REP_GOUT0 : 1); ++rp) phase_gemm_mfma(p, 1, layer, pass, (bf16_t*)smem); break;
      }
    }
    if (step + 1 < hi) xcd_barrier(xb);
  }
}

extern "C" void kernel_launch(void* const* d_in, const int* in_sizes, int n_in, void* d_out, int out_size, void* d_ws,
                              size_t ws_size, hipStream_t stream) {
  Params p{};
  p.x = (const float*)d_in[0]; p.c = (const float*)d_in[1]; p.ctx = (const float*)d_in[2]; p.c_ctx = (const float*)d_in[3];
  p.norm_w = (const float*)d_in[4]; p.w_mod = (const float*)d_in[5]; p.b_mod = (const float*)d_in[6];
  p.w_in = (const float*)d_in[7]; p.ssd_conv_w = (const float*)d_in[8]; p.ssd_conv_b = (const float*)d_in[9];
  p.ssd_dt_bias = (const float*)d_in[10]; p.ssd_a_log = (const float*)d_in[11]; p.ssd_d = (const float*)d_in[12];
  p.ssd_norm_w = (const float*)d_in[13]; p.sc_conv_w = (const float*)d_in[14]; p.attn_sink = (const float*)d_in[15];
  p.w_out = (const float*)d_in[16]; p.final_norm_w = (const float*)d_in[17];
  p.out = (float*)d_out;
  char* w = (char*)d_ws; size_t off = 0;
  auto take = [&](size_t bytes) { char* r = w + off; off += (bytes + 255) & ~(size_t)255; return r; };
  p.WinT = (bf16_t*)take((size_t)2 * NWIN * 1024 * 2);
  p.WoutT = (bf16_t*)take((size_t)2 * 1024 * 2048 * 2);
  p.MOD = (float*)take((size_t)2 * 5 * 3072 * 4);
  p.CTX1 = (float*)take((size_t)4 * CTXL * D * 4);
  p.ROPE = (float*)take((size_t)64 * 16 * 2 * 4);
  char* big = take((size_t)NT * (1024 + 1536 + 2048) * 2);
  p.H = (bf16_t*)big;
  p.PXBC = (bf16_t*)(big + (size_t)NT * 1024 * 2);
  p.PSC = (bf16_t*)(big + (size_t)NT * (1024 + 1536) * 2);
  p.LST = (float*)big;
  p.PART = (float*)(big + (size_t)24 * 1024 * 1024);
  p.PZ = (bf16_t*)take((size_t)NT * 1024 * 2);
  p.PATT = (bf16_t*)take((size_t)NT * 1280 * 2);
  p.QR = (bf16_t*)take((size_t)NT * 512 * 2);
  p.KR = (bf16_t*)take((size_t)NT * 128 * 2);
  p.VT = (bf16_t*)take((size_t)NT * 128 * 2);
  p.SIN = p.PATT;
  p.DTRAW = (float*)take((size_t)NT * 32 * 4);
  p.CUMT = (float*)take((size_t)NT * 32 * 4);
  p.VV = (float*)take((size_t)NT * 32 * 4);
  p.EC = (float*)take((size_t)NT * 32 * 4);
  p.WW = (float*)take((size_t)NT * 32 * 4);
  p.SSQ = (float*)take((size_t)NT * 16 * 4);
  p.XT = (bf16_t*)take((size_t)NT * 1024 * 2);
  p.BR = (bf16_t*)take((size_t)NT * 256 * 2);
  p.CR = (bf16_t*)take((size_t)NT * 256 * 2);
  p.BT = (bf16_t*)take((size_t)NT * 256 * 2);
  p.Y = (bf16_t*)take((size_t)NT * 2048 * 2);
  p.bar = (unsigned*)take((size_t)XCD_BAR_WORDS * 4);
  if (off > ws_size) { fprintf(stderr, "workspace too small: need %zu have %zu\n", off, ws_size); return; }
  static int grid_blocks = 0;
  if (!grid_blocks) {
    int dev = 0, cus = 0, per_cu = 0;
    hipGetDevice(&dev);
    hipDeviceGetAttribute(&cus, hipDeviceAttributeMultiprocessorCount, dev);
    hipOccupancyMaxActiveBlocksPerMultiprocessor(&per_cu, mega, 256, 0);
    if (per_cu > 2) per_cu = 2;
    if (per_cu < 1) per_cu = 1;
    grid_blocks = cus * per_cu;
  }
  hipMemsetAsync(p.bar, 0, (size_t)XCD_BAR_WORDS * 4, stream);
  int lo = 0, hi = NSTEP;
  void* args[] = {&p, &lo, &hi};
  hipError_t e = hipLaunchCooperativeKernel((void*)mega, dim3(grid_blocks), dim3(256), args, 0, stream);
  if (e != hipSuccess) fprintf(stderr, "cooperative launch failed: %s (grid %d)\n", hipGetErrorString(e), grid_blocks);
}
```

```cpp
#include <hip/hip_runtime.h>
#include <hip/hip_cooperative_groups.h>
#include <cstdio>
#include <type_traits>
namespace cg = cooperative_groups;

typedef unsigned short bf16_t;
typedef __attribute__((ext_vector_type(8))) short bf16x8;
typedef __attribute__((ext_vector_type(4))) short bf16x4;
typedef __attribute__((ext_vector_type(4))) float f32x4;
typedef __attribute__((ext_vector_type(16))) float f32x16;

constexpr int D = 1024, SEQ = 4096, CTXL = 256;
constexpr int NB = 2;
constexpr int NPASS = 2;
constexpr int NTL = NB * SEQ;
constexpr int NTC = NB * CTXL;
constexpr int NT = NTL + NTC;
constexpr int NCH = NT / 128;
constexpr int NWIN = 6016;
constexpr float EPS = 1e-6f;

constexpr int ST_NORM = 0, ST_GIN = 1, ST_PREP = 2, ST_MIX = 3, ST_S2 = 4, ST_S3 = 5, ST_GOUT = 6;
constexpr int NSTEP = 1 + NPASS * 2 * 7 + 1;

struct Params {
  const float *x, *c, *ctx, *c_ctx, *norm_w, *w_mod, *b_mod, *w_in, *ssd_conv_w, *ssd_conv_b, *ssd_dt_bias,
      *ssd_a_log, *ssd_d, *ssd_norm_w, *sc_conv_w, *attn_sink, *w_out, *final_norm_w;
  float* out;
  bf16_t *WinT, *WoutT, *H, *PXBC, *PSC, *PZ, *PATT, *XT, *BR, *CR, *BT, *QR, *KR, *VT, *Y, *SIN;
  float *MOD, *CTX1, *DTRAW, *CUMT, *VV, *EC, *WW, *SSQ, *LST, *ROPE, *PART;
  unsigned* bar;
};

__device__ __forceinline__ int opq_tid() { int t = threadIdx.x; asm volatile("" : "+v"(t)); return t; }
__device__ __forceinline__ int opq_bid() { int b = blockIdx.x; asm volatile("" : "+s"(b)); return b; }
typedef __attribute__((ext_vector_type(2))) __bf16 bfv2;
typedef __attribute__((ext_vector_type(2))) float f32x2;
typedef __attribute__((ext_vector_type(4))) unsigned u32x4;
__device__ __forceinline__ unsigned pk2(float a, float b) {
  f32x2 v = {a, b};
  bfv2 r = __builtin_convertvector(v, bfv2);
  return *(unsigned*)&r;
}
__device__ __forceinline__ bf16_t f2bf(float f) { return (bf16_t)(pk2(f, 0.f) & 0xffffu); }
__device__ __forceinline__ bf16x8 pack8(f32x4 a, f32x4 b) {
  u32x4 u = {pk2(a[0], a[1]), pk2(a[2], a[3]), pk2(b[0], b[1]), pk2(b[2], b[3])};
  return *(bf16x8*)&u;
}
__device__ __forceinline__ float bf2f(bf16_t h) { return __uint_as_float(((unsigned)h) << 16); }
__device__ __forceinline__ float silu_f(float v) { return v * __builtin_amdgcn_rcpf(1.f + __expf(-v)); }
__device__ __forceinline__ float wave_sum(float v) {
#pragma unroll
  for (int o = 32; o > 0; o >>= 1) v += __shfl_xor(v, o);
  return v;
}

#define XB_TMO      128
#define XB_XCNT(j)  (256  + 64 * (j))
#define XB_XSUB(j)  (1280 + 64 * (j))
#define XB_XGEN(j)  (2304 + 64 * (j))
#define XB_TOP      3328
#define XB_TOPGEN   3392
#define XCD_BAR_WORDS 3456
#define XB_SPIN_CAP (1u << 18)
#define LAS __attribute__((address_space(3)))

__device__ __forceinline__ unsigned xb_ld(unsigned* p)              { return __hip_atomic_load(p, __ATOMIC_RELAXED, __HIP_MEMORY_SCOPE_AGENT); }
__device__ __forceinline__ unsigned xb_add(unsigned* p, unsigned v) { return __hip_atomic_fetch_add(p, v, __ATOMIC_RELAXED, __HIP_MEMORY_SCOPE_AGENT); }
__device__ __forceinline__ unsigned xb_xcc_id() { return (unsigned)__builtin_amdgcn_s_getreg((3 << 11) | 20) & 0xFu; }
#define XB_SPIN(cond, bar) do { unsigned _sp = 0; while (cond) { __builtin_amdgcn_s_sleep(1); \
    if ((++_sp & 255u) == 0u) { if (xb_ld(&(bar)[XB_TMO])) break; if (_sp > XB_SPIN_CAP) { atomicAdd(&(bar)[XB_TMO], 1u); break; } } } } while (0)

struct XcdBarrier {
    unsigned* bar; unsigned x;
    volatile LAS unsigned* st;
};

__device__ __forceinline__ XcdBarrier xcd_barrier_post(unsigned* bar, volatile LAS unsigned* st) {
    XcdBarrier b; b.bar = bar; b.x = xb_xcc_id(); b.st = st;
    if (threadIdx.x == 0) (void)xb_add(&bar[XB_XCNT(b.x)], 1u);
    return b;
}
__device__ __forceinline__ void xcd_barrier_complete(unsigned* bar, unsigned x, unsigned& nloc, unsigned& nx) {
    const unsigned G = gridDim.x * gridDim.y * gridDim.z;
    unsigned sum, cnt, mine, sp = 0u;
    for (;;) {
        sum = 0u; cnt = 0u; mine = 0u;
#pragma unroll
        for (unsigned j = 0; j < 16; ++j) { const unsigned c = xb_ld(&bar[XB_XCNT(j)]); sum += c; cnt += (c > 0u) ? 1u : 0u; mine = (j == x) ? c : mine; }
        if (sum == G) break;
        __builtin_amdgcn_s_sleep(1);
        if ((++sp & 255u) == 0u) { if (xb_ld(&bar[XB_TMO])) break; if (sp > XB_SPIN_CAP) { atomicAdd(&bar[XB_TMO], 1u); break; } }
    }
    nloc = mine > 0u ? mine : 1u; nx = cnt > 0u ? cnt : 1u;
}

__device__ __forceinline__ void xcd_barrier(const XcdBarrier& b) {
    asm volatile("s_waitcnt vmcnt(0)" ::: "memory");
    __syncthreads();
    if (threadIdx.x == 0) {
        unsigned* bar = b.bar;
        __builtin_amdgcn_s_waitcnt(0);
        unsigned nloc = b.st[0], nx = b.st[1];
        if (nloc == 0u) { xcd_barrier_complete(bar, b.x, nloc, nx); b.st[0] = nloc; b.st[1] = nx; }
        const unsigned old = xb_add(&bar[XB_XSUB(b.x)], 1u);
        const unsigned gen = old / nloc;
        if (old + 1u == (gen + 1u) * nloc) {
            __builtin_amdgcn_fence(__ATOMIC_RELEASE, "agent");
            asm volatile("s_waitcnt vmcnt(0)" ::: "memory");
            const unsigned og = xb_add(&bar[XB_TOP], 1u);
            const unsigned tg = og / nx;
            if (og + 1u == (tg + 1u) * nx) xb_add(&bar[XB_TOPGEN], 1u);
            else XB_SPIN(xb_ld(&bar[XB_TOPGEN]) == tg, bar);
            __builtin_amdgcn_fence(__ATOMIC_ACQUIRE, "agent");
            xb_add(&bar[XB_XGEN(b.x)], 1u);
            asm volatile("s_waitcnt vmcnt(0)" ::: "memory");
        } else {
            XB_SPIN(xb_ld(&bar[XB_XGEN(b.x)]) == gen, bar);
            __builtin_amdgcn_fence(__ATOMIC_ACQUIRE, "agent");
            asm volatile("s_waitcnt vmcnt(0)" ::: "memory");
        }
    }
    __syncthreads();
}


__device__ void phase_weights(const Params& p, float* smem) {
  const int tid = opq_tid();
  const int NW1 = 2 * 94 * 16, NW2 = 2 * 16 * 32, NM = 192;
  for (int it = opq_bid(); it < NW1 + NW2 + NM; it += gridDim.x) {
    if (it < NW1) {
      int l = it / (94 * 16), r = it % (94 * 16), nt = r / 16, kt = r % 16;
      for (int e = tid; e < 4096; e += 256) {
        int kk = e >> 6, nn = e & 63;
        int n = nt * 64 + nn;
        int oc = (n < 2560) ? n : (n < 5888 ? n + 32 : (n < 5920 ? n - 5888 + 2560 : -1));
        float v = 0.f;
        if (oc >= 0) v = p.w_in[((size_t)l * 1024 + kt * 64 + kk) * 5920 + oc];
        smem[kk * 65 + nn] = v;
      }
      __syncthreads();
      for (int e = tid; e < 4096; e += 256) {
        int nn = e >> 6, kk = e & 63;
        p.WinT[((size_t)l * NWIN + nt * 64 + nn) * 1024 + kt * 64 + kk] = f2bf(smem[kk * 65 + nn]);
      }
      __syncthreads();
    } else if (it < NW1 + NW2) {
      int i2 = it - NW1;
      int l = i2 / 512, r = i2 % 512, nt = r / 32, kt = r % 32;
      for (int e = tid; e < 4096; e += 256) {
        int kk = e >> 6, nn = e & 63;
        int k = kt * 64 + kk;
        float v = p.w_out[((size_t)l * 2048 + k) * 1024 + nt * 64 + nn];
        if (k < 1024) v *= p.ssd_norm_w[l * 1024 + k];
        smem[kk * 65 + nn] = v;
      }
      __syncthreads();
      for (int e = tid; e < 4096; e += 256) {
        int nn = e >> 6, kk = e & 63;
        p.WoutT[((size_t)l * 1024 + nt * 64 + nn) * 2048 + kt * 64 + kk] = f2bf(smem[kk * 65 + nn]);
      }
      __syncthreads();
    } else {
      int i3 = it - NW1 - NW2;
      int l = i3 / 96, jb = i3 % 96;
      float* sc = smem;
      float* part = smem + 5120;
      for (int e = tid; e < 5120; e += 256) {
        int r = e >> 10, k = e & 1023;
        float v = (r < 4) ? p.c[r * 1024 + k] : p.c_ctx[k];
        sc[e] = silu_f(v);
      }
      __syncthreads();
      int col = tid & 31, kg = tid >> 5;
      float a0 = 0, a1 = 0, a2 = 0, a3 = 0, a4 = 0;
      const float* wp = p.w_mod + ((size_t)l * 1024 + kg * 128) * 3072 + jb * 32 + col;
      for (int k0 = 0; k0 < 128; k0 += 16) {
        float wv[16];
#pragma unroll
        for (int j = 0; j < 16; ++j) wv[j] = wp[(size_t)(k0 + j) * 3072];
#pragma unroll
        for (int j = 0; j < 16; ++j) {
          int k = kg * 128 + k0 + j;
          a0 += sc[k] * wv[j]; a1 += sc[1024 + k] * wv[j]; a2 += sc[2048 + k] * wv[j]; a3 += sc[3072 + k] * wv[j]; a4 += sc[4096 + k] * wv[j];
        }
      }
      part[(kg * 5 + 0) * 32 + col] = a0; part[(kg * 5 + 1) * 32 + col] = a1; part[(kg * 5 + 2) * 32 + col] = a2;
      part[(kg * 5 + 3) * 32 + col] = a3; part[(kg * 5 + 4) * 32 + col] = a4;
      __syncthreads();
      if (tid < 160) {
        int r = tid >> 5, cc = tid & 31;
        float s = 0.f;
#pragma unroll
        for (int g8 = 0; g8 < 8; ++g8) s += part[(g8 * 5 + r) * 32 + cc];
        p.MOD[((size_t)l * 5 + r) * 3072 + jb * 32 + cc] = s + p.b_mod[l * 3072 + jb * 32 + cc];
      }
      if (i3 == 0) {
        for (int e = tid; e < 1024; e += 256) {
          int pos = e >> 4, i = e & 15;
          float inv = powf(10000.f, -(float)i * (1.f / 16.f));
          float ang = (float)pos * inv;
          p.ROPE[2 * e] = cosf(ang); p.ROPE[2 * e + 1] = sinf(ang);
        }
      }
      __syncthreads();
    }
  }
}

__device__ void phase_norm(const Params& p, int layer, int pass) {
  const int lane = opq_tid() & 63;
  const int gw = opq_bid() * 4 + (opq_tid() >> 6), nw = gridDim.x * 4;
  const int b0 = pass * NB;
  for (int row = gw; row < NT; row += nw) {
    const float* src; int mrow;
    if (row < NTL) { src = (layer == 0 ? p.x : p.out) + ((size_t)b0 * SEQ + row) * D; mrow = b0 + row / SEQ; }
    else { src = (layer == 0 ? p.ctx : p.CTX1) + ((size_t)b0 * CTXL + (row - NTL)) * D; mrow = 4; }
    const float* mod = p.MOD + ((size_t)layer * 5 + mrow) * 3072;
    float4 v[4]; float ss = 0.f;
    const bool from_parts = (layer == 1 && row >= NTL);
    if (from_parts) src = p.ctx + ((size_t)b0 * CTXL + (row - NTL)) * D;
#pragma unroll
    for (int i = 0; i < 4; ++i) {
      v[i] = *(const float4*)(src + (i * 64 + lane) * 4);
      if (from_parts) {
        int k = (i * 64 + lane) * 4;
        float4 a = {0.f, 0.f, 0.f, 0.f};
#pragma unroll
        for (int ks = 0; ks < 8; ++ks) {
          float4 q = *(const float4*)(p.PART + ((size_t)ks * NTC + (row - NTL)) * D + k);
          a.x += q.x; a.y += q.y; a.z += q.z; a.w += q.w;
        }
        float4 gt = *(const float4*)(p.MOD + ((size_t)0 * 5 + 4) * 3072 + 2048 + k);
        v[i].x += gt.x * a.x; v[i].y += gt.y * a.y; v[i].z += gt.z * a.z; v[i].w += gt.w * a.w;
      }
      ss += v[i].x * v[i].x + v[i].y * v[i].y + v[i].z * v[i].z + v[i].w * v[i].w;
    }
    ss = wave_sum(ss);
    float rstd = rsqrtf(ss * (1.f / D) + EPS);
#pragma unroll
    for (int i = 0; i < 4; ++i) {
      int k = (i * 64 + lane) * 4;
      float4 nwv = *(const float4*)(p.norm_w + layer * D + k);
      float4 sh = *(const float4*)(mod + k);
      float4 scl = *(const float4*)(mod + 1024 + k);
      bf16x4 o;
      o[0] = (short)f2bf(v[i].x * rstd * nwv.x * (1.f + scl.x) + sh.x);
      o[1] = (short)f2bf(v[i].y * rstd * nwv.y * (1.f + scl.y) + sh.y);
      o[2] = (short)f2bf(v[i].z * rstd * nwv.z * (1.f + scl.z) + sh.z);
      o[3] = (short)f2bf(v[i].w * rstd * nwv.w * (1.f + scl.w) + sh.w);
      *(bf16x4*)(p.H + (size_t)row * D + k) = o;
    }
  }
}

__device__ __forceinline__ void epi_store(const Params& p, int mode, int layer, int pass, int m, int n, float v) {
  if (mode == 0) {
    if (n < 1024) p.PZ[(size_t)m * 1024 + n] = f2bf(v);
    else if (n < 2560) p.PXBC[(size_t)m * 1536 + (n - 1024)] = f2bf(v);
    else if (n < 4608) p.PSC[(size_t)m * 2048 + (n - 2560)] = f2bf(v);
    else if (n < 5888) p.PATT[(size_t)m * 1280 + (n - 4608)] = f2bf(v);
    else if (n < 5920) p.DTRAW[(size_t)m * 32 + (n - 5888)] = v;
  } else {
    const int b0 = pass * NB;
    if (m < NTL) {
      int b = b0 + m / SEQ;
      float g = p.MOD[((size_t)layer * 5 + b) * 3072 + 2048 + n];
      size_t idx = ((size_t)b0 * SEQ + m) * D + n;
      float xo = (layer == 0) ? p.x[idx] : p.out[idx];
      p.out[idx] = xo + g * v;
    } else {
      float g = p.MOD[((size_t)layer * 5 + 4) * 3072 + 2048 + n];
      size_t idx = ((size_t)b0 * CTXL + (m - NTL)) * D + n;
      p.CTX1[idx] = p.ctx[idx] + g * v;
    }
  }
}

__device__ void phase_gemm_naive(const Params& p, int mode, int layer, int pass, float* smem) {
  const int M = (mode == 0) ? NT : (layer == 0 ? NT : NTL);
  const int N = (mode == 0) ? NWIN : 1024;
  const int K = (mode == 0) ? 1024 : 2048;
  const bf16_t* A = (mode == 0) ? p.H : p.Y;
  const bf16_t* Bt = (mode == 0) ? p.WinT + (size_t)layer * NWIN * 1024 : p.WoutT + (size_t)layer * 1024 * 2048;
  const int tm = M / 64, tn = N / 64;
  const int tid = opq_tid(), tx = tid & 15, ty = tid >> 4;
  float* As = smem;
  float* Bs = smem + 16 * 68;
  for (int t = opq_bid(); t < tm * tn; t += gridDim.x) {
    int m0 = (t / tn) * 64, n0 = (t % tn) * 64;
    float acc[4][4];
#pragma unroll
    for (int i = 0; i < 4; ++i)
#pragma unroll
      for (int j = 0; j < 4; ++j) acc[i][j] = 0.f;
    int lr = tid >> 2, kq = (tid & 3) * 4;
    for (int k0 = 0; k0 < K; k0 += 16) {
      bf16x4 av = *(const bf16x4*)(A + (size_t)(m0 + lr) * K + k0 + kq);
      bf16x4 bv = *(const bf16x4*)(Bt + (size_t)(n0 + lr) * K + k0 + kq);
#pragma unroll
      for (int j = 0; j < 4; ++j) {
        As[(kq + j) * 68 + lr] = bf2f((bf16_t)av[j]);
        Bs[(kq + j) * 68 + lr] = bf2f((bf16_t)bv[j]);
      }
      __syncthreads();
#pragma unroll
      for (int kk = 0; kk < 16; ++kk) {
        float4 a4 = *(const float4*)(As + kk * 68 + ty * 4);
        float4 b4 = *(const float4*)(Bs + kk * 68 + tx * 4);
        float a[4] = {a4.x, a4.y, a4.z, a4.w}, b[4] = {b4.x, b4.y, b4.z, b4.w};
#pragma unroll
        for (int i = 0; i < 4; ++i)
#pragma unroll
          for (int j = 0; j < 4; ++j) acc[i][j] += a[i] * b[j];
      }
      __syncthreads();
    }
#pragma unroll
    for (int i = 0; i < 4; ++i)
#pragma unroll
      for (int j = 0; j < 4; ++j) epi_store(p, mode, layer, pass, m0 + ty * 4 + i, n0 + tx * 4 + j, acc[i][j]);
  }
}

__device__ void phase_gemm_mfma(const Params& p, int mode, int layer, int pass, bf16_t* smem) {
  const bool do_split = (mode == 1 && layer == 0);
  const bool ctx_sparse = (mode == 0 && layer == 1);
  const int M = (mode == 0 && !ctx_sparse) ? NT : NTL;
  const int N = (mode == 0) ? NWIN : 1024;
  const int K = (mode == 0) ? 1024 : 2048;
  const bf16_t* A = (mode == 0) ? p.H : p.Y;
  const bf16_t* Bt = (mode == 0) ? p.WinT + (size_t)layer * NWIN * 1024 : p.WoutT + (size_t)layer * 1024 * 2048;
  const int tm = M / 128, tn = N / 128, T_main = tm * tn, T = T_main + (ctx_sparse ? 60 : 0);
  const int tid = opq_tid(), lane = tid & 63, wid = tid >> 6, wm = wid >> 1, wn = wid & 1;
  const int lr = lane & 31, lh = lane >> 5;
  bf16_t* As = smem;
  bf16_t* Bs = smem + 128 * 72;
  float* rsS = (float*)(smem + 2 * 128 * 72);
  const int bid = opq_bid();
  int tstart = 0, tend = T, lb = bid, nbx = gridDim.x;
  if ((gridDim.x & 7) == 0) {
    int xcd = bid & 7; lb = bid >> 3; nbx = gridDim.x >> 3;
    tstart = (int)((long)T * xcd / 8); tend = (int)((long)T * (xcd + 1) / 8);
  }
  const int ng_full = tn / 8, rem = tn % 8, per_group = tm * 8;
  const int nk = K / 64;
  const int sr = tid >> 3, sc = (tid & 7) * 8;
  const int b0 = pass * NB;
  auto tile = [&](const int mi, const int ni, auto split_tag, const int ks) __attribute__((always_inline)) {
    constexpr bool SPLIT = decltype(split_tag)::value;
    const int kt0 = SPLIT ? ks * 4 : 0;
    const int kt1 = SPLIT ? kt0 + 4 : nk;
    const int m0 = mi * 128, n0 = ni * 128;
    f32x16 acc[2][2];
#pragma unroll
    for (int i = 0; i < 2; ++i)
#pragma unroll
      for (int j = 0; j < 2; ++j)
#pragma unroll
        for (int r = 0; r < 16; ++r) acc[i][j][r] = 0.f;
    const bf16_t* ga = A + (size_t)(m0 + sr) * K + sc + kt0 * 64;
    const bf16_t* gb = Bt + (size_t)(n0 + sr) * K + sc + kt0 * 64;
    bf16x8 ra[4], rb[4];
#pragma unroll
    for (int i = 0; i < 4; ++i) { ra[i] = *(const bf16x8*)(ga + (size_t)i * 32 * K); rb[i] = *(const bf16x8*)(gb + (size_t)i * 32 * K); }
    if (mode == 1) {
      int row = m0 + (tid >> 1), grp = tid & 1;
      const float* sp = p.SSQ + (size_t)row * 16 + grp * 8;
      f32x4 s0 = *(const f32x4*)sp, s1 = *(const f32x4*)(sp + 4);
      float ss = s0[0] + s0[1] + s0[2] + s0[3] + s1[0] + s1[1] + s1[2] + s1[3];
      rsS[tid] = rsqrtf(ss * (1.f / 512.f) + EPS);
    }
    if (mode == 1 && !SPLIT) {
      bf16x8 ra2[4], rb2[4];
#pragma unroll
      for (int i = 0; i < 4; ++i) {
        ra2[i] = *(const bf16x8*)(ga + (size_t)i * 32 * K + 64);
        rb2[i] = *(const bf16x8*)(gb + (size_t)i * 32 * K + 64);
      }
      auto mma4 = [&]() __attribute__((always_inline)) {
#pragma unroll
        for (int kk = 0; kk < 4; ++kk) {
          bf16x8 a0 = *(const bf16x8*)(As + (wm * 64 + lr) * 72 + kk * 16 + lh * 8);
          bf16x8 a1 = *(const bf16x8*)(As + (wm * 64 + 32 + lr) * 72 + kk * 16 + lh * 8);
          bf16x8 b0v = *(const bf16x8*)(Bs + (wn * 64 + lr) * 72 + kk * 16 + lh * 8);
          bf16x8 b1v = *(const bf16x8*)(Bs + (wn * 64 + 32 + lr) * 72 + kk * 16 + lh * 8);
          acc[0][0] = __builtin_amdgcn_mfma_f32_32x32x16_bf16(a0, b0v, acc[0][0], 0, 0, 0);
          acc[0][1] = __builtin_amdgcn_mfma_f32_32x32x16_bf16(a0, b1v, acc[0][1], 0, 0, 0);
          acc[1][0] = __builtin_amdgcn_mfma_f32_32x32x16_bf16(a1, b0v, acc[1][0], 0, 0, 0);
          acc[1][1] = __builtin_amdgcn_mfma_f32_32x32x16_bf16(a1, b1v, acc[1][1], 0, 0, 0);
        }
      };
      for (int kt = 0; kt < 32; kt += 2) {
        __syncthreads();
#pragma unroll
        for (int i = 0; i < 4; ++i) {
          *(bf16x8*)(As + (sr + i * 32) * 72 + sc) = ra[i];
          *(bf16x8*)(Bs + (sr + i * 32) * 72 + sc) = rb[i];
        }
        __syncthreads();
        if (kt + 2 < 32) {
#pragma unroll
          for (int i = 0; i < 4; ++i) {
            ra[i] = *(const bf16x8*)(ga + (size_t)i * 32 * K + (kt + 2) * 64);
            rb[i] = *(const bf16x8*)(gb + (size_t)i * 32 * K + (kt + 2) * 64);
          }
        }
        mma4();
        __syncthreads();
#pragma unroll
        for (int i = 0; i < 4; ++i) {
          *(bf16x8*)(As + (sr + i * 32) * 72 + sc) = ra2[i];
          *(bf16x8*)(Bs + (sr + i * 32) * 72 + sc) = rb2[i];
        }
        __syncthreads();
        if (kt + 3 < 32) {
#pragma unroll
          for (int i = 0; i < 4; ++i) {
            ra2[i] = *(const bf16x8*)(ga + (size_t)i * 32 * K + (kt + 3) * 64);
            rb2[i] = *(const bf16x8*)(gb + (size_t)i * 32 * K + (kt + 3) * 64);
          }
        }
        mma4();
        if (kt == 6 || kt == 14) {
#pragma unroll
          for (int i = 0; i < 2; ++i)
#pragma unroll
            for (int r = 0; r < 16; ++r) {
              int lrow = wm * 64 + i * 32 + (r & 3) + 8 * (r >> 2) + 4 * lh;
              float r0 = rsS[lrow * 2], r1 = rsS[lrow * 2 + 1];
              float f = (kt == 6) ? r0 * __builtin_amdgcn_rcpf(r1) : r1;
              acc[i][0][r] *= f; acc[i][1][r] *= f;
            }
        }
      }
    } else
    for (int kt = kt0; kt < kt1; ++kt) {
      __syncthreads();
#pragma unroll
      for (int i = 0; i < 4; ++i) {
        *(bf16x8*)(As + (sr + i * 32) * 72 + sc) = ra[i];
        *(bf16x8*)(Bs + (sr + i * 32) * 72 + sc) = rb[i];
      }
      __syncthreads();
      if (kt + 1 < kt1) {
#pragma unroll
        for (int i = 0; i < 4; ++i) {
          ra[i] = *(const bf16x8*)(ga + (size_t)i * 32 * K + (kt + 1 - kt0) * 64);
          rb[i] = *(const bf16x8*)(gb + (size_t)i * 32 * K + (kt + 1 - kt0) * 64);
        }
      }
#pragma unroll
      for (int kk = 0; kk < 4; ++kk) {
        bf16x8 a0 = *(const bf16x8*)(As + (wm * 64 + lr) * 72 + kk * 16 + lh * 8);
        bf16x8 a1 = *(const bf16x8*)(As + (wm * 64 + 32 + lr) * 72 + kk * 16 + lh * 8);
        bf16x8 b0v = *(const bf16x8*)(Bs + (wn * 64 + lr) * 72 + kk * 16 + lh * 8);
        bf16x8 b1v = *(const bf16x8*)(Bs + (wn * 64 + 32 + lr) * 72 + kk * 16 + lh * 8);
        acc[0][0] = __builtin_amdgcn_mfma_f32_32x32x16_bf16(a0, b0v, acc[0][0], 0, 0, 0);
        acc[0][1] = __builtin_amdgcn_mfma_f32_32x32x16_bf16(a0, b1v, acc[0][1], 0, 0, 0);
        acc[1][0] = __builtin_amdgcn_mfma_f32_32x32x16_bf16(a1, b0v, acc[1][0], 0, 0, 0);
        acc[1][1] = __builtin_amdgcn_mfma_f32_32x32x16_bf16(a1, b1v, acc[1][1], 0, 0, 0);
      }
      if (mode == 1 && !SPLIT && (kt == 7 || kt == 15)) {
#pragma unroll
        for (int i = 0; i < 2; ++i)
#pragma unroll
          for (int r = 0; r < 16; ++r) {
            int lrow = wm * 64 + i * 32 + (r & 3) + 8 * (r >> 2) + 4 * lh;
            float r0 = rsS[lrow * 2], r1 = rsS[lrow * 2 + 1];
            float f = (kt == 7) ? r0 * __builtin_amdgcn_rcpf(r1) : r1;
            acc[i][0][r] *= f; acc[i][1][r] *= f;
          }
      }
    }
    if (mode == 0) {
      if (ni < 46) {
        bf16_t* dst; int ld, cb;
        if (ni < 8) { dst = p.PZ; ld = 1024; cb = ni * 128; }
        else if (ni < 20) { dst = p.PXBC; ld = 1536; cb = (ni - 8) * 128; }
        else if (ni < 36) { dst = p.PSC; ld = 2048; cb = (ni - 20) * 128; }
        else { dst = p.PATT; ld = 1280; cb = (ni - 36) * 128; }
#pragma unroll
        for (int i = 0; i < 2; ++i)
#pragma unroll
          for (int j = 0; j < 2; ++j)
#pragma unroll
            for (int r = 0; r < 16; ++r) {
              int row = m0 + wm * 64 + i * 32 + (r & 3) + 8 * (r >> 2) + 4 * lh;
              int col = cb + wn * 64 + j * 32 + lr;
              dst[(size_t)row * ld + col] = f2bf(acc[i][j][r]);
            }
      } else if (wn == 0) {
#pragma unroll
        for (int i = 0; i < 2; ++i)
#pragma unroll
          for (int r = 0; r < 16; ++r) {
            int row = m0 + wm * 64 + i * 32 + (r & 3) + 8 * (r >> 2) + 4 * lh;
            p.DTRAW[(size_t)row * 32 + lr] = acc[i][0][r];
          }
      }
    } else if (!SPLIT) {
      float* Os = (float*)smem;
      const int ocol4 = (tid & 31) * 4, orow = tid >> 5;
      const int b = b0 + m0 / SEQ;
      const float4 g4 = *(const float4*)(p.MOD + ((size_t)layer * 5 + b) * 3072 + 2048 + n0 + ocol4);
      __syncthreads();
#pragma unroll
      for (int half = 0; half < 2; ++half) {
        if (wm == half) {
#pragma unroll
          for (int i = 0; i < 2; ++i)
#pragma unroll
            for (int j = 0; j < 2; ++j)
#pragma unroll
              for (int r = 0; r < 16; ++r)
                Os[(i * 32 + (r & 3) + 8 * (r >> 2) + 4 * lh) * 132 + wn * 64 + j * 32 + lr] = acc[i][j][r];
        }
        __syncthreads();
#pragma unroll 4
        for (int k = 0; k < 8; ++k) {
          int row = orow + 8 * k;
          float4 v = *(const float4*)(Os + row * 132 + ocol4);
          size_t idx = ((size_t)b0 * SEQ + m0 + half * 64 + row) * D + n0 + ocol4;
          float4 x4 = (layer == 0) ? *(const float4*)(p.x + idx) : *(const float4*)(p.out + idx);
          float4 o = {x4.x + g4.x * v.x, x4.y + g4.y * v.y, x4.z + g4.z * v.z, x4.w + g4.w * v.w};
          *(float4*)(p.out + idx) = o;
        }
        __syncthreads();
      }
    } else {
#pragma unroll
      for (int i = 0; i < 2; ++i)
#pragma unroll
        for (int j = 0; j < 2; ++j)
#pragma unroll
          for (int r = 0; r < 16; ++r) {
            int row = m0 + wm * 64 + i * 32 + (r & 3) + 8 * (r >> 2) + 4 * lh;
            int col = n0 + wn * 64 + j * 32 + lr;
            int lrow = row - m0;
            float f = (ks < 4) ? rsS[lrow * 2 + (ks >> 1)] : 1.f;
            p.PART[((size_t)ks * NTC + (row - NTL)) * D + col] = acc[i][j][r] * f;
          }
    }
  };
  for (int t = tstart + lb; t < tend; t += nbx) {
    int mi, ni;
    if (t >= T_main) { int e = t - T_main, j = e % 15; mi = 64 + e / 15; ni = (j < 12) ? 8 + j : ((j < 14) ? 28 + j : 46); }
    else if (t < ng_full * per_group) { int ng = t / per_group, r = t % per_group; mi = r >> 3; ni = ng * 8 + (r & 7); }
    else { int r = t - ng_full * per_group; mi = r / rem; ni = ng_full * 8 + r % rem; }
    tile(mi, ni, std::integral_constant<bool, false>{}, -1);
  }
  if (do_split) {
    for (int s = bid; s < 256; s += gridDim.x) {
      int ct = s >> 3, ks = s & 7;
      tile(64 + (ct >> 3), ct & 7, std::integral_constant<bool, true>{}, ks);
    }
  }
}

__device__ void phase_gemm_in256(const Params& p, int layer, int pass, bf16_t* smem) {
  constexpr int K = 1024, nk = 16;
  const bf16_t* A = p.H;
  const bf16_t* Bt = p.WinT + (size_t)layer * NWIN * 1024;
  const bool ctx_sparse = (layer == 1);
  const int tm = (ctx_sparse ? NTL : NT) / 256, tn = NWIN / 128, T_main = tm * tn, T = T_main + (ctx_sparse ? 30 : 0);
  const int tid = opq_tid(), lane = tid & 63, wid = tid >> 6, wm = wid >> 1, wn = wid & 1;
  const int lr = lane & 31, lh = lane >> 5;
  bf16_t* As = smem;
  bf16_t* Bs = smem + 256 * 72;
  const int bid = opq_bid();
  int tstart = 0, tend = T, lb = bid, nbx = gridDim.x;
  if ((gridDim.x & 7) == 0) {
    int xcd = bid & 7; lb = bid >> 3; nbx = gridDim.x >> 3;
    tstart = (int)((long)T * xcd / 8); tend = (int)((long)T * (xcd + 1) / 8);
  }
  const int ng_full = tn / 8, rem = tn % 8, per_group = tm * 8;
  const int sr = tid >> 3, sc = (tid & 7) * 8;
  for (int t = tstart + lb; t < tend; t += nbx) {
    int mi, ni;
    if (t >= T_main) { int e = t - T_main, j = e % 15; mi = 32 + e / 15; ni = (j < 12) ? 8 + j : ((j < 14) ? 28 + j : 46); }
    else if (t < ng_full * per_group) { int ng = t / per_group, r = t % per_group; mi = r >> 3; ni = ng * 8 + (r & 7); }
    else { int r = t - ng_full * per_group; mi = r / rem; ni = ng_full * 8 + r % rem; }
    const int m0 = mi * 256, n0 = ni * 128;
    f32x16 acc[4][2];
#pragma unroll
    for (int i = 0; i < 4; ++i)
#pragma unroll
      for (int j = 0; j < 2; ++j)
#pragma unroll
        for (int r = 0; r < 16; ++r) acc[i][j][r] = 0.f;
    const bf16_t* ga = A + (size_t)(m0 + sr) * K + sc;
    const bf16_t* gb = Bt + (size_t)(n0 + sr) * K + sc;
    bf16x8 ra[8], rb[4];
#pragma unroll
    for (int i = 0; i < 8; ++i) ra[i] = *(const bf16x8*)(ga + (size_t)i * 32 * K);
#pragma unroll
    for (int i = 0; i < 4; ++i) rb[i] = *(const bf16x8*)(gb + (size_t)i * 32 * K);
    for (int kt = 0; kt < nk; ++kt) {
      __syncthreads();
#pragma unroll
      for (int i = 0; i < 8; ++i) *(bf16x8*)(As + (sr + i * 32) * 72 + sc) = ra[i];
#pragma unroll
      for (int i = 0; i < 4; ++i) *(bf16x8*)(Bs + (sr + i * 32) * 72 + sc) = rb[i];
      __syncthreads();
      if (kt + 1 < nk) {
#pragma unroll
        for (int i = 0; i < 8; ++i) ra[i] = *(const bf16x8*)(ga + (size_t)i * 32 * K + (kt + 1) * 64);
#pragma unroll
        for (int i = 0; i < 4; ++i) rb[i] = *(const bf16x8*)(gb + (size_t)i * 32 * K + (kt + 1) * 64);
      }
#pragma unroll
      for (int kk = 0; kk < 4; ++kk) {
        bf16x8 b0v = *(const bf16x8*)(Bs + (wn * 64 + lr) * 72 + kk * 16 + lh * 8);
        bf16x8 b1v = *(const bf16x8*)(Bs + (wn * 64 + 32 + lr) * 72 + kk * 16 + lh * 8);
#pragma unroll
        for (int i = 0; i < 4; ++i) {
          bf16x8 av = *(const bf16x8*)(As + (wm * 128 + i * 32 + lr) * 72 + kk * 16 + lh * 8);
          acc[i][0] = __builtin_amdgcn_mfma_f32_32x32x16_bf16(av, b0v, acc[i][0], 0, 0, 0);
          acc[i][1] = __builtin_amdgcn_mfma_f32_32x32x16_bf16(av, b1v, acc[i][1], 0, 0, 0);
        }
      }
    }
    if (ni < 46) {
      bf16_t* dst; int ld, cb;
      if (ni < 8) { dst = p.PZ; ld = 1024; cb = ni * 128; }
      else if (ni < 20) { dst = p.PXBC; ld = 1536; cb = (ni - 8) * 128; }
      else if (ni < 36) { dst = p.PSC; ld = 2048; cb = (ni - 20) * 128; }
      else { dst = p.PATT; ld = 1280; cb = (ni - 36) * 128; }
      bf16_t* Os = smem;
      __syncthreads();
#pragma unroll
      for (int half = 0; half < 2; ++half) {
        if (wm == half) {
          bf16_t* q = Os + (4 * lh) * 136 + wn * 64 + lr;
#pragma unroll
          for (int i = 0; i < 4; ++i)
#pragma unroll
            for (int j = 0; j < 2; ++j)
#pragma unroll
              for (int r = 0; r < 16; ++r) q[(i * 32 + (r & 3) + 8 * (r >> 2)) * 136 + j * 32] = f2bf(acc[i][j][r]);
        }
        __syncthreads();
        {
          const int orow = tid >> 4, ocol = (tid & 15) * 8;
          bf16_t* gd = dst + (size_t)(m0 + half * 128 + orow) * ld + cb + ocol;
#pragma unroll
          for (int k = 0; k < 8; ++k) {
            bf16x8 v = *(const bf16x8*)(Os + (orow + 16 * k) * 136 + ocol);
            *(bf16x8*)(gd + (size_t)(16 * k) * ld) = v;
          }
        }
        __syncthreads();
      }
    } else if (wn == 0) {
#pragma unroll
      for (int i = 0; i < 4; ++i)
#pragma unroll
        for (int r = 0; r < 16; ++r) {
          int row = m0 + wm * 128 + i * 32 + (r & 3) + 8 * (r >> 2) + 4 * lh;
          p.DTRAW[(size_t)row * 32 + lr] = acc[i][0][r];
        }
    }
  }
}

__device__ void phase_prep(const Params& p, int layer, int pass, float* smem) {
  const int tid = opq_tid(), lane = tid & 63;
  const int gw = opq_bid() * 4 + (tid >> 6), nw = gridDim.x * 4;
  for (int gc = opq_bid(); gc < NCH; gc += gridDim.x) {
    float* sda = smem; float* sdt = smem + 4224;
    for (int e = tid; e < 4096; e += 256) {
      int l = e >> 5, dh = e & 31;
      float raw = p.DTRAW[((size_t)gc * 128 + l) * 32 + dh] + p.ssd_dt_bias[layer * 32 + dh];
      float dt = raw > 20.f ? raw : log1pf(expf(raw));
      float A = -expf(p.ssd_a_log[layer * 32 + dh]);
      sdt[l * 33 + dh] = dt;
      sda[l * 33 + dh] = dt * A;
    }
    __syncthreads();
    {
      const int dh = tid & 31, seg = tid >> 5;
      float* segtot = smem + 8448;
      float loc[16]; float s = 0.f;
      if (dh < 16) {
#pragma unroll
        for (int j = 0; j < 16; ++j) { s += sda[(seg * 16 + j) * 33 + dh]; loc[j] = s; }
      } else {
#pragma unroll
        for (int j = 15; j >= 0; --j) { s += sda[(seg * 16 + j) * 33 + dh]; loc[j] = s; }
      }
      segtot[seg * 32 + dh] = s;
      __syncthreads();
      float off = 0.f;
      if (dh < 16) { for (int k = 0; k < seg; ++k) off += segtot[k * 32 + dh]; }
      else { for (int k = 7; k > seg; --k) off += segtot[k * 32 + dh]; }
#pragma unroll
      for (int j = 0; j < 16; ++j) sda[(seg * 16 + j) * 33 + dh] = loc[j] + off;
    }
    __syncthreads();
    for (int e = tid; e < 4096; e += 256) {
      int dh = e >> 7, l = e & 127;
      float cum = sda[l * 33 + dh], dt = sdt[l * 33 + dh];
      float tot = (dh < 16) ? sda[127 * 33 + dh] : sda[dh];
      size_t idx = ((size_t)gc * 32 + dh) * 128 + l;
      p.CUMT[idx] = cum;
      p.VV[idx] = cum - logf(fmaxf(dt, 1e-30f));
      p.EC[idx] = expf(cum);
      p.WW[idx] = dt * expf(tot - cum);
    }
    __syncthreads();
  }
  const int nchc = (layer == 0) ? NCH : 64;
  const int Nb = NCH * 4 * 24, Nc = nchc * 16, Nd = (NT * 40) / 64, Ne = NCH * 16 * 2;
  for (int uu = gw; uu < Nb + Nc + Nd + Ne; uu += nw) {
  if (uu < Nb) {
    const int u = uu;
    int cblk = u % 24, l32 = (u / 24) & 3, gc = u / (24 * 4);
    int c = cblk * 64 + lane;
    bool first, last;
    if (gc < 64) { first = (gc % 32 == 0) && l32 == 0; last = (gc % 32 == 31) && l32 == 3; }
    else { first = ((gc - 64) % 2 == 0) && l32 == 0; last = ((gc - 64) % 2 == 1) && l32 == 3; }
    int t0 = gc * 128 + l32 * 32;
    float w0 = p.ssd_conv_w[((size_t)layer * 3 + 0) * 1536 + c], w1 = p.ssd_conv_w[((size_t)layer * 3 + 1) * 1536 + c],
          w2 = p.ssd_conv_w[((size_t)layer * 3 + 2) * 1536 + c], bs = p.ssd_conv_b[layer * 1536 + c];
    bf16_t raw[34];
#pragma unroll
    for (int i = 0; i < 34; ++i) {
      bool ok = !((i == 0 && first) || (i == 33 && last));
      raw[i] = ok ? p.PXBC[(size_t)(t0 + i - 1) * 1536 + c] : (bf16_t)0;
    }
    bf16x8 o[4];
#pragma unroll
    for (int j = 0; j < 32; ++j)
      o[j >> 3][j & 7] = (short)f2bf(silu_f(w0 * bf2f(raw[j]) + w1 * bf2f(raw[j + 1]) + w2 * bf2f(raw[j + 2]) + bs));
    if (c < 1024) {
#pragma unroll
      for (int k = 0; k < 4; ++k) *(bf16x8*)(p.XT + ((size_t)gc * 1024 + c) * 128 + l32 * 32 + k * 8) = o[k];
    } else if (c < 1280) {
      int n = c - 1024;
#pragma unroll
      for (int k = 0; k < 4; ++k) *(bf16x8*)(p.BT + ((size_t)gc * 256 + n) * 128 + l32 * 32 + k * 8) = o[k];
#pragma unroll
      for (int j = 0; j < 32; ++j) p.BR[(size_t)(t0 + j) * 256 + n] = (bf16_t)o[j >> 3][j & 7];
    } else {
      int n = c - 1280;
#pragma unroll
      for (int j = 0; j < 32; ++j) p.CR[(size_t)(t0 + j) * 256 + n] = (bf16_t)o[j >> 3][j & 7];
    }
  } else if (uu < Nb + Nc) {
    {
      const int u = uu - Nb;
      const int l8 = u & 15, gc = u >> 4;
      const int c0 = lane * 8;
      bool first, last;
      if (gc < 64) { first = (gc % 32 == 0) && l8 == 0; last = (gc % 32 == 31) && l8 == 15; }
      else { first = ((gc - 64) % 2 == 0) && l8 == 0; last = ((gc - 64) % 2 == 1) && l8 == 15; }
      const int t0 = gc * 128 + l8 * 8;
      float w0[8], w1[8], w2[8];
      {
        const float* wp = p.sc_conv_w + (size_t)layer * 3 * 512 + c0;
        f32x4 a0 = *(const f32x4*)wp, a1 = *(const f32x4*)(wp + 4);
        f32x4 b0 = *(const f32x4*)(wp + 512), b1 = *(const f32x4*)(wp + 516);
        f32x4 d0 = *(const f32x4*)(wp + 1024), d1 = *(const f32x4*)(wp + 1028);
#pragma unroll
        for (int k = 0; k < 4; ++k) { w0[k] = a0[k]; w0[4 + k] = a1[k]; w1[k] = b0[k]; w1[4 + k] = b1[k]; w2[k] = d0[k]; w2[4 + k] = d1[k]; }
      }
      float up[10][8];
#pragma unroll
      for (int i = 0; i < 10; ++i) {
        bool ok = !((i == 0 && first) || (i == 9 && last));
        const bf16_t* r = p.PSC + (size_t)(t0 + i - 1) * 2048 + c0;
        bf16x8 v8 = ok ? *(const bf16x8*)r : bf16x8{0, 0, 0, 0, 0, 0, 0, 0};
        bf16x8 g8 = ok ? *(const bf16x8*)(r + 512) : bf16x8{0, 0, 0, 0, 0, 0, 0, 0};
#pragma unroll
        for (int k = 0; k < 8; ++k) up[i][k] = bf2f((bf16_t)v8[k]) * bf2f((bf16_t)g8[k]);
      }
#pragma unroll
      for (int j = 0; j < 8; ++j) {
        const bf16_t* r = p.PSC + (size_t)(t0 + j) * 2048 + c0;
        bf16x8 b8 = *(const bf16x8*)(r + 1024), z8 = *(const bf16x8*)(r + 1536);
        f32x4 lo, hi;
#pragma unroll
        for (int k = 0; k < 8; ++k) {
          float cv = w0[k] * up[j][k] + w1[k] * up[j + 1][k] + w2[k] * up[j + 2][k];
          float o = bf2f((bf16_t)b8[k]) * cv * silu_f(bf2f((bf16_t)z8[k]));
          if (k < 4) lo[k] = o; else hi[k - 4] = o;
        }
        *(bf16x8*)(p.Y + (size_t)(t0 + j) * 2048 + 1024 + c0) = pack8(lo, hi);
      }
    }
  } else if (uu < Nb + Nc + Nd) {
    {
      const int idx = (uu - Nb - Nc) * 64 + lane;
      int row = idx / 40, r = idx % 40;
      int slot = r >> 2, a = (r >> 1) & 1, i0 = (r & 1) * 8;
      const bf16_t* src = p.PATT + (size_t)row * 1280 + (slot < 8 ? slot * 64 : 512 + (slot - 8) * 64) + a * 32 + i0;
      bf16x8 x1 = *(const bf16x8*)src, x2 = *(const bf16x8*)(src + 16);
      bf16x8 o1, o2;
      if (row < NTL) {
        int t = row & (SEQ - 1);
        int pos = (a == 0) ? (t >> 6) : (t & 63);
        const float* tb = p.ROPE + (pos * 16 + i0) * 2;
#pragma unroll
        for (int j = 0; j < 8; ++j) {
          float cs = tb[2 * j], sn = tb[2 * j + 1];
          float a1 = bf2f((bf16_t)x1[j]), a2 = bf2f((bf16_t)x2[j]);
          o1[j] = (short)f2bf(a1 * cs - a2 * sn);
          o2[j] = (short)f2bf(a1 * sn + a2 * cs);
        }
      } else { o1 = x1; o2 = x2; }
      bf16_t* dst = (slot < 8) ? p.QR + (size_t)row * 512 + slot * 64 + a * 32 + i0
                               : p.KR + (size_t)row * 128 + (slot - 8) * 64 + a * 32 + i0;
      *(bf16x8*)dst = o1; *(bf16x8*)(dst + 16) = o2;
    }
  } else {
    const int u = uu - Nb - Nc - Nd;
    int half = u & 1, l8 = (u >> 1) & 15, gc = u >> 5;
    int c = half * 64 + lane;
    int t0 = gc * 128 + l8 * 8;
    bf16x8 o;
#pragma unroll
    for (int j = 0; j < 8; ++j) o[j] = (short)p.PATT[(size_t)(t0 + j) * 1280 + 640 + c];
    *(bf16x8*)(p.VT + ((size_t)gc * 128 + c) * 128 + l8 * 8) = o;
  }
  }
}

__device__ void phase_attn_naive(const Params& p, int layer, int pass) {
  const int lane = opq_tid() & 63;
  const int gw = opq_bid() * 4 + (opq_tid() >> 6), nw = gridDim.x * 4;
  const int nrows = (layer == 0) ? NT : NTL;
  for (int u = gw; u < nrows * 8; u += nw) {
    int h = u & 7, row = u >> 3, kvh = h >> 2;
    float q = bf2f(p.QR[(size_t)row * 512 + h * 64 + lane]);
    float m = p.attn_sink[layer * 8 + h], l = 1.f, o = 0.f;
    int bl, k0 = 0, k1 = 0;
    if (row < NTL) {
      bl = row / SEQ; int t = row % SEQ;
      int lo = t - 128 < 0 ? 0 : t - 128, hi = t + 128 > SEQ - 1 ? SEQ - 1 : t + 128;
      k0 = bl * SEQ + lo; k1 = bl * SEQ + hi + 1;
    } else bl = (row - NTL) / CTXL;
    int nband = k1 - k0;
    for (int kk = 0; kk < nband + CTXL; ++kk) {
      int kr = (kk < nband) ? k0 + kk : NTL + bl * CTXL + (kk - nband);
      float kv = bf2f(p.KR[(size_t)kr * 128 + kvh * 64 + lane]);
      float vv = bf2f(p.VT[((size_t)(kr >> 7) * 128 + kvh * 64 + lane) * 128 + (kr & 127)]);
      float s = wave_sum(q * kv) * 0.125f;
      float mn = fmaxf(m, s);
      float corr = expf(m - mn), pe = expf(s - mn);
      l = l * corr + pe; o = o * corr + pe * vv; m = mn;
    }
    float z = bf2f(p.PATT[(size_t)row * 1280 + 768 + h * 64 + lane]);
    p.Y[(size_t)row * 2048 + 1536 + h * 64 + lane] = f2bf(o / l * silu_f(z));
  }
}

__device__ void phase_attn(const Params& p, int layer, int pass, bf16_t* smem) {
  const int tid = opq_tid(), lane = tid & 63, wid = tid >> 6, lr = lane & 31, lh = lane >> 5;
  const int nqt = ((layer == 0) ? NT : NTL) / 32;
  const int srow = tid >> 3, scol = (tid & 7) * 8;
  for (int u = (opq_bid() + (int)gridDim.x - 64) % (int)gridDim.x; u < nqt * 2; u += gridDim.x) {
    const int kvh = u & 1, qt = u >> 1, h = kvh * 4 + wid;
    const int q0 = qt * 32;
    int bl, nband = 0, tb0 = 0, t0 = 0;
    if (q0 < NTL) {
      bl = q0 >> 12; t0 = q0 & 4095;
      tb0 = (t0 - 128 < 0) ? 0 : ((t0 - 128) >> 6);
      int tb1 = (t0 + 159) >> 6; if (tb1 > 63) tb1 = 63;
      nband = tb1 - tb0 + 1;
    } else bl = (q0 - NTL) >> 8;
    const int ntile = nband + 4;
    bf16x8 qf[4];
    {
      const bf16_t* qp = p.QR + (size_t)(q0 + lr) * 512 + h * 64 + lh * 8;
#pragma unroll
      for (int kk = 0; kk < 4; ++kk) qf[kk] = *(const bf16x8*)(qp + kk * 16);
    }
    float m = p.attn_sink[layer * 8 + h], l = 1.f;
    f32x16 o[2];
#pragma unroll
    for (int r = 0; r < 16; ++r) { o[0][r] = 0.f; o[1][r] = 0.f; }
    const int qpos = t0 + lr;
    bf16x8 rk[2], rv[2];
    auto fetch = [&](int ti) __attribute__((always_inline)) {
      const int kr0 = (ti < nband) ? bl * 4096 + (tb0 + ti) * 64 : NTL + bl * 256 + (ti - nband) * 64;
      const bf16_t* kp = p.KR + (size_t)(kr0 + srow) * 128 + kvh * 64 + scol;
      const bf16_t* vp = p.VT + ((size_t)(kr0 >> 7) * 128 + kvh * 64 + srow) * 128 + (kr0 & 127) + scol;
      rk[0] = *(const bf16x8*)kp; rk[1] = *(const bf16x8*)(kp + 32 * 128);
      rv[0] = *(const bf16x8*)vp; rv[1] = *(const bf16x8*)(vp + 32 * 128);
    };
    auto stash = [&](bf16_t* buf) __attribute__((always_inline)) {
      *(bf16x8*)(buf + srow * 72 + scol) = rk[0];
      *(bf16x8*)(buf + (srow + 32) * 72 + scol) = rk[1];
      *(bf16x8*)(buf + 4608 + srow * 72 + scol) = rv[0];
      *(bf16x8*)(buf + 4608 + (srow + 32) * 72 + scol) = rv[1];
    };
    fetch(0);
    __syncthreads();
    stash(smem);
    if (1 < ntile) fetch(1);
    __syncthreads();
    for (int ti = 0; ti < ntile; ++ti) {
      const bf16_t* Kc = smem + (ti & 1) * 9216;
      const bf16_t* Vc = Kc + 4608;
      if (ti + 1 < ntile) {
        stash(smem + ((ti + 1) & 1) * 9216);
        if (ti + 2 < ntile) fetch(ti + 2);
      }
      f32x16 st[2];
#pragma unroll
      for (int r = 0; r < 16; ++r) { st[0][r] = 0.f; st[1][r] = 0.f; }
#pragma unroll
      for (int kk = 0; kk < 4; ++kk) {
        bf16x8 kf0 = *(const bf16x8*)(Kc + lr * 72 + kk * 16 + lh * 8);
        bf16x8 kf1 = *(const bf16x8*)(Kc + (32 + lr) * 72 + kk * 16 + lh * 8);
        st[0] = __builtin_amdgcn_mfma_f32_32x32x16_bf16(kf0, qf[kk], st[0], 0, 0, 0);
        st[1] = __builtin_amdgcn_mfma_f32_32x32x16_bf16(kf1, qf[kk], st[1], 0, 0, 0);
      }
      float mx = -3.0e38f;
      const bool band = ti < nband;
      const int kbase = (tb0 + ti) * 64 + 4 * lh;
#pragma unroll
      for (int hh = 0; hh < 2; ++hh)
#pragma unroll
        for (int r = 0; r < 16; ++r) {
          float s = st[hh][r] * 0.125f;
          if (band) {
            int dd = qpos - (kbase + hh * 32 + (r & 3) + 8 * (r >> 2));
            if (dd > 128 || dd < -128) s = -1e30f;
          }
          st[hh][r] = s; mx = fmaxf(mx, s);
        }
      mx = fmaxf(mx, __shfl_xor(mx, 32));
      const float mn = fmaxf(m, mx);
      const float corr = __expf(m - mn);
      m = mn;
      float ls = 0.f;
#pragma unroll
      for (int hh = 0; hh < 2; ++hh)
#pragma unroll
        for (int r = 0; r < 16; ++r) { st[hh][r] = __expf(st[hh][r] - mn); ls += st[hh][r]; }
      ls += __shfl_xor(ls, 32);
      l = l * corr + ls;
#pragma unroll
      for (int r = 0; r < 16; ++r) { o[0][r] *= corr; o[1][r] *= corr; }
#pragma unroll
      for (int hh = 0; hh < 2; ++hh)
#pragma unroll
        for (int s2 = 0; s2 < 2; ++s2) {
          f32x4 pa = {st[hh][8 * s2 + 0], st[hh][8 * s2 + 1], st[hh][8 * s2 + 2], st[hh][8 * s2 + 3]};
          f32x4 pb = {st[hh][8 * s2 + 4], st[hh][8 * s2 + 5], st[hh][8 * s2 + 6], st[hh][8 * s2 + 7]};
          bf16x8 pf = pack8(pa, pb);
#pragma unroll
          for (int mt = 0; mt < 2; ++mt) {
            const bf16_t* vp = Vc + (mt * 32 + lr) * 72 + hh * 32 + 16 * s2 + 4 * lh;
            bf16x4 x0 = *(const bf16x4*)vp, x1 = *(const bf16x4*)(vp + 8);
            bf16x8 vfr = {x0[0], x0[1], x0[2], x0[3], x1[0], x1[1], x1[2], x1[3]};
            o[mt] = __builtin_amdgcn_mfma_f32_32x32x16_bf16(vfr, pf, o[mt], 0, 0, 0);
          }
        }
      __syncthreads();
    }
    const float inv = 1.f / l;
    {
      bf16_t* Zw = smem + 2 * 9216 + wid * (32 * 72);
      const int er = lane >> 3, ec = (lane & 7) * 8;
      const bf16_t* zg = p.PATT + (size_t)(q0 + er) * 1280 + 768 + h * 64 + ec;
      bf16x8 zr[4];
#pragma unroll
      for (int i = 0; i < 4; ++i) zr[i] = *(const bf16x8*)(zg + (size_t)i * 8 * 1280);
#pragma unroll
      for (int i = 0; i < 4; ++i) *(bf16x8*)(Zw + (er + 8 * i) * 72 + ec) = zr[i];
#pragma unroll
      for (int mt = 0; mt < 2; ++mt)
#pragma unroll
        for (int qq = 0; qq < 4; ++qq) {
          int d0 = mt * 32 + 8 * qq + 4 * lh;
          bf16x4 z4 = *(const bf16x4*)(Zw + lr * 72 + d0);
          bf16x4 o4;
#pragma unroll
          for (int t = 0; t < 4; ++t) o4[t] = (short)f2bf(o[mt][qq * 4 + t] * inv * silu_f(bf2f((bf16_t)z4[t])));
          *(bf16x4*)(Zw + lr * 72 + d0) = o4;
        }
      bf16_t* yg = p.Y + (size_t)(q0 + er) * 2048 + 1536 + h * 64 + ec;
#pragma unroll
      for (int i = 0; i < 4; ++i) *(bf16x8*)(yg + (size_t)i * 8 * 2048) = *(const bf16x8*)(Zw + (er + 8 * i) * 72 + ec);
    }
  }
}

__device__ void phase_s1(const Params& p, int layer, int pass, bf16_t* smem) {
  const int tid = opq_tid(), lane = tid & 63, nt = tid >> 6, lr = lane & 31, lh = lane >> 5;
  constexpr int RS = 136;
  bf16_t* Xs = smem;
  bf16_t* Bts = smem + 64 * RS;
  float* Ws = (float*)(smem + 192 * RS);
  const int srow = tid >> 4, scol = (tid & 15) * 8;
  for (int u = opq_bid(); u < NCH * 16; u += gridDim.x) {
    const int h = u & 15, gc = u >> 4, g = h >> 3;
    bf16x8 rx[4], rb[8];
    {
      const bf16_t* Xg = p.XT + ((size_t)gc * 1024 + h * 64 + srow) * 128 + scol;
#pragma unroll
      for (int i = 0; i < 4; ++i) rx[i] = *(const bf16x8*)(Xg + i * 2048);
      const bf16_t* Bg = p.BT + ((size_t)gc * 256 + g * 128 + srow) * 128 + scol;
#pragma unroll
      for (int i = 0; i < 8; ++i) rb[i] = *(const bf16x8*)(Bg + i * 2048);
    }
    const float wv = p.WW[((size_t)gc * 32 + (tid >> 7) * 16 + h) * 128 + (tid & 127)];
    __syncthreads();
#pragma unroll
    for (int i = 0; i < 4; ++i) *(bf16x8*)(Xs + (srow + 16 * i) * RS + scol) = rx[i];
#pragma unroll
    for (int i = 0; i < 8; ++i) *(bf16x8*)(Bts + (srow + 16 * i) * RS + scol) = rb[i];
    Ws[tid] = wv;
    __syncthreads();
#pragma unroll 1
    for (int d = 0; d < 2; ++d) {
      f32x16 acc0, acc1;
#pragma unroll
      for (int r = 0; r < 16; ++r) { acc0[r] = 0.f; acc1[r] = 0.f; }
#pragma unroll
      for (int kk = 0; kk < 8; ++kk) {
        bf16x8 bfr = *(const bf16x8*)(Bts + (nt * 32 + lr) * RS + kk * 16 + lh * 8);
        bf16x8 x0 = *(const bf16x8*)(Xs + lr * RS + kk * 16 + lh * 8);
        bf16x8 x1 = *(const bf16x8*)(Xs + (32 + lr) * RS + kk * 16 + lh * 8);
        f32x4 wa = *(const f32x4*)(Ws + d * 128 + kk * 16 + lh * 8), wb = *(const f32x4*)(Ws + d * 128 + kk * 16 + lh * 8 + 4);
        f32x4 a0, a1, c0, c1;
#pragma unroll
        for (int j = 0; j < 4; ++j) {
          a0[j] = bf2f((bf16_t)x0[j]) * wa[j]; a1[j] = bf2f((bf16_t)x0[4 + j]) * wb[j];
          c0[j] = bf2f((bf16_t)x1[j]) * wa[j]; c1[j] = bf2f((bf16_t)x1[4 + j]) * wb[j];
        }
        acc0 = __builtin_amdgcn_mfma_f32_32x32x16_bf16(pack8(a0, a1), bfr, acc0, 0, 0, 0);
        acc1 = __builtin_amdgcn_mfma_f32_32x32x16_bf16(pack8(c0, c1), bfr, acc1, 0, 0, 0);
      }
      float* dst = p.LST + ((((size_t)gc * 16 + h) * 2 + d) * 64) * 128 + nt * 32 + lr;
#pragma unroll
      for (int r = 0; r < 16; ++r) {
        int pp = (r & 3) + 8 * (r >> 2) + 4 * lh;
        dst[(size_t)pp * 128] = acc0[r];
        dst[(size_t)(32 + pp) * 128] = acc1[r];
      }
    }
  }
}

__device__ __forceinline__ int scan_chunk(int ci, int bl, int d) {
  if (ci < 2) return 64 + bl * 2 + (d == 0 ? ci : 1 - ci);
  int cc = ci - 2;
  return bl * 32 + (d == 0 ? cc : 31 - cc);
}
__device__ void phase_s2(const Params& p, int layer, int pass) {
  const int nth = gridDim.x * 256;
  for (int e = opq_bid() * 256 + opq_tid(); e < 64 * 2048; e += nth) {
    int seq = e >> 11, q = e & 2047, pp = q >> 5, n4 = (q & 31) * 4;
    int d = seq & 1, h = (seq >> 1) & 15, bl = seq >> 5;
    f32x4 s = {0.f, 0.f, 0.f, 0.f};
    const size_t eoff = ((size_t)h * 2 + d) * 8192 + (size_t)pp * 128 + n4;
    const int toff = (d == 0) ? h * 128 + 127 : (16 + h) * 128;
#pragma unroll
    for (int half = 0; half < 2; ++half) {
      f32x4 loc[17]; float tot[17];
#pragma unroll
      for (int i = 0; i < 17; ++i) {
        int gc = scan_chunk(half * 17 + i, bl, d);
        loc[i] = *(const f32x4*)(p.LST + (size_t)gc * 262144 + eoff);
        tot[i] = p.CUMT[(size_t)gc * 4096 + toff];
      }
#pragma unroll
      for (int i = 0; i < 17; ++i) {
        int gc = scan_chunk(half * 17 + i, bl, d);
        uint2 o; o.x = pk2(s[0], s[1]); o.y = pk2(s[2], s[3]);
        *(uint2*)(p.SIN + (size_t)gc * 262144 + eoff) = o;
        float dec = expf(tot[i]);
        s = s * dec + loc[i];
      }
    }
  }
}

__device__ void phase_s3(const Params& p, int layer, int pass, bf16_t* smem) {
  const int tid = opq_tid(), lane = tid & 63, w = tid >> 6, lr = lane & 31, lh = lane >> 5;
  const int nch = (layer == 0) ? NCH : 64;
  constexpr int RS = 136;
  bf16_t* Ss = smem;
  bf16_t* Bs = smem;
  bf16_t* Xs = smem + 128 * RS;
  float* Vs = (float*)(smem + 192 * RS);
  bf16_t* Zs = smem + 192 * RS + 1536;
  bf16_t* Os = smem;
  const int srow = tid >> 4, scol = (tid & 15) * 8;
  for (int u = opq_bid(); u < nch * 16; u += gridDim.x) {
    const int h = u & 15, gc = u >> 4, g = h >> 3;
    const int i_own = 32 * w + lr;
    bf16x8 rs[8];
    {
      const bf16_t* Sg = p.SIN + ((size_t)gc * 16 + h) * 16384 + srow * 128 + scol;
#pragma unroll
      for (int i = 0; i < 8; ++i) rs[i] = *(const bf16x8*)(Sg + i * 2048);
    }
    bf16x8 cf[8];
    {
      const bf16_t* crow = p.CR + ((size_t)gc * 128 + i_own) * 256 + g * 128 + lh * 8;
#pragma unroll
      for (int kk = 0; kk < 8; ++kk) cf[kk] = *(const bf16x8*)(crow + kk * 16);
    }
    bf16x8 rz[4];
    {
      const bf16_t* Zg = p.PZ + ((size_t)gc * 128 + (tid >> 3)) * 1024 + h * 64 + (tid & 7) * 8;
#pragma unroll
      for (int i = 0; i < 4; ++i) rz[i] = *(const bf16x8*)(Zg + (size_t)i * 32 * 1024);
    }
    const size_t vidx = ((size_t)gc * 32 + (tid >> 7) * 16 + h) * 128 + (tid & 127);
    const float v_vv = p.VV[vidx], v_ec = p.EC[vidx], v_cu = p.CUMT[vidx];
    __syncthreads();
#pragma unroll
    for (int i = 0; i < 8; ++i) *(bf16x8*)(Ss + (srow + 16 * i) * RS + scol) = rs[i];
    Vs[tid] = v_vv; Vs[256 + tid] = v_ec; Vs[512 + tid] = v_cu;
#pragma unroll
    for (int i = 0; i < 4; ++i) *(bf16x8*)(Zs + ((tid >> 3) + 32 * i) * 72 + (tid & 7) * 8) = rz[i];
    bf16x8 rb[8], rx[4];
    {
      const bf16_t* Bg = p.BR + ((size_t)gc * 128 + srow) * 256 + g * 128 + scol;
#pragma unroll
      for (int i = 0; i < 8; ++i) rb[i] = *(const bf16x8*)(Bg + i * 16 * 256);
      const bf16_t* Xg = p.XT + ((size_t)gc * 1024 + h * 64 + srow) * 128 + scol;
#pragma unroll
      for (int i = 0; i < 4; ++i) rx[i] = *(const bf16x8*)(Xg + i * 2048);
    }
    __syncthreads();
    f32x16 y[2];
#pragma unroll
    for (int r = 0; r < 16; ++r) { y[0][r] = 0.f; y[1][r] = 0.f; }
#pragma unroll
    for (int d = 0; d < 2; ++d) {
      const float* ec = Vs + 256 + d * 128 + 32 * w + 4 * lh;
#pragma unroll
      for (int pt = 0; pt < 2; ++pt) {
        f32x16 tmp;
#pragma unroll
        for (int r = 0; r < 16; ++r) tmp[r] = 0.f;
        const bf16_t* sl = Ss + (d * 64 + pt * 32 + lr) * RS + lh * 8;
#pragma unroll
        for (int kk = 0; kk < 8; ++kk) {
          bf16x8 sf = *(const bf16x8*)(sl + kk * 16);
          tmp = __builtin_amdgcn_mfma_f32_32x32x16_bf16(cf[kk], sf, tmp, 0, 0, 0);
        }
#pragma unroll
        for (int q = 0; q < 4; ++q) {
          f32x4 e4 = *(const f32x4*)(ec + 8 * q);
#pragma unroll
          for (int t = 0; t < 4; ++t) y[pt][q * 4 + t] += tmp[q * 4 + t] * e4[t];
        }
      }
    }
    __syncthreads();
#pragma unroll
    for (int i = 0; i < 8; ++i) *(bf16x8*)(Bs + (srow + 16 * i) * RS + scol) = rb[i];
#pragma unroll
    for (int i = 0; i < 4; ++i) *(bf16x8*)(Xs + (srow + 16 * i) * RS + scol) = rx[i];
    __syncthreads();
    const float cum_f = Vs[512 + i_own];
    const float cum_b = Vs[512 + 128 + i_own];
#pragma unroll 1
    for (int jt = 0; jt < 4; ++jt) {
      f32x16 cb;
#pragma unroll
      for (int r = 0; r < 16; ++r) cb[r] = 0.f;
      const bf16_t* bl_ = Bs + (jt * 32 + lr) * RS + lh * 8;
#pragma unroll
      for (int kk = 0; kk < 8; ++kk) {
        bf16x8 bfr = *(const bf16x8*)(bl_ + kk * 16);
        cb = __builtin_amdgcn_mfma_f32_32x32x16_bf16(bfr, cf[kk], cb, 0, 0, 0);
      }
      bf16x8 xb[2][2];
#pragma unroll
      for (int s = 0; s < 2; ++s)
#pragma unroll
        for (int pt = 0; pt < 2; ++pt) {
          const bf16_t* xp = Xs + (pt * 32 + lr) * RS + jt * 32 + 16 * s + 4 * lh;
          bf16x4 x0 = *(const bf16x4*)xp, x1 = *(const bf16x4*)(xp + 8);
          bf16x8 t8 = {x0[0], x0[1], x0[2], x0[3], x1[0], x1[1], x1[2], x1[3]};
          xb[s][pt] = t8;
        }
#pragma unroll
      for (int d = 0; d < 2; ++d) {
        bool need = (d == 0) ? (jt <= w) : (jt >= w);
        if (!need) continue;
        const float* vv = Vs + d * 128 + jt * 32 + 4 * lh;
        const float ci = (d == 0) ? cum_f : cum_b;
        f32x16 gq;
#pragma unroll
        for (int q = 0; q < 4; ++q) {
          f32x4 v4 = *(const f32x4*)(vv + 8 * q);
#pragma unroll
          for (int t = 0; t < 4; ++t) {
            int j = jt * 32 + 8 * q + 4 * lh + t;
            float val = cb[q * 4 + t] * __expf(ci - v4[t]);
            bool ok = (jt != w) || ((d == 0) ? (j <= i_own) : (j >= i_own));
            gq[q * 4 + t] = ok ? val : 0.f;
          }
        }
#pragma unroll
        for (int s = 0; s < 2; ++s) {
          f32x4 ga = {gq[8 * s + 0], gq[8 * s + 1], gq[8 * s + 2], gq[8 * s + 3]};
          f32x4 gb = {gq[8 * s + 4], gq[8 * s + 5], gq[8 * s + 6], gq[8 * s + 7]};
          bf16x8 afr = pack8(ga, gb);
          y[0] = __builtin_amdgcn_mfma_f32_32x32x16_bf16(afr, xb[s][0], y[0], 0, 0, 0);
          y[1] = __builtin_amdgcn_mfma_f32_32x32x16_bf16(afr, xb[s][1], y[1], 0, 0, 0);
        }
      }
    }
    const float Dh = p.ssd_d[layer * 16 + h];
    float ssq[16];
#pragma unroll
    for (int r = 0; r < 16; ++r) ssq[r] = 0.f;
    __syncthreads();
#pragma unroll
    for (int pt = 0; pt < 2; ++pt)
#pragma unroll
      for (int q = 0; q < 4; ++q) {
        bf16x4 x4 = *(const bf16x4*)(Xs + (pt * 32 + lr) * RS + 32 * w + 8 * q + 4 * lh);
#pragma unroll
        for (int t = 0; t < 4; ++t) {
          int li = 32 * w + 8 * q + 4 * lh + t;
          float yv = y[pt][q * 4 + t] + Dh * bf2f((bf16_t)x4[t]);
          float z = bf2f(Zs[li * 72 + pt * 32 + lr]);
          float gv = yv * silu_f(z);
          ssq[q * 4 + t] += gv * gv;
          Os[li * 72 + pt * 32 + lr] = f2bf(gv);
        }
      }
    __syncthreads();
    {
      bf16_t* Yg = p.Y + ((size_t)gc * 128 + (tid >> 3)) * 2048 + h * 64 + (tid & 7) * 8;
#pragma unroll
      for (int i = 0; i < 4; ++i)
        *(bf16x8*)(Yg + (size_t)i * 32 * 2048) = *(const bf16x8*)(Os + ((tid >> 3) + 32 * i) * 72 + (tid & 7) * 8);
    }
#pragma unroll
    for (int r = 0; r < 16; ++r) {
      float v = ssq[r];
      v += __shfl_xor(v, 1); v += __shfl_xor(v, 2); v += __shfl_xor(v, 4); v += __shfl_xor(v, 8); v += __shfl_xor(v, 16);
      ssq[r] = v;
    }
    if (lr == 0) {
#pragma unroll
      for (int r = 0; r < 16; ++r) {
        int row = gc * 128 + 32 * w + (r & 3) + 8 * (r >> 2) + 4 * lh;
        p.SSQ[(size_t)row * 16 + h] = ssq[r];
      }
    }
  }
}

__device__ void phase_final(const Params& p) {
  const int lane = opq_tid() & 63;
  const int gw = opq_bid() * 4 + (opq_tid() >> 6), nw = gridDim.x * 4;
  for (int row = gw; row < 4 * SEQ; row += nw) {
    float* src = p.out + (size_t)row * D;
    float4 v[4]; float ss = 0.f;
#pragma unroll
    for (int i = 0; i < 4; ++i) {
      v[i] = *(const float4*)(src + (i * 64 + lane) * 4);
      ss += v[i].x * v[i].x + v[i].y * v[i].y + v[i].z * v[i].z + v[i].w * v[i].w;
    }
    ss = wave_sum(ss);
    float rstd = rsqrtf(ss * (1.f / D) + EPS);
#pragma unroll
    for (int i = 0; i < 4; ++i) {
      int k = (i * 64 + lane) * 4;
      float4 w = *(const float4*)(p.final_norm_w + k);
      float4 o = {v[i].x * rstd * w.x, v[i].y * rstd * w.y, v[i].z * rstd * w.z, v[i].w * rstd * w.w};
      *(float4*)(src + k) = o;
    }
  }
}

#ifndef REP_W
#define REP_W 1
#endif
#ifndef REP_GOUT0
#define REP_GOUT0 1
#endif
#ifndef REP_NORM
#define REP_NORM 1
#endif
#ifndef REP_GIN
#define REP_GIN 1
#endif
#ifndef REP_PREP
#define REP_PREP 1
#endif
#ifndef REP_S1
#define REP_S1 1
#endif
#ifndef REP_ATTN
#define REP_ATTN 1
#endif
#ifndef REP_S3
#define REP_S3 1
#endif
__global__ void __launch_bounds__(256, 2) mega(Params p, int lo, int hi) {
  __shared__ __attribute__((aligned(16))) float smem[18432];
  __shared__ uint4 xb_words;
  if (threadIdx.x == 0) xb_words = make_uint4(0u, 0u, 0u, 0u);
  __syncthreads();
  XcdBarrier xb = xcd_barrier_post(p.bar, (volatile LAS unsigned*)&xb_words);
  if (lo < 0) cg::this_grid().sync();
  for (int step = lo; step < hi; ++step) {
    if (step == 0) { for (int rp = 0; rp < REP_W; ++rp) phase_weights(p, smem); }
    else if (step == NSTEP - 1) phase_final(p);
    else {
      int s = step - 1;
      int pass = s / 14, r = s % 14, layer = r / 7, ph = r % 7;
      switch (ph) {
        case ST_NORM: for (int rp = 0; rp < REP_NORM; ++rp) phase_norm(p, layer, pass); break;
        case ST_GIN: for (int rp = 0; rp < REP_GIN; ++rp) phase_gemm_in256(p, layer, pass, (bf16_t*)smem); break;
        case ST_PREP: for (int rp = 0; rp < REP_PREP; ++rp) phase_prep(p, layer, pass, smem); break;
        case ST_MIX:
          for (int rp = 0; rp < REP_S1; ++rp) phase_s1(p, layer, pass, (bf16_t*)smem);
          for (int rp = 0; rp < REP_ATTN; ++rp) phase_attn(p, layer, pass, (bf16_t*)smem);
          break;
        case ST_S2: phase_s2(p, layer, pass); break;
        case ST_S3: for (int rp = 0; rp < REP_S3; ++rp) phase_s3(p, layer, pass, (bf16_t*)smem); break;
        case ST_GOUT: for (int rp = 0; rp < (layer == 0 ? REP_GOUT0 : 1); ++rp) phase_gemm_mfma(p, 1, layer, pass, (bf16_t*)smem); break;
      }
    }
    if (step + 1 < hi) xcd_barrier(xb);
  }
}

extern "C" void kernel_launch(void* const* d_in, const int* in_sizes, int n_in, void* d_out, int out_size, void* d_ws,
                              size_t ws_size, hipStream_t stream) {
  Params p{};
  p.x = (const float*)d_in[0]; p.c = (const float*)d_in[1]; p.ctx = (const float*)d_in[2]; p.c_ctx = (const float*)d_in[3];
  p.norm_w = (const float*)d_in[4]; p.w_mod = (const float*)d_in[5]; p.b_mod = (const float*)d_in[6];
  p.w_in = (const float*)d_in[7]; p.ssd_conv_w = (const float*)d_in[8]; p.ssd_conv_b = (const float*)d_in[9];
  p.ssd_dt_bias = (const float*)d_in[10]; p.ssd_a_log = (const float*)d_in[11]; p.ssd_d = (const float*)d_in[12];
  p.ssd_norm_w = (const float*)d_in[13]; p.sc_conv_w = (const float*)d_in[14]; p.attn_sink = (const float*)d_in[15];
  p.w_out = (const float*)d_in[16]; p.final_norm_w = (const float*)d_in[17];
  p.out = (float*)d_out;
  char* w = (char*)d_ws; size_t off = 0;
  auto take = [&](size_t bytes) { char* r = w + off; off += (bytes + 255) & ~(size_t)255; return r; };
  p.WinT = (bf16_t*)take((size_t)2 * NWIN * 1024 * 2);
  p.WoutT = (bf16_t*)take((size_t)2 * 1024 * 2048 * 2);
  p.MOD = (float*)take((size_t)2 * 5 * 3072 * 4);
  p.CTX1 = (float*)take((size_t)4 * CTXL * D * 4);
  p.ROPE = (float*)take((size_t)64 * 16 * 2 * 4);
  char* big = take((size_t)NT * (1024 + 1536 + 2048) * 2);
  p.H = (bf16_t*)big;
  p.PXBC = (bf16_t*)(big + (size_t)NT * 1024 * 2);
  p.PSC = (bf16_t*)(big + (size_t)NT * (1024 + 1536) * 2);
  p.LST = (float*)big;
  p.PART = (float*)(big + (size_t)24 * 1024 * 1024);
  p.PZ = (bf16_t*)take((size_t)NT * 1024 * 2);
  p.PATT = (bf16_t*)take((size_t)NT * 1280 * 2);
  p.QR = (bf16_t*)take((size_t)NT * 512 * 2);
  p.KR = (bf16_t*)take((size_t)NT * 128 * 2);
  p.VT = (bf16_t*)take((size_t)NT * 128 * 2);
  p.SIN = p.PATT;
  p.DTRAW = (float*)take((size_t)NT * 32 * 4);
  p.CUMT = (float*)take((size_t)NT * 32 * 4);
  p.VV = (float*)take((size_t)NT * 32 * 4);
  p.EC = (float*)take((size_t)NT * 32 * 4);
  p.WW = (float*)take((size_t)NT * 32 * 4);
  p.SSQ = (float*)take((size_t)NT * 16 * 4);
  p.XT = (bf16_t*)take((size_t)NT * 1024 * 2);
  p.BR = (bf16_t*)take((size_t)NT * 256 * 2);
  p.CR = (bf16_t*)take((size_t)NT * 256 * 2);
  p.BT = (bf16_t*)take((size_t)NT * 256 * 2);
  p.Y = (bf16_t*)take((size_t)NT * 2048 * 2);
  p.bar = (unsigned*)take((size_t)XCD_BAR_WORDS * 4);
  if (off > ws_size) { fprintf(stderr, "workspace too small: need %zu have %zu\n", off, ws_size); return; }
  static int grid_blocks = 0;
  if (!grid_blocks) {
    int dev = 0, cus = 0, per_cu = 0;
    hipGetDevice(&dev);
    hipDeviceGetAttribute(&cus, hipDeviceAttributeMultiprocessorCount, dev);
    hipOccupancyMaxActiveBlocksPerMultiprocessor(&per_cu, mega, 256, 0);
    if (per_cu > 2) per_cu = 2;
    if (per_cu < 1) per_cu = 1;
    grid_blocks = cus * per_cu;
  }
  hipMemsetAsync(p.bar, 0, (size_t)XCD_BAR_WORDS * 4, stream);
  int lo = 0, hi = NSTEP;
  void* args[] = {&p, &lo, &hi};
  hipError_t e = hipLaunchCooperativeKernel((void*)mega, dim3(grid_blocks), dim3(256), args, 0, stream);
  if (e != hipSuccess) fprintf(stderr, "cooperative launch failed: %s (grid %d)\n", hipGetErrorString(e), grid_blocks);
}
```

```cpp
#include <hip/hip_runtime.h>
#include <hip/hip_cooperative_groups.h>
#include <cstdio>
#include <type_traits>
namespace cg = cooperative_groups;

typedef unsigned short bf16_t;
typedef __attribute__((ext_vector_type(8))) short bf16x8;
typedef __attribute__((ext_vector_type(4))) short bf16x4;
typedef __attribute__((ext_vector_type(4))) float f32x4;
typedef __attribute__((ext_vector_type(16))) float f32x16;

constexpr int D = 1024, SEQ = 4096, CTXL = 256;
constexpr int NB = 2;
constexpr int NPASS = 2;
constexpr int NTL = NB * SEQ;
constexpr int NTC = NB * CTXL;
constexpr int NT = NTL + NTC;
constexpr int NCH = NT / 128;
constexpr int NWIN = 6016;
constexpr float EPS = 1e-6f;

constexpr int ST_NORM = 0, ST_GIN = 1, ST_PREP = 2, ST_MIX = 3, ST_S2 = 4, ST_S3 = 5, ST_GOUT = 6;
constexpr int NSTEP = 1 + NPASS * 2 * 7 + 1;

struct Params {
  const float *x, *c, *ctx, *c_ctx, *norm_w, *w_mod, *b_mod, *w_in, *ssd_conv_w, *ssd_conv_b, *ssd_dt_bias,
      *ssd_a_log, *ssd_d, *ssd_norm_w, *sc_conv_w, *attn_sink, *w_out, *final_norm_w;
  float* out;
  bf16_t *WinT, *WoutT, *H, *PXBC, *PSC, *PZ, *PATT, *XT, *BR, *CR, *BT, *QR, *KR, *VT, *Y, *SIN;
  float *MOD, *CTX1, *DTRAW, *CUMT, *VV, *EC, *WW, *SSQ, *LST, *ROPE, *PART;
  unsigned* bar;
};

__device__ __forceinline__ int opq_tid() { int t = threadIdx.x; asm volatile("" : "+v"(t)); return t; }
__device__ __forceinline__ int opq_bid() { int b = blockIdx.x; asm volatile("" : "+s"(b)); return b; }
typedef __attribute__((ext_vector_type(2))) __bf16 bfv2;
typedef __attribute__((ext_vector_type(2))) float f32x2;
typedef __attribute__((ext_vector_type(4))) unsigned u32x4;
__device__ __forceinline__ unsigned pk2(float a, float b) {
  f32x2 v = {a, b};
  bfv2 r = __builtin_convertvector(v, bfv2);
  return *(unsigned*)&r;
}
__device__ __forceinline__ bf16_t f2bf(float f) { return (bf16_t)(pk2(f, 0.f) & 0xffffu); }
__device__ __forceinline__ bf16x8 pack8(f32x4 a, f32x4 b) {
  u32x4 u = {pk2(a[0], a[1]), pk2(a[2], a[3]), pk2(b[0], b[1]), pk2(b[2], b[3])};
  return *(bf16x8*)&u;
}
__device__ __forceinline__ float bf2f(bf16_t h) { return __uint_as_float(((unsigned)h) << 16); }
__device__ __forceinline__ float silu_f(float v) { return v * __builtin_amdgcn_rcpf(1.f + __expf(-v)); }
__device__ __forceinline__ float wave_sum(float v) {
#pragma unroll
  for (int o = 32; o > 0; o >>= 1) v += __shfl_xor(v, o);
  return v;
}

#define XB_TMO      128
#define XB_XCNT(j)  (256  + 64 * (j))
#define XB_XSUB(j)  (1280 + 64 * (j))
#define XB_XGEN(j)  (2304 + 64 * (j))
#define XB_TOP      3328
#define XB_TOPGEN   3392
#define XCD_BAR_WORDS 3456
#define XB_SPIN_CAP (1u << 18)
#define LAS __attribute__((address_space(3)))

__device__ __forceinline__ unsigned xb_ld(unsigned* p)              { return __hip_atomic_load(p, __ATOMIC_RELAXED, __HIP_MEMORY_SCOPE_AGENT); }
__device__ __forceinline__ unsigned xb_add(unsigned* p, unsigned v) { return __hip_atomic_fetch_add(p, v, __ATOMIC_RELAXED, __HIP_MEMORY_SCOPE_AGENT); }
__device__ __forceinline__ unsigned xb_xcc_id() { return (unsigned)__builtin_amdgcn_s_getreg((3 << 11) | 20) & 0xFu; }
#define XB_SPIN(cond, bar) do { unsigned _sp = 0; while (cond) { __builtin_amdgcn_s_sleep(1); \
    if ((++_sp & 255u) == 0u) { if (xb_ld(&(bar)[XB_TMO])) break; if (_sp > XB_SPIN_CAP) { atomicAdd(&(bar)[XB_TMO], 1u); break; } } } } while (0)

struct XcdBarrier {
    unsigned* bar; unsigned x;
    volatile LAS unsigned* st;
};

__device__ __forceinline__ XcdBarrier xcd_barrier_post(unsigned* bar, volatile LAS unsigned* st) {
    XcdBarrier b; b.bar = bar; b.x = xb_xcc_id(); b.st = st;
    if (threadIdx.x == 0) (void)xb_add(&bar[XB_XCNT(b.x)], 1u);
    return b;
}
__device__ __forceinline__ void xcd_barrier_complete(unsigned* bar, unsigned x, unsigned& nloc, unsigned& nx) {
    const unsigned G = gridDim.x * gridDim.y * gridDim.z;
    unsigned sum, cnt, mine, sp = 0u;
    for (;;) {
        sum = 0u; cnt = 0u; mine = 0u;
#pragma unroll
        for (unsigned j = 0; j < 16; ++j) { const unsigned c = xb_ld(&bar[XB_XCNT(j)]); sum += c; cnt += (c > 0u) ? 1u : 0u; mine = (j == x) ? c : mine; }
        if (sum == G) break;
        __builtin_amdgcn_s_sleep(1);
        if ((++sp & 255u) == 0u) { if (xb_ld(&bar[XB_TMO])) break; if (sp > XB_SPIN_CAP) { atomicAdd(&bar[XB_TMO], 1u); break; } }
    }
    nloc = mine > 0u ? mine : 1u; nx = cnt > 0u ? cnt : 1u;
}

__device__ __forceinline__ void xcd_barrier(const XcdBarrier& b) {
    asm volatile("s_waitcnt vmcnt(0)" ::: "memory");
    __syncthreads();
    if (threadIdx.x == 0) {
        unsigned* bar = b.bar;
        __builtin_amdgcn_s_waitcnt(0);
        unsigned nloc = b.st[0], nx = b.st[1];
        if (nloc == 0u) { xcd_barrier_complete(bar, b.x, nloc, nx); b.st[0] = nloc; b.st[1] = nx; }
        const unsigned old = xb_add(&bar[XB_XSUB(b.x)], 1u);
        const unsigned gen = old / nloc;
        if (old + 1u == (gen + 1u) * nloc) {
            __builtin_amdgcn_fence(__ATOMIC_RELEASE, "agent");
            asm volatile("s_waitcnt vmcnt(0)" ::: "memory");
            const unsigned og = xb_add(&bar[XB_TOP], 1u);
            const unsigned tg = og / nx;
            if (og + 1u == (tg + 1u) * nx) xb_add(&bar[XB_TOPGEN], 1u);
            else XB_SPIN(xb_ld(&bar[XB_TOPGEN]) == tg, bar);
            __builtin_amdgcn_fence(__ATOMIC_ACQUIRE, "agent");
            xb_add(&bar[XB_XGEN(b.x)], 1u);
            asm volatile("s_waitcnt vmcnt(0)" ::: "memory");
        } else {
            XB_SPIN(xb_ld(&bar[XB_XGEN(b.x)]) == gen, bar);
            __builtin_amdgcn_fence(__ATOMIC_ACQUIRE, "agent");
            asm volatile("s_waitcnt vmcnt(0)" ::: "memory");
        }
    }
    __syncthreads();
}


__device__ void phase_weights(const Params& p, float* smem) {
  const int tid = opq_tid();
  const int NW1 = 2 * 94 * 16, NW2 = 2 * 16 * 32, NM = 192;
  auto load_tile = [&](int it, float* sm) __attribute__((always_inline)) {
    float v[16];
    if (it < NW1) {
      int l = it / (94 * 16), r = it % (94 * 16), nt = r / 16, kt = r % 16;
#pragma unroll
      for (int j = 0; j < 16; ++j) {
        int e = tid + 256 * j, kk = e >> 6, nn = e & 63;
        int n = nt * 64 + nn;
        int oc = (n < 2560) ? n : (n < 5888 ? n + 32 : (n < 5920 ? n - 5888 + 2560 : -1));
        v[j] = (oc >= 0) ? p.w_in[((size_t)l * 1024 + kt * 64 + kk) * 5920 + oc] : 0.f;
      }
    } else {
      int i2 = it - NW1;
      int l = i2 / 512, r = i2 % 512, nt = r / 32, kt = r % 32;
#pragma unroll
      for (int j = 0; j < 16; ++j) {
        int e = tid + 256 * j, kk = e >> 6, nn = e & 63;
        int k = kt * 64 + kk;
        float w = p.w_out[((size_t)l * 2048 + k) * 1024 + nt * 64 + nn];
        v[j] = (k < 1024) ? w * p.ssd_norm_w[l * 1024 + k] : w;
      }
    }
#pragma unroll
    for (int j = 0; j < 16; ++j) { int e = tid + 256 * j; sm[(e >> 6) * 65 + (e & 63)] = v[j]; }
  };
  auto store_tile = [&](int it, const float* sm) __attribute__((always_inline)) {
    if (it < NW1) {
      int l = it / (94 * 16), r = it % (94 * 16), nt = r / 16, kt = r % 16;
#pragma unroll
      for (int j = 0; j < 16; ++j) {
        int e = tid + 256 * j, nn = e >> 6, kk = e & 63;
        p.WinT[((size_t)l * NWIN + nt * 64 + nn) * 1024 + kt * 64 + kk] = f2bf(sm[kk * 65 + nn]);
      }
    } else {
      int i2 = it - NW1;
      int l = i2 / 512, r = i2 % 512, nt = r / 32, kt = r % 32;
#pragma unroll
      for (int j = 0; j < 16; ++j) {
        int e = tid + 256 * j, nn = e >> 6, kk = e & 63;
        p.WoutT[((size_t)l * 1024 + nt * 64 + nn) * 2048 + kt * 64 + kk] = f2bf(sm[kk * 65 + nn]);
      }
    }
  };
  for (int it = opq_bid(); it < NW1 + NW2; it += 2 * gridDim.x) {
    const int it2 = it + gridDim.x;
    const bool has2 = it2 < NW1 + NW2;
    load_tile(it, smem);
    if (has2) load_tile(it2, smem + 4224);
    __syncthreads();
    store_tile(it, smem);
    if (has2) store_tile(it2, smem + 4224);
    __syncthreads();
  }
  for (int it = opq_bid(); it < NW1 + NW2 + NM; it += gridDim.x) {
    if (it < NW1 + NW2) continue;
    {
      int i3 = it - NW1 - NW2;
      int l = i3 / 96, jb = i3 % 96;
      float* sc = smem;
      float* part = smem + 5120;
      for (int e = tid; e < 5120; e += 256) {
        int r = e >> 10, k = e & 1023;
        float v = (r < 4) ? p.c[r * 1024 + k] : p.c_ctx[k];
        sc[e] = silu_f(v);
      }
      __syncthreads();
      int col = tid & 31, kg = tid >> 5;
      float a0 = 0, a1 = 0, a2 = 0, a3 = 0, a4 = 0;
      const float* wp = p.w_mod + ((size_t)l * 1024 + kg * 128) * 3072 + jb * 32 + col;
      for (int k0 = 0; k0 < 128; k0 += 16) {
        float wv[16];
#pragma unroll
        for (int j = 0; j < 16; ++j) wv[j] = wp[(size_t)(k0 + j) * 3072];
#pragma unroll
        for (int j = 0; j < 16; ++j) {
          int k = kg * 128 + k0 + j;
          a0 += sc[k] * wv[j]; a1 += sc[1024 + k] * wv[j]; a2 += sc[2048 + k] * wv[j]; a3 += sc[3072 + k] * wv[j]; a4 += sc[4096 + k] * wv[j];
        }
      }
      part[(kg * 5 + 0) * 32 + col] = a0; part[(kg * 5 + 1) * 32 + col] = a1; part[(kg * 5 + 2) * 32 + col] = a2;
      part[(kg * 5 + 3) * 32 + col] = a3; part[(kg * 5 + 4) * 32 + col] = a4;
      __syncthreads();
      if (tid < 160) {
        int r = tid >> 5, cc = tid & 31;
        float s = 0.f;
#pragma unroll
        for (int g8 = 0; g8 < 8; ++g8) s += part[(g8 * 5 + r) * 32 + cc];
        p.MOD[((size_t)l * 5 + r) * 3072 + jb * 32 + cc] = s + p.b_mod[l * 3072 + jb * 32 + cc];
      }
      if (i3 == 0) {
        for (int e = tid; e < 1024; e += 256) {
          int pos = e >> 4, i = e & 15;
          float inv = powf(10000.f, -(float)i * (1.f / 16.f));
          float ang = (float)pos * inv;
          p.ROPE[2 * e] = cosf(ang); p.ROPE[2 * e + 1] = sinf(ang);
        }
      }
      __syncthreads();
    }
  }
}

__device__ void phase_norm(const Params& p, int layer, int pass) {
  const int lane = opq_tid() & 63;
  const int gw = opq_bid() * 4 + (opq_tid() >> 6), nw = gridDim.x * 4;
  const int b0 = pass * NB;
  for (int row = gw; row < NT; row += nw) {
    const float* src; int mrow;
    if (row < NTL) { src = (layer == 0 ? p.x : p.out) + ((size_t)b0 * SEQ + row) * D; mrow = b0 + row / SEQ; }
    else { src = (layer == 0 ? p.ctx : p.CTX1) + ((size_t)b0 * CTXL + (row - NTL)) * D; mrow = 4; }
    const float* mod = p.MOD + ((size_t)layer * 5 + mrow) * 3072;
    float4 v[4]; float ss = 0.f;
    const bool from_parts = (layer == 1 && row >= NTL);
    if (from_parts) src = p.ctx + ((size_t)b0 * CTXL + (row - NTL)) * D;
#pragma unroll
    for (int i = 0; i < 4; ++i) {
      v[i] = *(const float4*)(src + (i * 64 + lane) * 4);
      if (from_parts) {
        int k = (i * 64 + lane) * 4;
        float4 a = {0.f, 0.f, 0.f, 0.f};
#pragma unroll
        for (int ks = 0; ks < 8; ++ks) {
          float4 q = *(const float4*)(p.PART + ((size_t)ks * NTC + (row - NTL)) * D + k);
          a.x += q.x; a.y += q.y; a.z += q.z; a.w += q.w;
        }
        float4 gt = *(const float4*)(p.MOD + ((size_t)0 * 5 + 4) * 3072 + 2048 + k);
        v[i].x += gt.x * a.x; v[i].y += gt.y * a.y; v[i].z += gt.z * a.z; v[i].w += gt.w * a.w;
      }
      ss += v[i].x * v[i].x + v[i].y * v[i].y + v[i].z * v[i].z + v[i].w * v[i].w;
    }
    ss = wave_sum(ss);
    float rstd = rsqrtf(ss * (1.f / D) + EPS);
#pragma unroll
    for (int i = 0; i < 4; ++i) {
      int k = (i * 64 + lane) * 4;
      float4 nwv = *(const float4*)(p.norm_w + layer * D + k);
      float4 sh = *(const float4*)(mod + k);
      float4 scl = *(const float4*)(mod + 1024 + k);
      bf16x4 o;
      o[0] = (short)f2bf(v[i].x * rstd * nwv.x * (1.f + scl.x) + sh.x);
      o[1] = (short)f2bf(v[i].y * rstd * nwv.y * (1.f + scl.y) + sh.y);
      o[2] = (short)f2bf(v[i].z * rstd * nwv.z * (1.f + scl.z) + sh.z);
      o[3] = (short)f2bf(v[i].w * rstd * nwv.w * (1.f + scl.w) + sh.w);
      *(bf16x4*)(p.H + (size_t)row * D + k) = o;
    }
  }
}

__device__ __forceinline__ void epi_store(const Params& p, int mode, int layer, int pass, int m, int n, float v) {
  if (mode == 0) {
    if (n < 1024) p.PZ[(size_t)m * 1024 + n] = f2bf(v);
    else if (n < 2560) p.PXBC[(size_t)m * 1536 + (n - 1024)] = f2bf(v);
    else if (n < 4608) p.PSC[(size_t)m * 2048 + (n - 2560)] = f2bf(v);
    else if (n < 5888) p.PATT[(size_t)m * 1280 + (n - 4608)] = f2bf(v);
    else if (n < 5920) p.DTRAW[(size_t)m * 32 + (n - 5888)] = v;
  } else {
    const int b0 = pass * NB;
    if (m < NTL) {
      int b = b0 + m / SEQ;
      float g = p.MOD[((size_t)layer * 5 + b) * 3072 + 2048 + n];
      size_t idx = ((size_t)b0 * SEQ + m) * D + n;
      float xo = (layer == 0) ? p.x[idx] : p.out[idx];
      p.out[idx] = xo + g * v;
    } else {
      float g = p.MOD[((size_t)layer * 5 + 4) * 3072 + 2048 + n];
      size_t idx = ((size_t)b0 * CTXL + (m - NTL)) * D + n;
      p.CTX1[idx] = p.ctx[idx] + g * v;
    }
  }
}

__device__ void phase_gemm_naive(const Params& p, int mode, int layer, int pass, float* smem) {
  const int M = (mode == 0) ? NT : (layer == 0 ? NT : NTL);
  const int N = (mode == 0) ? NWIN : 1024;
  const int K = (mode == 0) ? 1024 : 2048;
  const bf16_t* A = (mode == 0) ? p.H : p.Y;
  const bf16_t* Bt = (mode == 0) ? p.WinT + (size_t)layer * NWIN * 1024 : p.WoutT + (size_t)layer * 1024 * 2048;
  const int tm = M / 64, tn = N / 64;
  const int tid = opq_tid(), tx = tid & 15, ty = tid >> 4;
  float* As = smem;
  float* Bs = smem + 16 * 68;
  for (int t = opq_bid(); t < tm * tn; t += gridDim.x) {
    int m0 = (t / tn) * 64, n0 = (t % tn) * 64;
    float acc[4][4];
#pragma unroll
    for (int i = 0; i < 4; ++i)
#pragma unroll
      for (int j = 0; j < 4; ++j) acc[i][j] = 0.f;
    int lr = tid >> 2, kq = (tid & 3) * 4;
    for (int k0 = 0; k0 < K; k0 += 16) {
      bf16x4 av = *(const bf16x4*)(A + (size_t)(m0 + lr) * K + k0 + kq);
      bf16x4 bv = *(const bf16x4*)(Bt + (size_t)(n0 + lr) * K + k0 + kq);
#pragma unroll
      for (int j = 0; j < 4; ++j) {
        As[(kq + j) * 68 + lr] = bf2f((bf16_t)av[j]);
        Bs[(kq + j) * 68 + lr] = bf2f((bf16_t)bv[j]);
      }
      __syncthreads();
#pragma unroll
      for (int kk = 0; kk < 16; ++kk) {
        float4 a4 = *(const float4*)(As + kk * 68 + ty * 4);
        float4 b4 = *(const float4*)(Bs + kk * 68 + tx * 4);
        float a[4] = {a4.x, a4.y, a4.z, a4.w}, b[4] = {b4.x, b4.y, b4.z, b4.w};
#pragma unroll
        for (int i = 0; i < 4; ++i)
#pragma unroll
          for (int j = 0; j < 4; ++j) acc[i][j] += a[i] * b[j];
      }
      __syncthreads();
    }
#pragma unroll
    for (int i = 0; i < 4; ++i)
#pragma unroll
      for (int j = 0; j < 4; ++j) epi_store(p, mode, layer, pass, m0 + ty * 4 + i, n0 + tx * 4 + j, acc[i][j]);
  }
}

__device__ void phase_gemm_mfma(const Params& p, int mode, int layer, int pass, bf16_t* smem) {
  const bool do_split = (mode == 1 && layer == 0);
  const bool ctx_sparse = (mode == 0 && layer == 1);
  const int M = (mode == 0 && !ctx_sparse) ? NT : NTL;
  const int N = (mode == 0) ? NWIN : 1024;
  const int K = (mode == 0) ? 1024 : 2048;
  const bf16_t* A = (mode == 0) ? p.H : p.Y;
  const bf16_t* Bt = (mode == 0) ? p.WinT + (size_t)layer * NWIN * 1024 : p.WoutT + (size_t)layer * 1024 * 2048;
  const int tm = M / 128, tn = N / 128, T_main = tm * tn, T = T_main + (ctx_sparse ? 60 : 0);
  const int tid = opq_tid(), lane = tid & 63, wid = tid >> 6, wm = wid >> 1, wn = wid & 1;
  const int lr = lane & 31, lh = lane >> 5;
  bf16_t* As = smem;
  bf16_t* Bs = smem + 128 * 72;
  float* rsS = (float*)(smem + 2 * 128 * 72);
  const int bid = opq_bid();
  int tstart = 0, tend = T, lb = bid, nbx = gridDim.x;
  if ((gridDim.x & 7) == 0) {
    int xcd = bid & 7; lb = bid >> 3; nbx = gridDim.x >> 3;
    tstart = (int)((long)T * xcd / 8); tend = (int)((long)T * (xcd + 1) / 8);
  }
  const int ng_full = tn / 8, rem = tn % 8, per_group = tm * 8;
  const int nk = K / 64;
  const int sr = tid >> 3, sc = (tid & 7) * 8;
  const int b0 = pass * NB;
  auto tile = [&](const int mi, const int ni, auto split_tag, const int ks) __attribute__((always_inline)) {
    constexpr bool SPLIT = decltype(split_tag)::value;
    const int kt0 = SPLIT ? ks * 4 : 0;
    const int kt1 = SPLIT ? kt0 + 4 : nk;
    const int m0 = mi * 128, n0 = ni * 128;
    f32x16 acc[2][2];
#pragma unroll
    for (int i = 0; i < 2; ++i)
#pragma unroll
      for (int j = 0; j < 2; ++j)
#pragma unroll
        for (int r = 0; r < 16; ++r) acc[i][j][r] = 0.f;
    const bf16_t* ga = A + (size_t)(m0 + sr) * K + sc + kt0 * 64;
    const bf16_t* gb = Bt + (size_t)(n0 + sr) * K + sc + kt0 * 64;
    bf16x8 ra[4], rb[4];
#pragma unroll
    for (int i = 0; i < 4; ++i) { ra[i] = *(const bf16x8*)(ga + (size_t)i * 32 * K); rb[i] = *(const bf16x8*)(gb + (size_t)i * 32 * K); }
    if (mode == 1) {
      int row = m0 + (tid >> 1), grp = tid & 1;
      const float* sp = p.SSQ + (size_t)row * 16 + grp * 8;
      f32x4 s0 = *(const f32x4*)sp, s1 = *(const f32x4*)(sp + 4);
      float ss = s0[0] + s0[1] + s0[2] + s0[3] + s1[0] + s1[1] + s1[2] + s1[3];
      rsS[tid] = rsqrtf(ss * (1.f / 512.f) + EPS);
    }
    if (mode == 1 && !SPLIT) {
      bf16x8 ra2[4], rb2[4];
#pragma unroll
      for (int i = 0; i < 4; ++i) {
        ra2[i] = *(const bf16x8*)(ga + (size_t)i * 32 * K + 64);
        rb2[i] = *(const bf16x8*)(gb + (size_t)i * 32 * K + 64);
      }
      auto mma4 = [&]() __attribute__((always_inline)) {
#pragma unroll
        for (int kk = 0; kk < 4; ++kk) {
          bf16x8 a0 = *(const bf16x8*)(As + (wm * 64 + lr) * 72 + kk * 16 + lh * 8);
          bf16x8 a1 = *(const bf16x8*)(As + (wm * 64 + 32 + lr) * 72 + kk * 16 + lh * 8);
          bf16x8 b0v = *(const bf16x8*)(Bs + (wn * 64 + lr) * 72 + kk * 16 + lh * 8);
          bf16x8 b1v = *(const bf16x8*)(Bs + (wn * 64 + 32 + lr) * 72 + kk * 16 + lh * 8);
          acc[0][0] = __builtin_amdgcn_mfma_f32_32x32x16_bf16(a0, b0v, acc[0][0], 0, 0, 0);
          acc[0][1] = __builtin_amdgcn_mfma_f32_32x32x16_bf16(a0, b1v, acc[0][1], 0, 0, 0);
          acc[1][0] = __builtin_amdgcn_mfma_f32_32x32x16_bf16(a1, b0v, acc[1][0], 0, 0, 0);
          acc[1][1] = __builtin_amdgcn_mfma_f32_32x32x16_bf16(a1, b1v, acc[1][1], 0, 0, 0);
        }
      };
      for (int kt = 0; kt < 32; kt += 2) {
        __syncthreads();
#pragma unroll
        for (int i = 0; i < 4; ++i) {
          *(bf16x8*)(As + (sr + i * 32) * 72 + sc) = ra[i];
          *(bf16x8*)(Bs + (sr + i * 32) * 72 + sc) = rb[i];
        }
        __syncthreads();
        if (kt + 2 < 32) {
#pragma unroll
          for (int i = 0; i < 4; ++i) {
            ra[i] = *(const bf16x8*)(ga + (size_t)i * 32 * K + (kt + 2) * 64);
            rb[i] = *(const bf16x8*)(gb + (size_t)i * 32 * K + (kt + 2) * 64);
          }
        }
        mma4();
        __syncthreads();
#pragma unroll
        for (int i = 0; i < 4; ++i) {
          *(bf16x8*)(As + (sr + i * 32) * 72 + sc) = ra2[i];
          *(bf16x8*)(Bs + (sr + i * 32) * 72 + sc) = rb2[i];
        }
        __syncthreads();
        if (kt + 3 < 32) {
#pragma unroll
          for (int i = 0; i < 4; ++i) {
            ra2[i] = *(const bf16x8*)(ga + (size_t)i * 32 * K + (kt + 3) * 64);
            rb2[i] = *(const bf16x8*)(gb + (size_t)i * 32 * K + (kt + 3) * 64);
          }
        }
        mma4();
        if (kt == 6 || kt == 14) {
#pragma unroll
          for (int i = 0; i < 2; ++i)
#pragma unroll
            for (int r = 0; r < 16; ++r) {
              int lrow = wm * 64 + i * 32 + (r & 3) + 8 * (r >> 2) + 4 * lh;
              float r0 = rsS[lrow * 2], r1 = rsS[lrow * 2 + 1];
              float f = (kt == 6) ? r0 * __builtin_amdgcn_rcpf(r1) : r1;
              acc[i][0][r] *= f; acc[i][1][r] *= f;
            }
        }
      }
    } else
    for (int kt = kt0; kt < kt1; ++kt) {
      __syncthreads();
#pragma unroll
      for (int i = 0; i < 4; ++i) {
        *(bf16x8*)(As + (sr + i * 32) * 72 + sc) = ra[i];
        *(bf16x8*)(Bs + (sr + i * 32) * 72 + sc) = rb[i];
      }
      __syncthreads();
      if (kt + 1 < kt1) {
#pragma unroll
        for (int i = 0; i < 4; ++i) {
          ra[i] = *(const bf16x8*)(ga + (size_t)i * 32 * K + (kt + 1 - kt0) * 64);
          rb[i] = *(const bf16x8*)(gb + (size_t)i * 32 * K + (kt + 1 - kt0) * 64);
        }
      }
#pragma unroll
      for (int kk = 0; kk < 4; ++kk) {
        bf16x8 a0 = *(const bf16x8*)(As + (wm * 64 + lr) * 72 + kk * 16 + lh * 8);
        bf16x8 a1 = *(const bf16x8*)(As + (wm * 64 + 32 + lr) * 72 + kk * 16 + lh * 8);
        bf16x8 b0v = *(const bf16x8*)(Bs + (wn * 64 + lr) * 72 + kk * 16 + lh * 8);
        bf16x8 b1v = *(const bf16x8*)(Bs + (wn * 64 + 32 + lr) * 72 + kk * 16 + lh * 8);
        acc[0][0] = __builtin_amdgcn_mfma_f32_32x32x16_bf16(a0, b0v, acc[0][0], 0, 0, 0);
        acc[0][1] = __builtin_amdgcn_mfma_f32_32x32x16_bf16(a0, b1v, acc[0][1], 0, 0, 0);
        acc[1][0] = __builtin_amdgcn_mfma_f32_32x32x16_bf16(a1, b0v, acc[1][0], 0, 0, 0);
        acc[1][1] = __builtin_amdgcn_mfma_f32_32x32x16_bf16(a1, b1v, acc[1][1], 0, 0, 0);
      }
      if (mode == 1 && !SPLIT && (kt == 7 || kt == 15)) {
#pragma unroll
        for (int i = 0; i < 2; ++i)
#pragma unroll
          for (int r = 0; r < 16; ++r) {
            int lrow = wm * 64 + i * 32 + (r & 3) + 8 * (r >> 2) + 4 * lh;
            float r0 = rsS[lrow * 2], r1 = rsS[lrow * 2 + 1];
            float f = (kt == 7) ? r0 * __builtin_amdgcn_rcpf(r1) : r1;
            acc[i][0][r] *= f; acc[i][1][r] *= f;
          }
      }
    }
    if (mode == 0) {
      if (ni < 46) {
        bf16_t* dst; int ld, cb;
        if (ni < 8) { dst = p.PZ; ld = 1024; cb = ni * 128; }
        else if (ni < 20) { dst = p.PXBC; ld = 1536; cb = (ni - 8) * 128; }
        else if (ni < 36) { dst = p.PSC; ld = 2048; cb = (ni - 20) * 128; }
        else { dst = p.PATT; ld = 1280; cb = (ni - 36) * 128; }
#pragma unroll
        for (int i = 0; i < 2; ++i)
#pragma unroll
          for (int j = 0; j < 2; ++j)
#pragma unroll
            for (int r = 0; r < 16; ++r) {
              int row = m0 + wm * 64 + i * 32 + (r & 3) + 8 * (r >> 2) + 4 * lh;
              int col = cb + wn * 64 + j * 32 + lr;
              dst[(size_t)row * ld + col] = f2bf(acc[i][j][r]);
            }
      } else if (wn == 0) {
#pragma unroll
        for (int i = 0; i < 2; ++i)
#pragma unroll
          for (int r = 0; r < 16; ++r) {
            int row = m0 + wm * 64 + i * 32 + (r & 3) + 8 * (r >> 2) + 4 * lh;
            p.DTRAW[(size_t)row * 32 + lr] = acc[i][0][r];
          }
      }
    } else if (!SPLIT) {
      float* Os = (float*)smem;
      const int ocol4 = (tid & 31) * 4, orow = tid >> 5;
      const int b = b0 + m0 / SEQ;
      const float4 g4 = *(const float4*)(p.MOD + ((size_t)layer * 5 + b) * 3072 + 2048 + n0 + ocol4);
      __syncthreads();
#pragma unroll
      for (int half = 0; half < 2; ++half) {
        if (wm == half) {
#pragma unroll
          for (int i = 0; i < 2; ++i)
#pragma unroll
            for (int j = 0; j < 2; ++j)
#pragma unroll
              for (int r = 0; r < 16; ++r)
                Os[(i * 32 + (r & 3) + 8 * (r >> 2) + 4 * lh) * 132 + wn * 64 + j * 32 + lr] = acc[i][j][r];
        }
        __syncthreads();
#pragma unroll 4
        for (int k = 0; k < 8; ++k) {
          int row = orow + 8 * k;
          float4 v = *(const float4*)(Os + row * 132 + ocol4);
          size_t idx = ((size_t)b0 * SEQ + m0 + half * 64 + row) * D + n0 + ocol4;
          float4 x4 = (layer == 0) ? *(const float4*)(p.x + idx) : *(const float4*)(p.out + idx);
          float4 o = {x4.x + g4.x * v.x, x4.y + g4.y * v.y, x4.z + g4.z * v.z, x4.w + g4.w * v.w};
          *(float4*)(p.out + idx) = o;
        }
        __syncthreads();
      }
    } else {
#pragma unroll
      for (int i = 0; i < 2; ++i)
#pragma unroll
        for (int j = 0; j < 2; ++j)
#pragma unroll
          for (int r = 0; r < 16; ++r) {
            int row = m0 + wm * 64 + i * 32 + (r & 3) + 8 * (r >> 2) + 4 * lh;
            int col = n0 + wn * 64 + j * 32 + lr;
            int lrow = row - m0;
            float f = (ks < 4) ? rsS[lrow * 2 + (ks >> 1)] : 1.f;
            p.PART[((size_t)ks * NTC + (row - NTL)) * D + col] = acc[i][j][r] * f;
          }
    }
  };
  for (int t = tstart + lb; t < tend; t += nbx) {
    int mi, ni;
    if (t >= T_main) { int e = t - T_main, j = e % 15; mi = 64 + e / 15; ni = (j < 12) ? 8 + j : ((j < 14) ? 28 + j : 46); }
    else if (t < ng_full * per_group) { int ng = t / per_group, r = t % per_group; mi = r >> 3; ni = ng * 8 + (r & 7); }
    else { int r = t - ng_full * per_group; mi = r / rem; ni = ng_full * 8 + r % rem; }
    tile(mi, ni, std::integral_constant<bool, false>{}, -1);
  }
  if (do_split) {
    for (int s = bid; s < 256; s += gridDim.x) {
      int ct = s >> 3, ks = s & 7;
      tile(64 + (ct >> 3), ct & 7, std::integral_constant<bool, true>{}, ks);
    }
  }
}

__device__ void phase_gemm_in256(const Params& p, int layer, int pass, bf16_t* smem) {
  constexpr int K = 1024, nk = 16;
  const bf16_t* A = p.H;
  const bf16_t* Bt = p.WinT + (size_t)layer * NWIN * 1024;
  const bool ctx_sparse = (layer == 1);
  const int tm = (ctx_sparse ? NTL : NT) / 256, tn = NWIN / 128, T_main = tm * tn, T = T_main + (ctx_sparse ? 30 : 0);
  const int tid = opq_tid(), lane = tid & 63, wid = tid >> 6, wm = wid >> 1, wn = wid & 1;
  const int lr = lane & 31, lh = lane >> 5;
  bf16_t* As = smem;
  bf16_t* Bs = smem + 256 * 72;
  const int bid = opq_bid();
  int tstart = 0, tend = T, lb = bid, nbx = gridDim.x;
  if ((gridDim.x & 7) == 0) {
    int xcd = bid & 7; lb = bid >> 3; nbx = gridDim.x >> 3;
    tstart = (int)((long)T * xcd / 8); tend = (int)((long)T * (xcd + 1) / 8);
  }
  const int ng_full = tn / 8, rem = tn % 8, per_group = tm * 8;
  const int sr = tid >> 3, sc = (tid & 7) * 8;
  for (int t = tstart + lb; t < tend; t += nbx) {
    int mi, ni;
    if (t >= T_main) { int e = t - T_main, j = e % 15; mi = 32 + e / 15; ni = (j < 12) ? 8 + j : ((j < 14) ? 28 + j : 46); }
    else if (t < ng_full * per_group) { int ng = t / per_group, r = t % per_group; mi = r >> 3; ni = ng * 8 + (r & 7); }
    else { int r = t - ng_full * per_group; mi = r / rem; ni = ng_full * 8 + r % rem; }
    const int m0 = mi * 256, n0 = ni * 128;
    f32x16 acc[4][2];
#pragma unroll
    for (int i = 0; i < 4; ++i)
#pragma unroll
      for (int j = 0; j < 2; ++j)
#pragma unroll
        for (int r = 0; r < 16; ++r) acc[i][j][r] = 0.f;
    const bf16_t* ga = A + (size_t)(m0 + sr) * K + sc;
    const bf16_t* gb = Bt + (size_t)(n0 + sr) * K + sc;
    bf16x8 ra[8], rb[4];
#pragma unroll
    for (int i = 0; i < 8; ++i) ra[i] = *(const bf16x8*)(ga + (size_t)i * 32 * K);
#pragma unroll
    for (int i = 0; i < 4; ++i) rb[i] = *(const bf16x8*)(gb + (size_t)i * 32 * K);
    for (int kt = 0; kt < nk; ++kt) {
      __syncthreads();
#pragma unroll
      for (int i = 0; i < 8; ++i) *(bf16x8*)(As + (sr + i * 32) * 72 + sc) = ra[i];
#pragma unroll
      for (int i = 0; i < 4; ++i) *(bf16x8*)(Bs + (sr + i * 32) * 72 + sc) = rb[i];
      __syncthreads();
      if (kt + 1 < nk) {
#pragma unroll
        for (int i = 0; i < 8; ++i) ra[i] = *(const bf16x8*)(ga + (size_t)i * 32 * K + (kt + 1) * 64);
#pragma unroll
        for (int i = 0; i < 4; ++i) rb[i] = *(const bf16x8*)(gb + (size_t)i * 32 * K + (kt + 1) * 64);
      }
#pragma unroll
      for (int kk = 0; kk < 4; ++kk) {
        bf16x8 b0v = *(const bf16x8*)(Bs + (wn * 64 + lr) * 72 + kk * 16 + lh * 8);
        bf16x8 b1v = *(const bf16x8*)(Bs + (wn * 64 + 32 + lr) * 72 + kk * 16 + lh * 8);
#pragma unroll
        for (int i = 0; i < 4; ++i) {
          bf16x8 av = *(const bf16x8*)(As + (wm * 128 + i * 32 + lr) * 72 + kk * 16 + lh * 8);
          acc[i][0] = __builtin_amdgcn_mfma_f32_32x32x16_bf16(av, b0v, acc[i][0], 0, 0, 0);
          acc[i][1] = __builtin_amdgcn_mfma_f32_32x32x16_bf16(av, b1v, acc[i][1], 0, 0, 0);
        }
      }
    }
    if (ni < 46) {
      bf16_t* dst; int ld, cb;
      if (ni < 8) { dst = p.PZ; ld = 1024; cb = ni * 128; }
      else if (ni < 20) { dst = p.PXBC; ld = 1536; cb = (ni - 8) * 128; }
      else if (ni < 36) { dst = p.PSC; ld = 2048; cb = (ni - 20) * 128; }
      else { dst = p.PATT; ld = 1280; cb = (ni - 36) * 128; }
      bf16_t* Os = smem;
      __syncthreads();
#pragma unroll
      for (int half = 0; half < 2; ++half) {
        if (wm == half) {
          bf16_t* q = Os + (4 * lh) * 136 + wn * 64 + lr;
#pragma unroll
          for (int i = 0; i < 4; ++i)
#pragma unroll
            for (int j = 0; j < 2; ++j)
#pragma unroll
              for (int r = 0; r < 16; ++r) q[(i * 32 + (r & 3) + 8 * (r >> 2)) * 136 + j * 32] = f2bf(acc[i][j][r]);
        }
        __syncthreads();
        {
          const int orow = tid >> 4, ocol = (tid & 15) * 8;
          bf16_t* gd = dst + (size_t)(m0 + half * 128 + orow) * ld + cb + ocol;
#pragma unroll
          for (int k = 0; k < 8; ++k) {
            bf16x8 v = *(const bf16x8*)(Os + (orow + 16 * k) * 136 + ocol);
            *(bf16x8*)(gd + (size_t)(16 * k) * ld) = v;
          }
        }
        __syncthreads();
      }
    } else if (wn == 0) {
#pragma unroll
      for (int i = 0; i < 4; ++i)
#pragma unroll
        for (int r = 0; r < 16; ++r) {
          int row = m0 + wm * 128 + i * 32 + (r & 3) + 8 * (r >> 2) + 4 * lh;
          p.DTRAW[(size_t)row * 32 + lr] = acc[i][0][r];
        }
    }
  }
}

__device__ void phase_prep(const Params& p, int layer, int pass, float* smem) {
  const int tid = opq_tid(), lane = tid & 63;
  const int gw = opq_bid() * 4 + (tid >> 6), nw = gridDim.x * 4;
  for (int gc = opq_bid(); gc < NCH; gc += gridDim.x) {
    float* sda = smem; float* sdt = smem + 4224;
    for (int e = tid; e < 4096; e += 256) {
      int l = e >> 5, dh = e & 31;
      float raw = p.DTRAW[((size_t)gc * 128 + l) * 32 + dh] + p.ssd_dt_bias[layer * 32 + dh];
      float dt = raw > 20.f ? raw : log1pf(expf(raw));
      float A = -expf(p.ssd_a_log[layer * 32 + dh]);
      sdt[l * 33 + dh] = dt;
      sda[l * 33 + dh] = dt * A;
    }
    __syncthreads();
    {
      const int dh = tid & 31, seg = tid >> 5;
      float* segtot = smem + 8448;
      float loc[16]; float s = 0.f;
      if (dh < 16) {
#pragma unroll
        for (int j = 0; j < 16; ++j) { s += sda[(seg * 16 + j) * 33 + dh]; loc[j] = s; }
      } else {
#pragma unroll
        for (int j = 15; j >= 0; --j) { s += sda[(seg * 16 + j) * 33 + dh]; loc[j] = s; }
      }
      segtot[seg * 32 + dh] = s;
      __syncthreads();
      float off = 0.f;
      if (dh < 16) { for (int k = 0; k < seg; ++k) off += segtot[k * 32 + dh]; }
      else { for (int k = 7; k > seg; --k) off += segtot[k * 32 + dh]; }
#pragma unroll
      for (int j = 0; j < 16; ++j) sda[(seg * 16 + j) * 33 + dh] = loc[j] + off;
    }
    __syncthreads();
    for (int e = tid; e < 4096; e += 256) {
      int dh = e >> 7, l = e & 127;
      float cum = sda[l * 33 + dh], dt = sdt[l * 33 + dh];
      float tot = (dh < 16) ? sda[127 * 33 + dh] : sda[dh];
      size_t idx = ((size_t)gc * 32 + dh) * 128 + l;
      p.CUMT[idx] = cum;
      p.VV[idx] = cum - logf(fmaxf(dt, 1e-30f));
      p.EC[idx] = expf(cum);
      p.WW[idx] = dt * expf(tot - cum);
    }
    __syncthreads();
  }
  const int nchc = (layer == 0) ? NCH : 64;
  const int Nb = NCH * 4 * 24, Nc = nchc * 16, Nd = (NT * 40) / 64, Ne = NCH * 16 * 2;
  for (int uu = gw; uu < Nb + Nc + Nd + Ne; uu += nw) {
  if (uu < Nb) {
    const int u = uu;
    int cblk = u % 24, l32 = (u / 24) & 3, gc = u / (24 * 4);
    int c = cblk * 64 + lane;
    bool first, last;
    if (gc < 64) { first = (gc % 32 == 0) && l32 == 0; last = (gc % 32 == 31) && l32 == 3; }
    else { first = ((gc - 64) % 2 == 0) && l32 == 0; last = ((gc - 64) % 2 == 1) && l32 == 3; }
    int t0 = gc * 128 + l32 * 32;
    float w0 = p.ssd_conv_w[((size_t)layer * 3 + 0) * 1536 + c], w1 = p.ssd_conv_w[((size_t)layer * 3 + 1) * 1536 + c],
          w2 = p.ssd_conv_w[((size_t)layer * 3 + 2) * 1536 + c], bs = p.ssd_conv_b[layer * 1536 + c];
    bf16_t raw[34];
#pragma unroll
    for (int i = 0; i < 34; ++i) {
      bool ok = !((i == 0 && first) || (i == 33 && last));
      raw[i] = ok ? p.PXBC[(size_t)(t0 + i - 1) * 1536 + c] : (bf16_t)0;
    }
    bf16x8 o[4];
#pragma unroll
    for (int j = 0; j < 32; ++j)
      o[j >> 3][j & 7] = (short)f2bf(silu_f(w0 * bf2f(raw[j]) + w1 * bf2f(raw[j + 1]) + w2 * bf2f(raw[j + 2]) + bs));
    if (c < 1024) {
#pragma unroll
      for (int k = 0; k < 4; ++k) *(bf16x8*)(p.XT + ((size_t)gc * 1024 + c) * 128 + l32 * 32 + k * 8) = o[k];
    } else if (c < 1280) {
      int n = c - 1024;
#pragma unroll
      for (int k = 0; k < 4; ++k) *(bf16x8*)(p.BT + ((size_t)gc * 256 + n) * 128 + l32 * 32 + k * 8) = o[k];
#pragma unroll
      for (int j = 0; j < 32; ++j) p.BR[(size_t)(t0 + j) * 256 + n] = (bf16_t)o[j >> 3][j & 7];
    } else {
      int n = c - 1280;
#pragma unroll
      for (int j = 0; j < 32; ++j) p.CR[(size_t)(t0 + j) * 256 + n] = (bf16_t)o[j >> 3][j & 7];
    }
  } else if (uu < Nb + Nc) {
    {
      const int u = uu - Nb;
      const int l8 = u & 15, gc = u >> 4;
      const int c0 = lane * 8;
      bool first, last;
      if (gc < 64) { first = (gc % 32 == 0) && l8 == 0; last = (gc % 32 == 31) && l8 == 15; }
      else { first = ((gc - 64) % 2 == 0) && l8 == 0; last = ((gc - 64) % 2 == 1) && l8 == 15; }
      const int t0 = gc * 128 + l8 * 8;
      float w0[8], w1[8], w2[8];
      {
        const float* wp = p.sc_conv_w + (size_t)layer * 3 * 512 + c0;
        f32x4 a0 = *(const f32x4*)wp, a1 = *(const f32x4*)(wp + 4);
        f32x4 b0 = *(const f32x4*)(wp + 512), b1 = *(const f32x4*)(wp + 516);
        f32x4 d0 = *(const f32x4*)(wp + 1024), d1 = *(const f32x4*)(wp + 1028);
#pragma unroll
        for (int k = 0; k < 4; ++k) { w0[k] = a0[k]; w0[4 + k] = a1[k]; w1[k] = b0[k]; w1[4 + k] = b1[k]; w2[k] = d0[k]; w2[4 + k] = d1[k]; }
      }
      float up[10][8];
#pragma unroll
      for (int i = 0; i < 10; ++i) {
        bool ok = !((i == 0 && first) || (i == 9 && last));
        const bf16_t* r = p.PSC + (size_t)(t0 + i - 1) * 2048 + c0;
        bf16x8 v8 = ok ? *(const bf16x8*)r : bf16x8{0, 0, 0, 0, 0, 0, 0, 0};
        bf16x8 g8 = ok ? *(const bf16x8*)(r + 512) : bf16x8{0, 0, 0, 0, 0, 0, 0, 0};
#pragma unroll
        for (int k = 0; k < 8; ++k) up[i][k] = bf2f((bf16_t)v8[k]) * bf2f((bf16_t)g8[k]);
      }
#pragma unroll
      for (int j = 0; j < 8; ++j) {
        const bf16_t* r = p.PSC + (size_t)(t0 + j) * 2048 + c0;
        bf16x8 b8 = *(const bf16x8*)(r + 1024), z8 = *(const bf16x8*)(r + 1536);
        f32x4 lo, hi;
#pragma unroll
        for (int k = 0; k < 8; ++k) {
          float cv = w0[k] * up[j][k] + w1[k] * up[j + 1][k] + w2[k] * up[j + 2][k];
          float o = bf2f((bf16_t)b8[k]) * cv * silu_f(bf2f((bf16_t)z8[k]));
          if (k < 4) lo[k] = o; else hi[k - 4] = o;
        }
        *(bf16x8*)(p.Y + (size_t)(t0 + j) * 2048 + 1024 + c0) = pack8(lo, hi);
      }
    }
  } else if (uu < Nb + Nc + Nd) {
    {
      const int idx = (uu - Nb - Nc) * 64 + lane;
      int row = idx / 40, r = idx % 40;
      int slot = r >> 2, a = (r >> 1) & 1, i0 = (r & 1) * 8;
      const bf16_t* src = p.PATT + (size_t)row * 1280 + (slot < 8 ? slot * 64 : 512 + (slot - 8) * 64) + a * 32 + i0;
      bf16x8 x1 = *(const bf16x8*)src, x2 = *(const bf16x8*)(src + 16);
      bf16x8 o1, o2;
      if (row < NTL) {
        int t = row & (SEQ - 1);
        int pos = (a == 0) ? (t >> 6) : (t & 63);
        const float* tb = p.ROPE + (pos * 16 + i0) * 2;
#pragma unroll
        for (int j = 0; j < 8; ++j) {
          float cs = tb[2 * j], sn = tb[2 * j + 1];
          float a1 = bf2f((bf16_t)x1[j]), a2 = bf2f((bf16_t)x2[j]);
          o1[j] = (short)f2bf(a1 * cs - a2 * sn);
          o2[j] = (short)f2bf(a1 * sn + a2 * cs);
        }
      } else { o1 = x1; o2 = x2; }
      bf16_t* dst = (slot < 8) ? p.QR + (size_t)row * 512 + slot * 64 + a * 32 + i0
                               : p.KR + (size_t)row * 128 + (slot - 8) * 64 + a * 32 + i0;
      *(bf16x8*)dst = o1; *(bf16x8*)(dst + 16) = o2;
    }
  } else {
    const int u = uu - Nb - Nc - Nd;
    int half = u & 1, l8 = (u >> 1) & 15, gc = u >> 5;
    int c = half * 64 + lane;
    int t0 = gc * 128 + l8 * 8;
    bf16x8 o;
#pragma unroll
    for (int j = 0; j < 8; ++j) o[j] = (short)p.PATT[(size_t)(t0 + j) * 1280 + 640 + c];
    *(bf16x8*)(p.VT + ((size_t)gc * 128 + c) * 128 + l8 * 8) = o;
  }
  }
}

__device__ void phase_attn_naive(const Params& p, int layer, int pass) {
  const int lane = opq_tid() & 63;
  const int gw = opq_bid() * 4 + (opq_tid() >> 6), nw = gridDim.x * 4;
  const int nrows = (layer == 0) ? NT : NTL;
  for (int u = gw; u < nrows * 8; u += nw) {
    int h = u & 7, row = u >> 3, kvh = h >> 2;
    float q = bf2f(p.QR[(size_t)row * 512 + h * 64 + lane]);
    float m = p.attn_sink[layer * 8 + h], l = 1.f, o = 0.f;
    int bl, k0 = 0, k1 = 0;
    if (row < NTL) {
      bl = row / SEQ; int t = row % SEQ;
      int lo = t - 128 < 0 ? 0 : t - 128, hi = t + 128 > SEQ - 1 ? SEQ - 1 : t + 128;
      k0 = bl * SEQ + lo; k1 = bl * SEQ + hi + 1;
    } else bl = (row - NTL) / CTXL;
    int nband = k1 - k0;
    for (int kk = 0; kk < nband + CTXL; ++kk) {
      int kr = (kk < nband) ? k0 + kk : NTL + bl * CTXL + (kk - nband);
      float kv = bf2f(p.KR[(size_t)kr * 128 + kvh * 64 + lane]);
      float vv = bf2f(p.VT[((size_t)(kr >> 7) * 128 + kvh * 64 + lane) * 128 + (kr & 127)]);
      float s = wave_sum(q * kv) * 0.125f;
      float mn = fmaxf(m, s);
      float corr = expf(m - mn), pe = expf(s - mn);
      l = l * corr + pe; o = o * corr + pe * vv; m = mn;
    }
    float z = bf2f(p.PATT[(size_t)row * 1280 + 768 + h * 64 + lane]);
    p.Y[(size_t)row * 2048 + 1536 + h * 64 + lane] = f2bf(o / l * silu_f(z));
  }
}

__device__ void phase_attn(const Params& p, int layer, int pass, bf16_t* smem) {
  const int tid = opq_tid(), lane = tid & 63, wid = tid >> 6, lr = lane & 31, lh = lane >> 5;
  const int nqt = ((layer == 0) ? NT : NTL) / 32;
  const int srow = tid >> 3, scol = (tid & 7) * 8;
  for (int u = (opq_bid() + (int)gridDim.x - 64) % (int)gridDim.x; u < nqt * 2; u += gridDim.x) {
    const int kvh = u & 1, qt = u >> 1, h = kvh * 4 + wid;
    const int q0 = qt * 32;
    int bl, nband = 0, tb0 = 0, t0 = 0;
    if (q0 < NTL) {
      bl = q0 >> 12; t0 = q0 & 4095;
      tb0 = (t0 - 128 < 0) ? 0 : ((t0 - 128) >> 6);
      int tb1 = (t0 + 159) >> 6; if (tb1 > 63) tb1 = 63;
      nband = tb1 - tb0 + 1;
    } else bl = (q0 - NTL) >> 8;
    const int ntile = nband + 4;
    bf16x8 qf[4];
    {
      const bf16_t* qp = p.QR + (size_t)(q0 + lr) * 512 + h * 64 + lh * 8;
#pragma unroll
      for (int kk = 0; kk < 4; ++kk) qf[kk] = *(const bf16x8*)(qp + kk * 16);
    }
    float m = p.attn_sink[layer * 8 + h], l = 1.f;
    f32x16 o[2];
#pragma unroll
    for (int r = 0; r < 16; ++r) { o[0][r] = 0.f; o[1][r] = 0.f; }
    const int qpos = t0 + lr;
    bf16x8 rk[2], rv[2];
    auto fetch = [&](int ti) __attribute__((always_inline)) {
      const int kr0 = (ti < nband) ? bl * 4096 + (tb0 + ti) * 64 : NTL + bl * 256 + (ti - nband) * 64;
      const bf16_t* kp = p.KR + (size_t)(kr0 + srow) * 128 + kvh * 64 + scol;
      const bf16_t* vp = p.VT + ((size_t)(kr0 >> 7) * 128 + kvh * 64 + srow) * 128 + (kr0 & 127) + scol;
      rk[0] = *(const bf16x8*)kp; rk[1] = *(const bf16x8*)(kp + 32 * 128);
      rv[0] = *(const bf16x8*)vp; rv[1] = *(const bf16x8*)(vp + 32 * 128);
    };
    auto stash = [&](bf16_t* buf) __attribute__((always_inline)) {
      *(bf16x8*)(buf + srow * 72 + scol) = rk[0];
      *(bf16x8*)(buf + (srow + 32) * 72 + scol) = rk[1];
      *(bf16x8*)(buf + 4608 + srow * 72 + scol) = rv[0];
      *(bf16x8*)(buf + 4608 + (srow + 32) * 72 + scol) = rv[1];
    };
    fetch(0);
    __syncthreads();
    stash(smem);
    if (1 < ntile) fetch(1);
    __syncthreads();
    for (int ti = 0; ti < ntile; ++ti) {
      const bf16_t* Kc = smem + (ti & 1) * 9216;
      const bf16_t* Vc = Kc + 4608;
      if (ti + 1 < ntile) {
        stash(smem + ((ti + 1) & 1) * 9216);
        if (ti + 2 < ntile) fetch(ti + 2);
      }
      f32x16 st[2];
#pragma unroll
      for (int r = 0; r < 16; ++r) { st[0][r] = 0.f; st[1][r] = 0.f; }
#pragma unroll
      for (int kk = 0; kk < 4; ++kk) {
        bf16x8 kf0 = *(const bf16x8*)(Kc + lr * 72 + kk * 16 + lh * 8);
        bf16x8 kf1 = *(const bf16x8*)(Kc + (32 + lr) * 72 + kk * 16 + lh * 8);
        st[0] = __builtin_amdgcn_mfma_f32_32x32x16_bf16(kf0, qf[kk], st[0], 0, 0, 0);
        st[1] = __builtin_amdgcn_mfma_f32_32x32x16_bf16(kf1, qf[kk], st[1], 0, 0, 0);
      }
      float mx = -3.0e38f;
      const bool band = ti < nband;
      const int kbase = (tb0 + ti) * 64 + 4 * lh;
#pragma unroll
      for (int hh = 0; hh < 2; ++hh)
#pragma unroll
        for (int r = 0; r < 16; ++r) {
          float s = st[hh][r] * 0.125f;
          if (band) {
            int dd = qpos - (kbase + hh * 32 + (r & 3) + 8 * (r >> 2));
            if (dd > 128 || dd < -128) s = -1e30f;
          }
          st[hh][r] = s; mx = fmaxf(mx, s);
        }
      mx = fmaxf(mx, __shfl_xor(mx, 32));
      const float mn = fmaxf(m, mx);
      const float corr = __expf(m - mn);
      m = mn;
      float ls = 0.f;
#pragma unroll
      for (int hh = 0; hh < 2; ++hh)
#pragma unroll
        for (int r = 0; r < 16; ++r) { st[hh][r] = __expf(st[hh][r] - mn); ls += st[hh][r]; }
      ls += __shfl_xor(ls, 32);
      l = l * corr + ls;
#pragma unroll
      for (int r = 0; r < 16; ++r) { o[0][r] *= corr; o[1][r] *= corr; }
#pragma unroll
      for (int hh = 0; hh < 2; ++hh)
#pragma unroll
        for (int s2 = 0; s2 < 2; ++s2) {
          f32x4 pa = {st[hh][8 * s2 + 0], st[hh][8 * s2 + 1], st[hh][8 * s2 + 2], st[hh][8 * s2 + 3]};
          f32x4 pb = {st[hh][8 * s2 + 4], st[hh][8 * s2 + 5], st[hh][8 * s2 + 6], st[hh][8 * s2 + 7]};
          bf16x8 pf = pack8(pa, pb);
#pragma unroll
          for (int mt = 0; mt < 2; ++mt) {
            const bf16_t* vp = Vc + (mt * 32 + lr) * 72 + hh * 32 + 16 * s2 + 4 * lh;
            bf16x4 x0 = *(const bf16x4*)vp, x1 = *(const bf16x4*)(vp + 8);
            bf16x8 vfr = {x0[0], x0[1], x0[2], x0[3], x1[0], x1[1], x1[2], x1[3]};
            o[mt] = __builtin_amdgcn_mfma_f32_32x32x16_bf16(vfr, pf, o[mt], 0, 0, 0);
          }
        }
      __syncthreads();
    }
    const float inv = 1.f / l;
    {
      bf16_t* Zw = smem + 2 * 9216 + wid * (32 * 72);
      const int er = lane >> 3, ec = (lane & 7) * 8;
      const bf16_t* zg = p.PATT + (size_t)(q0 + er) * 1280 + 768 + h * 64 + ec;
      bf16x8 zr[4];
#pragma unroll
      for (int i = 0; i < 4; ++i) zr[i] = *(const bf16x8*)(zg + (size_t)i * 8 * 1280);
#pragma unroll
      for (int i = 0; i < 4; ++i) *(bf16x8*)(Zw + (er + 8 * i) * 72 + ec) = zr[i];
#pragma unroll
      for (int mt = 0; mt < 2; ++mt)
#pragma unroll
        for (int qq = 0; qq < 4; ++qq) {
          int d0 = mt * 32 + 8 * qq + 4 * lh;
          bf16x4 z4 = *(const bf16x4*)(Zw + lr * 72 + d0);
          bf16x4 o4;
#pragma unroll
          for (int t = 0; t < 4; ++t) o4[t] = (short)f2bf(o[mt][qq * 4 + t] * inv * silu_f(bf2f((bf16_t)z4[t])));
          *(bf16x4*)(Zw + lr * 72 + d0) = o4;
        }
      bf16_t* yg = p.Y + (size_t)(q0 + er) * 2048 + 1536 + h * 64 + ec;
#pragma unroll
      for (int i = 0; i < 4; ++i) *(bf16x8*)(yg + (size_t)i * 8 * 2048) = *(const bf16x8*)(Zw + (er + 8 * i) * 72 + ec);
    }
  }
}

__device__ void phase_s1(const Params& p, int layer, int pass, bf16_t* smem) {
  const int tid = opq_tid(), lane = tid & 63, nt = tid >> 6, lr = lane & 31, lh = lane >> 5;
  constexpr int RS = 136;
  bf16_t* Xs = smem;
  bf16_t* Bts = smem + 64 * RS;
  float* Ws = (float*)(smem + 192 * RS);
  const int srow = tid >> 4, scol = (tid & 15) * 8;
  for (int u = opq_bid(); u < NCH * 16; u += gridDim.x) {
    const int h = u & 15, gc = u >> 4, g = h >> 3;
    bf16x8 rx[4], rb[8];
    {
      const bf16_t* Xg = p.XT + ((size_t)gc * 1024 + h * 64 + srow) * 128 + scol;
#pragma unroll
      for (int i = 0; i < 4; ++i) rx[i] = *(const bf16x8*)(Xg + i * 2048);
      const bf16_t* Bg = p.BT + ((size_t)gc * 256 + g * 128 + srow) * 128 + scol;
#pragma unroll
      for (int i = 0; i < 8; ++i) rb[i] = *(const bf16x8*)(Bg + i * 2048);
    }
    const float wv = p.WW[((size_t)gc * 32 + (tid >> 7) * 16 + h) * 128 + (tid & 127)];
    __syncthreads();
#pragma unroll
    for (int i = 0; i < 4; ++i) *(bf16x8*)(Xs + (srow + 16 * i) * RS + scol) = rx[i];
#pragma unroll
    for (int i = 0; i < 8; ++i) *(bf16x8*)(Bts + (srow + 16 * i) * RS + scol) = rb[i];
    Ws[tid] = wv;
    __syncthreads();
#pragma unroll 1
    for (int d = 0; d < 2; ++d) {
      f32x16 acc0, acc1;
#pragma unroll
      for (int r = 0; r < 16; ++r) { acc0[r] = 0.f; acc1[r] = 0.f; }
#pragma unroll
      for (int kk = 0; kk < 8; ++kk) {
        bf16x8 bfr = *(const bf16x8*)(Bts + (nt * 32 + lr) * RS + kk * 16 + lh * 8);
        bf16x8 x0 = *(const bf16x8*)(Xs + lr * RS + kk * 16 + lh * 8);
        bf16x8 x1 = *(const bf16x8*)(Xs + (32 + lr) * RS + kk * 16 + lh * 8);
        f32x4 wa = *(const f32x4*)(Ws + d * 128 + kk * 16 + lh * 8), wb = *(const f32x4*)(Ws + d * 128 + kk * 16 + lh * 8 + 4);
        f32x4 a0, a1, c0, c1;
#pragma unroll
        for (int j = 0; j < 4; ++j) {
          a0[j] = bf2f((bf16_t)x0[j]) * wa[j]; a1[j] = bf2f((bf16_t)x0[4 + j]) * wb[j];
          c0[j] = bf2f((bf16_t)x1[j]) * wa[j]; c1[j] = bf2f((bf16_t)x1[4 + j]) * wb[j];
        }
        acc0 = __builtin_amdgcn_mfma_f32_32x32x16_bf16(pack8(a0, a1), bfr, acc0, 0, 0, 0);
        acc1 = __builtin_amdgcn_mfma_f32_32x32x16_bf16(pack8(c0, c1), bfr, acc1, 0, 0, 0);
      }
      float* dst = p.LST + ((((size_t)gc * 16 + h) * 2 + d) * 64) * 128 + nt * 32 + lr;
#pragma unroll
      for (int r = 0; r < 16; ++r) {
        int pp = (r & 3) + 8 * (r >> 2) + 4 * lh;
        dst[(size_t)pp * 128] = acc0[r];
        dst[(size_t)(32 + pp) * 128] = acc1[r];
      }
    }
  }
}

__device__ __forceinline__ int scan_chunk(int ci, int bl, int d) {
  if (ci < 2) return 64 + bl * 2 + (d == 0 ? ci : 1 - ci);
  int cc = ci - 2;
  return bl * 32 + (d == 0 ? cc : 31 - cc);
}
__device__ void phase_s2(const Params& p, int layer, int pass) {
  const int nth = gridDim.x * 256;
  for (int e = opq_bid() * 256 + opq_tid(); e < 64 * 2048; e += nth) {
    int seq = e >> 11, q = e & 2047, pp = q >> 5, n4 = (q & 31) * 4;
    int d = seq & 1, h = (seq >> 1) & 15, bl = seq >> 5;
    f32x4 s = {0.f, 0.f, 0.f, 0.f};
    const size_t eoff = ((size_t)h * 2 + d) * 8192 + (size_t)pp * 128 + n4;
    const int toff = (d == 0) ? h * 128 + 127 : (16 + h) * 128;
#pragma unroll
    for (int half = 0; half < 2; ++half) {
      f32x4 loc[17]; float tot[17];
#pragma unroll
      for (int i = 0; i < 17; ++i) {
        int gc = scan_chunk(half * 17 + i, bl, d);
        loc[i] = *(const f32x4*)(p.LST + (size_t)gc * 262144 + eoff);
        tot[i] = p.CUMT[(size_t)gc * 4096 + toff];
      }
#pragma unroll
      for (int i = 0; i < 17; ++i) {
        int gc = scan_chunk(half * 17 + i, bl, d);
        uint2 o; o.x = pk2(s[0], s[1]); o.y = pk2(s[2], s[3]);
        *(uint2*)(p.SIN + (size_t)gc * 262144 + eoff) = o;
        float dec = expf(tot[i]);
        s = s * dec + loc[i];
      }
    }
  }
}

__device__ void phase_s3(const Params& p, int layer, int pass, bf16_t* smem) {
  const int tid = opq_tid(), lane = tid & 63, w = tid >> 6, lr = lane & 31, lh = lane >> 5;
  const int nch = (layer == 0) ? NCH : 64;
  constexpr int RS = 136;
  bf16_t* Ss = smem;
  bf16_t* Bs = smem;
  bf16_t* Xs = smem + 128 * RS;
  float* Vs = (float*)(smem + 192 * RS);
  bf16_t* Zs = smem + 192 * RS + 1536;
  bf16_t* Os = smem;
  const int srow = tid >> 4, scol = (tid & 15) * 8;
  for (int u = opq_bid(); u < nch * 16; u += gridDim.x) {
    const int h = u & 15, gc = u >> 4, g = h >> 3;
    const int i_own = 32 * w + lr;
    bf16x8 rs[8];
    {
      const bf16_t* Sg = p.SIN + ((size_t)gc * 16 + h) * 16384 + srow * 128 + scol;
#pragma unroll
      for (int i = 0; i < 8; ++i) rs[i] = *(const bf16x8*)(Sg + i * 2048);
    }
    bf16x8 cf[8];
    {
      const bf16_t* crow = p.CR + ((size_t)gc * 128 + i_own) * 256 + g * 128 + lh * 8;
#pragma unroll
      for (int kk = 0; kk < 8; ++kk) cf[kk] = *(const bf16x8*)(crow + kk * 16);
    }
    bf16x8 rz[4];
    {
      const bf16_t* Zg = p.PZ + ((size_t)gc * 128 + (tid >> 3)) * 1024 + h * 64 + (tid & 7) * 8;
#pragma unroll
      for (int i = 0; i < 4; ++i) rz[i] = *(const bf16x8*)(Zg + (size_t)i * 32 * 1024);
    }
    const size_t vidx = ((size_t)gc * 32 + (tid >> 7) * 16 + h) * 128 + (tid & 127);
    const float v_vv = p.VV[vidx], v_ec = p.EC[vidx], v_cu = p.CUMT[vidx];
    __syncthreads();
#pragma unroll
    for (int i = 0; i < 8; ++i) *(bf16x8*)(Ss + (srow + 16 * i) * RS + scol) = rs[i];
    Vs[tid] = v_vv; Vs[256 + tid] = v_ec; Vs[512 + tid] = v_cu;
#pragma unroll
    for (int i = 0; i < 4; ++i) *(bf16x8*)(Zs + ((tid >> 3) + 32 * i) * 72 + (tid & 7) * 8) = rz[i];
    bf16x8 rb[8], rx[4];
    {
      const bf16_t* Bg = p.BR + ((size_t)gc * 128 + srow) * 256 + g * 128 + scol;
#pragma unroll
      for (int i = 0; i < 8; ++i) rb[i] = *(const bf16x8*)(Bg + i * 16 * 256);
      const bf16_t* Xg = p.XT + ((size_t)gc * 1024 + h * 64 + srow) * 128 + scol;
#pragma unroll
      for (int i = 0; i < 4; ++i) rx[i] = *(const bf16x8*)(Xg + i * 2048);
    }
    __syncthreads();
    f32x16 y[2];
#pragma unroll
    for (int r = 0; r < 16; ++r) { y[0][r] = 0.f; y[1][r] = 0.f; }
#pragma unroll
    for (int d = 0; d < 2; ++d) {
      const float* ec = Vs + 256 + d * 128 + 32 * w + 4 * lh;
#pragma unroll
      for (int pt = 0; pt < 2; ++pt) {
        f32x16 tmp;
#pragma unroll
        for (int r = 0; r < 16; ++r) tmp[r] = 0.f;
        const bf16_t* sl = Ss + (d * 64 + pt * 32 + lr) * RS + lh * 8;
#pragma unroll
        for (int kk = 0; kk < 8; ++kk) {
          bf16x8 sf = *(const bf16x8*)(sl + kk * 16);
          tmp = __builtin_amdgcn_mfma_f32_32x32x16_bf16(cf[kk], sf, tmp, 0, 0, 0);
        }
#pragma unroll
        for (int q = 0; q < 4; ++q) {
          f32x4 e4 = *(const f32x4*)(ec + 8 * q);
#pragma unroll
          for (int t = 0; t < 4; ++t) y[pt][q * 4 + t] += tmp[q * 4 + t] * e4[t];
        }
      }
    }
    __syncthreads();
#pragma unroll
    for (int i = 0; i < 8; ++i) *(bf16x8*)(Bs + (srow + 16 * i) * RS + scol) = rb[i];
#pragma unroll
    for (int i = 0; i < 4; ++i) *(bf16x8*)(Xs + (srow + 16 * i) * RS + scol) = rx[i];
    __syncthreads();
    const float cum_f = Vs[512 + i_own];
    const float cum_b = Vs[512 + 128 + i_own];
#pragma unroll 1
    for (int jt = 0; jt < 4; ++jt) {
      f32x16 cb;
#pragma unroll
      for (int r = 0; r < 16; ++r) cb[r] = 0.f;
      const bf16_t* bl_ = Bs + (jt * 32 + lr) * RS + lh * 8;
#pragma unroll
      for (int kk = 0; kk < 8; ++kk) {
        bf16x8 bfr = *(const bf16x8*)(bl_ + kk * 16);
        cb = __builtin_amdgcn_mfma_f32_32x32x16_bf16(bfr, cf[kk], cb, 0, 0, 0);
      }
      bf16x8 xb[2][2];
#pragma unroll
      for (int s = 0; s < 2; ++s)
#pragma unroll
        for (int pt = 0; pt < 2; ++pt) {
          const bf16_t* xp = Xs + (pt * 32 + lr) * RS + jt * 32 + 16 * s + 4 * lh;
          bf16x4 x0 = *(const bf16x4*)xp, x1 = *(const bf16x4*)(xp + 8);
          bf16x8 t8 = {x0[0], x0[1], x0[2], x0[3], x1[0], x1[1], x1[2], x1[3]};
          xb[s][pt] = t8;
        }
#pragma unroll
      for (int d = 0; d < 2; ++d) {
        bool need = (d == 0) ? (jt <= w) : (jt >= w);
        if (!need) continue;
        const float* vv = Vs + d * 128 + jt * 32 + 4 * lh;
        const float ci = (d == 0) ? cum_f : cum_b;
        f32x16 gq;
#pragma unroll
        for (int q = 0; q < 4; ++q) {
          f32x4 v4 = *(const f32x4*)(vv + 8 * q);
#pragma unroll
          for (int t = 0; t < 4; ++t) {
            int j = jt * 32 + 8 * q + 4 * lh + t;
            float val = cb[q * 4 + t] * __expf(ci - v4[t]);
            bool ok = (jt != w) || ((d == 0) ? (j <= i_own) : (j >= i_own));
            gq[q * 4 + t] = ok ? val : 0.f;
          }
        }
#pragma unroll
        for (int s = 0; s < 2; ++s) {
          f32x4 ga = {gq[8 * s + 0], gq[8 * s + 1], gq[8 * s + 2], gq[8 * s + 3]};
          f32x4 gb = {gq[8 * s + 4], gq[8 * s + 5], gq[8 * s + 6], gq[8 * s + 7]};
          bf16x8 afr = pack8(ga, gb);
          y[0] = __builtin_amdgcn_mfma_f32_32x32x16_bf16(afr, xb[s][0], y[0], 0, 0, 0);
          y[1] = __builtin_amdgcn_mfma_f32_32x32x16_bf16(afr, xb[s][1], y[1], 0, 0, 0);
        }
      }
    }
    const float Dh = p.ssd_d[layer * 16 + h];
    float ssq[16];
#pragma unroll
    for (int r = 0; r < 16; ++r) ssq[r] = 0.f;
    __syncthreads();
#pragma unroll
    for (int pt = 0; pt < 2; ++pt)
#pragma unroll
      for (int q = 0; q < 4; ++q) {
        bf16x4 x4 = *(const bf16x4*)(Xs + (pt * 32 + lr) * RS + 32 * w + 8 * q + 4 * lh);
#pragma unroll
        for (int t = 0; t < 4; ++t) {
          int li = 32 * w + 8 * q + 4 * lh + t;
          float yv = y[pt][q * 4 + t] + Dh * bf2f((bf16_t)x4[t]);
          float z = bf2f(Zs[li * 72 + pt * 32 + lr]);
          float gv = yv * silu_f(z);
          ssq[q * 4 + t] += gv * gv;
          Os[li * 72 + pt * 32 + lr] = f2bf(gv);
        }
      }
    __syncthreads();
    {
      bf16_t* Yg = p.Y + ((size_t)gc * 128 + (tid >> 3)) * 2048 + h * 64 + (tid & 7) * 8;
#pragma unroll
      for (int i = 0; i < 4; ++i)
        *(bf16x8*)(Yg + (size_t)i * 32 * 2048) = *(const bf16x8*)(Os + ((tid >> 3) + 32 * i) * 72 + (tid & 7) * 8);
    }
#pragma unroll
    for (int r = 0; r < 16; ++r) {
      float v = ssq[r];
      v += __shfl_xor(v, 1); v += __shfl_xor(v, 2); v += __shfl_xor(v, 4); v += __shfl_xor(v, 8); v += __shfl_xor(v, 16);
      ssq[r] = v;
    }
    if (lr == 0) {
#pragma unroll
      for (int r = 0; r < 16; ++r) {
        int row = gc * 128 + 32 * w + (r & 3) + 8 * (r >> 2) + 4 * lh;
        p.SSQ[(size_t)row * 16 + h] = ssq[r];
      }
    }
  }
}

__device__ void phase_final(const Params& p) {
  const int lane = opq_tid() & 63;
  const int gw = opq_bid() * 4 + (opq_tid() >> 6), nw = gridDim.x * 4;
  for (int row = gw; row < 4 * SEQ; row += nw) {
    float* src = p.out + (size_t)row * D;
    float4 v[4]; float ss = 0.f;
#pragma unroll
    for (int i = 0; i < 4; ++i) {
      v[i] = *(const float4*)(src + (i * 64 + lane) * 4);
      ss += v[i].x * v[i].x + v[i].y * v[i].y + v[i].z * v[i].z + v[i].w * v[i].w;
    }
    ss = wave_sum(ss);
    float rstd = rsqrtf(ss * (1.f / D) + EPS);
#pragma unroll
    for (int i = 0; i < 4; ++i) {
      int k = (i * 64 + lane) * 4;
      float4 w = *(const float4*)(p.final_norm_w + k);
      float4 o = {v[i].x * rstd * w.x, v[i].y * rstd * w.y, v[i].z * rstd * w.z, v[i].w * rstd * w.w};
      *(float4*)(src + k) = o;
    }
  }
}

#ifndef REP_W
#define REP_W 1
#endif
#ifndef REP_GOUT0
#define REP_GOUT0 1
#endif
#ifndef REP_NORM
#define REP_NORM 1
#endif
#ifndef REP_GIN
#define REP_GIN 1
#endif
#ifndef REP_PREP
#define REP_PREP 1
#endif
#ifndef REP_S1
#define REP_S1 1
#endif
#ifndef REP_ATTN
#define REP_ATTN 1
#endif
#ifndef REP_S3
#define REP_S3 1
#endif
__global__ void __launch_bounds__(256, 2) mega(Params p, int lo, int hi) {
  __shared__ __attribute__((aligned(16))) float smem[18432];
  __shared__ uint4 xb_words;
  if (threadIdx.x == 0) xb_words = make_uint4(0u, 0u, 0u, 0u);
  __syncthreads();
  XcdBarrier xb = xcd_barrier_post(p.bar, (volatile LAS unsigned*)&xb_words);
  if (lo < 0) cg::this_grid().sync();
  for (int step = lo; step < hi; ++step) {
    if (step == 0) { for (int rp = 0; rp < REP_W; ++rp) phase_weights(p, smem); }
    else if (step == NSTEP - 1) phase_final(p);
    else {
      int s = step - 1;
      int pass = s / 14, r = s % 14, layer = r / 7, ph = r % 7;
      switch (ph) {
        case ST_NORM: for (int rp = 0; rp < REP_NORM; ++rp) phase_norm(p, layer, pass); break;
        case ST_GIN: for (int rp = 0; rp < REP_GIN; ++rp) phase_gemm_in256(p, layer, pass, (bf16_t*)smem); break;
        case ST_PREP: for (int rp = 0; rp < REP_PREP; ++rp) phase_prep(p, layer, pass, smem); break;
        case ST_MIX:
          for (int rp = 0; rp < REP_S1; ++rp) phase_s1(p, layer, pass, (bf16_t*)smem);
          for (int rp = 0; rp < REP_ATTN; ++rp) phase_attn(p, layer, pass, (bf16_t*)smem);
          break;
        case ST_S2: phase_s2(p, layer, pass); break;
        case ST_S3: for (int rp = 0; rp < REP_S3; ++rp) phase_s3(p, layer, pass, (bf16_t*)smem); break;
        case ST_GOUT: for (int rp = 0; rp < (layer == 0 ? REP_GOUT0 : 1); ++rp) phase_gemm_mfma(p, 1, layer, pass, (bf16_t*)smem); break;
      }
    }
    if (step + 1 < hi) xcd_barrier(xb);
  }
}

extern "C" void kernel_launch(void* const* d_in, const int* in_sizes, int n_in, void* d_out, int out_size, void* d_ws,
                              size_t ws_size, hipStream_t stream) {
  Params p{};
  p.x = (const float*)d_in[0]; p.c = (const float*)d_in[1]; p.ctx = (const float*)d_in[2]; p.c_ctx = (const float*)d_in[3];
  p.norm_w = (const float*)d_in[4]; p.w_mod = (const float*)d_in[5]; p.b_mod = (const float*)d_in[6];
  p.w_in = (const float*)d_in[7]; p.ssd_conv_w = (const float*)d_in[8]; p.ssd_conv_b = (const float*)d_in[9];
  p.ssd_dt_bias = (const float*)d_in[10]; p.ssd_a_log = (const float*)d_in[11]; p.ssd_d = (const float*)d_in[12];
  p.ssd_norm_w = (const float*)d_in[13]; p.sc_conv_w = (const float*)d_in[14]; p.attn_sink = (const float*)d_in[15];
  p.w_out = (const float*)d_in[16]; p.final_norm_w = (const float*)d_in[17];
  p.out = (float*)d_out;
  char* w = (char*)d_ws; size_t off = 0;
  auto take = [&](size_t bytes) { char* r = w + off; off += (bytes + 255) & ~(size_t)255; return r; };
  p.WinT = (bf16_t*)take((size_t)2 * NWIN * 1024 * 2);
  p.WoutT = (bf16_t*)take((size_t)2 * 1024 * 2048 * 2);
  p.MOD = (float*)take((size_t)2 * 5 * 3072 * 4);
  p.CTX1 = (float*)take((size_t)4 * CTXL * D * 4);
  p.ROPE = (float*)take((size_t)64 * 16 * 2 * 4);
  char* big = take((size_t)NT * (1024 + 1536 + 2048) * 2);
  p.H = (bf16_t*)big;
  p.PXBC = (bf16_t*)(big + (size_t)NT * 1024 * 2);
  p.PSC = (bf16_t*)(big + (size_t)NT * (1024 + 1536) * 2);
  p.LST = (float*)big;
  p.PART = (float*)(big + (size_t)24 * 1024 * 1024);
  p.PZ = (bf16_t*)take((size_t)NT * 1024 * 2);
  p.PATT = (bf16_t*)take((size_t)NT * 1280 * 2);
  p.QR = (bf16_t*)take((size_t)NT * 512 * 2);
  p.KR = (bf16_t*)take((size_t)NT * 128 * 2);
  p.VT = (bf16_t*)take((size_t)NT * 128 * 2);
  p.SIN = p.PATT;
  p.DTRAW = (float*)take((size_t)NT * 32 * 4);
  p.CUMT = (float*)take((size_t)NT * 32 * 4);
  p.VV = (float*)take((size_t)NT * 32 * 4);
  p.EC = (float*)take((size_t)NT * 32 * 4);
  p.WW = (float*)take((size_t)NT * 32 * 4);
  p.SSQ = (float*)take((size_t)NT * 16 * 4);
  p.XT = (bf16_t*)take((size_t)NT * 1024 * 2);
  p.BR = (bf16_t*)take((size_t)NT * 256 * 2);
  p.CR = (bf16_t*)take((size_t)NT * 256 * 2);
  p.BT = (bf16_t*)take((size_t)NT * 256 * 2);
  p.Y = (bf16_t*)take((size_t)NT * 2048 * 2);
  p.bar = (unsigned*)take((size_t)XCD_BAR_WORDS * 4);
  if (off > ws_size) { fprintf(stderr, "workspace too small: need %zu have %zu\n", off, ws_size); return; }
  static int grid_blocks = 0;
  if (!grid_blocks) {
    int dev = 0, cus = 0, per_cu = 0;
    hipGetDevice(&dev);
    hipDeviceGetAttribute(&cus, hipDeviceAttributeMultiprocessorCount, dev);
    hipOccupancyMaxActiveBlocksPerMultiprocessor(&per_cu, mega, 256, 0);
    if (per_cu > 2) per_cu = 2;
    if (per_cu < 1) per_cu = 1;
    grid_blocks = cus * per_cu;
  }
  hipMemsetAsync(p.bar, 0, (size_t)XCD_BAR_WORDS * 4, stream);
  int lo = 0, hi = NSTEP;
  void* args[] = {&p, &lo, &hi};
  hipError_t e = hipLaunchCooperativeKernel((void*)mega, dim3(grid_blocks), dim3(256), args, 0, stream);
  if (e != hipSuccess) fprintf(stderr, "cooperative launch failed: %s (grid %d)\n", hipGetErrorString(e), grid_blocks);
}
```

```cpp
#include <hip/hip_runtime.h>
#include <hip/hip_cooperative_groups.h>
#include <cstdio>
#include <type_traits>
namespace cg = cooperative_groups;

typedef unsigned short bf16_t;
typedef __attribute__((ext_vector_type(8))) short bf16x8;
typedef __attribute__((ext_vector_type(4))) short bf16x4;
typedef __attribute__((ext_vector_type(4))) float f32x4;
typedef __attribute__((ext_vector_type(16))) float f32x16;

constexpr int D = 1024, SEQ = 4096, CTXL = 256;
constexpr int NB = 2;
constexpr int NPASS = 2;
constexpr int NTL = NB * SEQ;
constexpr int NTC = NB * CTXL;
constexpr int NT = NTL + NTC;
constexpr int NCH = NT / 128;
constexpr int NWIN = 6016;
constexpr float EPS = 1e-6f;

constexpr int ST_NORM = 0, ST_GIN = 1, ST_PREP = 2, ST_MIX = 3, ST_S2 = 4, ST_S3 = 5, ST_GOUT = 6;
constexpr int NSTEP = 1 + NPASS * 2 * 7 + 1;

struct Params {
  const float *x, *c, *ctx, *c_ctx, *norm_w, *w_mod, *b_mod, *w_in, *ssd_conv_w, *ssd_conv_b, *ssd_dt_bias,
      *ssd_a_log, *ssd_d, *ssd_norm_w, *sc_conv_w, *attn_sink, *w_out, *final_norm_w;
  float* out;
  bf16_t *WinT, *WoutT, *H, *PXBC, *PSC, *PZ, *PATT, *XT, *BR, *CR, *BT, *QR, *KR, *VT, *Y, *SIN;
  float *MOD, *CTX1, *DTRAW, *CUMT, *VV, *EC, *WW, *SSQ, *LST, *ROPE, *PART;
  unsigned* bar;
};

__device__ __forceinline__ int opq_tid() { int t = threadIdx.x; asm volatile("" : "+v"(t)); return t; }
__device__ __forceinline__ int opq_bid() { int b = blockIdx.x; asm volatile("" : "+s"(b)); return b; }
typedef __attribute__((ext_vector_type(2))) __bf16 bfv2;
typedef __attribute__((ext_vector_type(2))) float f32x2;
typedef __attribute__((ext_vector_type(4))) unsigned u32x4;
__device__ __forceinline__ unsigned pk2(float a, float b) {
  f32x2 v = {a, b};
  bfv2 r = __builtin_convertvector(v, bfv2);
  return *(unsigned*)&r;
}
__device__ __forceinline__ bf16_t f2bf(float f) { return (bf16_t)(pk2(f, 0.f) & 0xffffu); }
__device__ __forceinline__ bf16x8 pack8(f32x4 a, f32x4 b) {
  u32x4 u = {pk2(a[0], a[1]), pk2(a[2], a[3]), pk2(b[0], b[1]), pk2(b[2], b[3])};
  return *(bf16x8*)&u;
}
__device__ __forceinline__ float bf2f(bf16_t h) { return __uint_as_float(((unsigned)h) << 16); }
__device__ __forceinline__ float silu_f(float v) { return v * __builtin_amdgcn_rcpf(1.f + __expf(-v)); }
__device__ __forceinline__ float wave_sum(float v) {
#pragma unroll
  for (int o = 32; o > 0; o >>= 1) v += __shfl_xor(v, o);
  return v;
}

#define XB_TMO      128
#define XB_XCNT(j)  (256  + 64 * (j))
#define XB_XSUB(j)  (1280 + 64 * (j))
#define XB_XGEN(j)  (2304 + 64 * (j))
#define XB_TOP      3328
#define XB_TOPGEN   3392
#define XCD_BAR_WORDS 3456
#define XB_SPIN_CAP (1u << 18)
#define LAS __attribute__((address_space(3)))

__device__ __forceinline__ unsigned xb_ld(unsigned* p)              { return __hip_atomic_load(p, __ATOMIC_RELAXED, __HIP_MEMORY_SCOPE_AGENT); }
__device__ __forceinline__ unsigned xb_add(unsigned* p, unsigned v) { return __hip_atomic_fetch_add(p, v, __ATOMIC_RELAXED, __HIP_MEMORY_SCOPE_AGENT); }
__device__ __forceinline__ unsigned xb_xcc_id() { return (unsigned)__builtin_amdgcn_s_getreg((3 << 11) | 20) & 0xFu; }
#define XB_SPIN(cond, bar) do { unsigned _sp = 0; while (cond) { __builtin_amdgcn_s_sleep(1); \
    if ((++_sp & 255u) == 0u) { if (xb_ld(&(bar)[XB_TMO])) break; if (_sp > XB_SPIN_CAP) { atomicAdd(&(bar)[XB_TMO], 1u); break; } } } } while (0)

struct XcdBarrier {
    unsigned* bar; unsigned x;
    volatile LAS unsigned* st;
};

__device__ __forceinline__ XcdBarrier xcd_barrier_post(unsigned* bar, volatile LAS unsigned* st) {
    XcdBarrier b; b.bar = bar; b.x = xb_xcc_id(); b.st = st;
    if (threadIdx.x == 0) (void)xb_add(&bar[XB_XCNT(b.x)], 1u);
    return b;
}
__device__ __forceinline__ void xcd_barrier_complete(unsigned* bar, unsigned x, unsigned& nloc, unsigned& nx) {
    const unsigned G = gridDim.x * gridDim.y * gridDim.z;
    unsigned sum, cnt, mine, sp = 0u;
    for (;;) {
        sum = 0u; cnt = 0u; mine = 0u;
#pragma unroll
        for (unsigned j = 0; j < 16; ++j) { const unsigned c = xb_ld(&bar[XB_XCNT(j)]); sum += c; cnt += (c > 0u) ? 1u : 0u; mine = (j == x) ? c : mine; }
        if (sum == G) break;
        __builtin_amdgcn_s_sleep(1);
        if ((++sp & 255u) == 0u) { if (xb_ld(&bar[XB_TMO])) break; if (sp > XB_SPIN_CAP) { atomicAdd(&bar[XB_TMO], 1u); break; } }
    }
    nloc = mine > 0u ? mine : 1u; nx = cnt > 0u ? cnt : 1u;
}

__device__ __forceinline__ void xcd_barrier(const XcdBarrier& b) {
    asm volatile("s_waitcnt vmcnt(0)" ::: "memory");
    __syncthreads();
    if (threadIdx.x == 0) {
        unsigned* bar = b.bar;
        __builtin_amdgcn_s_waitcnt(0);
        unsigned nloc = b.st[0], nx = b.st[1];
        if (nloc == 0u) { xcd_barrier_complete(bar, b.x, nloc, nx); b.st[0] = nloc; b.st[1] = nx; }
        const unsigned old = xb_add(&bar[XB_XSUB(b.x)], 1u);
        const unsigned gen = old / nloc;
        if (old + 1u == (gen + 1u) * nloc) {
            __builtin_amdgcn_fence(__ATOMIC_RELEASE, "agent");
            asm volatile("s_waitcnt vmcnt(0)" ::: "memory");
            const unsigned og = xb_add(&bar[XB_TOP], 1u);
            const unsigned tg = og / nx;
            if (og + 1u == (tg + 1u) * nx) xb_add(&bar[XB_TOPGEN], 1u);
            else XB_SPIN(xb_ld(&bar[XB_TOPGEN]) == tg, bar);
            __builtin_amdgcn_fence(__ATOMIC_ACQUIRE, "agent");
            xb_add(&bar[XB_XGEN(b.x)], 1u);
            asm volatile("s_waitcnt vmcnt(0)" ::: "memory");
        } else {
            XB_SPIN(xb_ld(&bar[XB_XGEN(b.x)]) == gen, bar);
            __builtin_amdgcn_fence(__ATOMIC_ACQUIRE, "agent");
            asm volatile("s_waitcnt vmcnt(0)" ::: "memory");
        }
    }
    __syncthreads();
}


__device__ void phase_weights(const Params& p, float* smem) {
  const int tid = opq_tid();
  const int NW1 = 2 * 94 * 16, NW2 = 2 * 16 * 32, NM = 192;
  auto load_tile = [&](int it, float* sm) __attribute__((always_inline)) {
    float v[16];
    if (it < NW1) {
      int l = it / (94 * 16), r = it % (94 * 16), nt = r / 16, kt = r % 16;
#pragma unroll
      for (int j = 0; j < 16; ++j) {
        int e = tid + 256 * j, kk = e >> 6, nn = e & 63;
        int n = nt * 64 + nn;
        int oc = (n < 2560) ? n : (n < 5888 ? n + 32 : (n < 5920 ? n - 5888 + 2560 : -1));
        v[j] = (oc >= 0) ? p.w_in[((size_t)l * 1024 + kt * 64 + kk) * 5920 + oc] : 0.f;
      }
    } else {
      int i2 = it - NW1;
      int l = i2 / 512, r = i2 % 512, nt = r / 32, kt = r % 32;
#pragma unroll
      for (int j = 0; j < 16; ++j) {
        int e = tid + 256 * j, kk = e >> 6, nn = e & 63;
        int k = kt * 64 + kk;
        float w = p.w_out[((size_t)l * 2048 + k) * 1024 + nt * 64 + nn];
        v[j] = (k < 1024) ? w * p.ssd_norm_w[l * 1024 + k] : w;
      }
    }
#pragma unroll
    for (int j = 0; j < 16; ++j) { int e = tid + 256 * j; sm[(e >> 6) * 65 + (e & 63)] = v[j]; }
  };
  auto store_tile = [&](int it, const float* sm) __attribute__((always_inline)) {
    if (it < NW1) {
      int l = it / (94 * 16), r = it % (94 * 16), nt = r / 16, kt = r % 16;
#pragma unroll
      for (int j = 0; j < 16; ++j) {
        int e = tid + 256 * j, nn = e >> 6, kk = e & 63;
        p.WinT[((size_t)l * NWIN + nt * 64 + nn) * 1024 + kt * 64 + kk] = f2bf(sm[kk * 65 + nn]);
      }
    } else {
      int i2 = it - NW1;
      int l = i2 / 512, r = i2 % 512, nt = r / 32, kt = r % 32;
#pragma unroll
      for (int j = 0; j < 16; ++j) {
        int e = tid + 256 * j, nn = e >> 6, kk = e & 63;
        p.WoutT[((size_t)l * 1024 + nt * 64 + nn) * 2048 + kt * 64 + kk] = f2bf(sm[kk * 65 + nn]);
      }
    }
  };
  for (int it = opq_bid(); it < NW1 + NW2; it += 4 * gridDim.x) {
#pragma unroll
    for (int q = 0; q < 4; ++q) { int itq = it + q * (int)gridDim.x; if (itq < NW1 + NW2) load_tile(itq, smem + q * 4224); }
    __syncthreads();
#pragma unroll
    for (int q = 0; q < 4; ++q) { int itq = it + q * (int)gridDim.x; if (itq < NW1 + NW2) store_tile(itq, smem + q * 4224); }
    __syncthreads();
  }
  for (int it = opq_bid(); it < NW1 + NW2 + NM; it += gridDim.x) {
    if (it < NW1 + NW2) continue;
    {
      int i3 = it - NW1 - NW2;
      int l = i3 / 96, jb = i3 % 96;
      float* sc = smem;
      float* part = smem + 5120;
      for (int e = tid; e < 5120; e += 256) {
        int r = e >> 10, k = e & 1023;
        float v = (r < 4) ? p.c[r * 1024 + k] : p.c_ctx[k];
        sc[e] = silu_f(v);
      }
      __syncthreads();
      int col = tid & 31, kg = tid >> 5;
      float a0 = 0, a1 = 0, a2 = 0, a3 = 0, a4 = 0;
      const float* wp = p.w_mod + ((size_t)l * 1024 + kg * 128) * 3072 + jb * 32 + col;
      for (int k0 = 0; k0 < 128; k0 += 16) {
        float wv[16];
#pragma unroll
        for (int j = 0; j < 16; ++j) wv[j] = wp[(size_t)(k0 + j) * 3072];
#pragma unroll
        for (int j = 0; j < 16; ++j) {
          int k = kg * 128 + k0 + j;
          a0 += sc[k] * wv[j]; a1 += sc[1024 + k] * wv[j]; a2 += sc[2048 + k] * wv[j]; a3 += sc[3072 + k] * wv[j]; a4 += sc[4096 + k] * wv[j];
        }
      }
      part[(kg * 5 + 0) * 32 + col] = a0; part[(kg * 5 + 1) * 32 + col] = a1; part[(kg * 5 + 2) * 32 + col] = a2;
      part[(kg * 5 + 3) * 32 + col] = a3; part[(kg * 5 + 4) * 32 + col] = a4;
      __syncthreads();
      if (tid < 160) {
        int r = tid >> 5, cc = tid & 31;
        float s = 0.f;
#pragma unroll
        for (int g8 = 0; g8 < 8; ++g8) s += part[(g8 * 5 + r) * 32 + cc];
        p.MOD[((size_t)l * 5 + r) * 3072 + jb * 32 + cc] = s + p.b_mod[l * 3072 + jb * 32 + cc];
      }
      if (i3 == 0) {
        for (int e = tid; e < 1024; e += 256) {
          int pos = e >> 4, i = e & 15;
          float inv = powf(10000.f, -(float)i * (1.f / 16.f));
          float ang = (float)pos * inv;
          p.ROPE[2 * e] = cosf(ang); p.ROPE[2 * e + 1] = sinf(ang);
        }
      }
      __syncthreads();
    }
  }
}

__device__ void phase_norm(const Params& p, int layer, int pass) {
  const int lane = opq_tid() & 63;
  const int gw = opq_bid() * 4 + (opq_tid() >> 6), nw = gridDim.x * 4;
  const int b0 = pass * NB;
  for (int row = gw; row < NT; row += nw) {
    const float* src; int mrow;
    if (row < NTL) { src = (layer == 0 ? p.x : p.out) + ((size_t)b0 * SEQ + row) * D; mrow = b0 + row / SEQ; }
    else { src = (layer == 0 ? p.ctx : p.CTX1) + ((size_t)b0 * CTXL + (row - NTL)) * D; mrow = 4; }
    const float* mod = p.MOD + ((size_t)layer * 5 + mrow) * 3072;
    float4 v[4]; float ss = 0.f;
    const bool from_parts = (layer == 1 && row >= NTL);
    if (from_parts) src = p.ctx + ((size_t)b0 * CTXL + (row - NTL)) * D;
#pragma unroll
    for (int i = 0; i < 4; ++i) {
      v[i] = *(const float4*)(src + (i * 64 + lane) * 4);
      if (from_parts) {
        int k = (i * 64 + lane) * 4;
        float4 a = {0.f, 0.f, 0.f, 0.f};
#pragma unroll
        for (int ks = 0; ks < 8; ++ks) {
          float4 q = *(const float4*)(p.PART + ((size_t)ks * NTC + (row - NTL)) * D + k);
          a.x += q.x; a.y += q.y; a.z += q.z; a.w += q.w;
        }
        float4 gt = *(const float4*)(p.MOD + ((size_t)0 * 5 + 4) * 3072 + 2048 + k);
        v[i].x += gt.x * a.x; v[i].y += gt.y * a.y; v[i].z += gt.z * a.z; v[i].w += gt.w * a.w;
      }
      ss += v[i].x * v[i].x + v[i].y * v[i].y + v[i].z * v[i].z + v[i].w * v[i].w;
    }
    ss = wave_sum(ss);
    float rstd = rsqrtf(ss * (1.f / D) + EPS);
#pragma unroll
    for (int i = 0; i < 4; ++i) {
      int k = (i * 64 + lane) * 4;
      float4 nwv = *(const float4*)(p.norm_w + layer * D + k);
      float4 sh = *(const float4*)(mod + k);
      float4 scl = *(const float4*)(mod + 1024 + k);
      bf16x4 o;
      o[0] = (short)f2bf(v[i].x * rstd * nwv.x * (1.f + scl.x) + sh.x);
      o[1] = (short)f2bf(v[i].y * rstd * nwv.y * (1.f + scl.y) + sh.y);
      o[2] = (short)f2bf(v[i].z * rstd * nwv.z * (1.f + scl.z) + sh.z);
      o[3] = (short)f2bf(v[i].w * rstd * nwv.w * (1.f + scl.w) + sh.w);
      *(bf16x4*)(p.H + (size_t)row * D + k) = o;
    }
  }
}

__device__ __forceinline__ void epi_store(const Params& p, int mode, int layer, int pass, int m, int n, float v) {
  if (mode == 0) {
    if (n < 1024) p.PZ[(size_t)m * 1024 + n] = f2bf(v);
    else if (n < 2560) p.PXBC[(size_t)m * 1536 + (n - 1024)] = f2bf(v);
    else if (n < 4608) p.PSC[(size_t)m * 2048 + (n - 2560)] = f2bf(v);
    else if (n < 5888) p.PATT[(size_t)m * 1280 + (n - 4608)] = f2bf(v);
    else if (n < 5920) p.DTRAW[(size_t)m * 32 + (n - 5888)] = v;
  } else {
    const int b0 = pass * NB;
    if (m < NTL) {
      int b = b0 + m / SEQ;
      float g = p.MOD[((size_t)layer * 5 + b) * 3072 + 2048 + n];
      size_t idx = ((size_t)b0 * SEQ + m) * D + n;
      float xo = (layer == 0) ? p.x[idx] : p.out[idx];
      p.out[idx] = xo + g * v;
    } else {
      float g = p.MOD[((size_t)layer * 5 + 4) * 3072 + 2048 + n];
      size_t idx = ((size_t)b0 * CTXL + (m - NTL)) * D + n;
      p.CTX1[idx] = p.ctx[idx] + g * v;
    }
  }
}

__device__ void phase_gemm_naive(const Params& p, int mode, int layer, int pass, float* smem) {
  const int M = (mode == 0) ? NT : (layer == 0 ? NT : NTL);
  const int N = (mode == 0) ? NWIN : 1024;
  const int K = (mode == 0) ? 1024 : 2048;
  const bf16_t* A = (mode == 0) ? p.H : p.Y;
  const bf16_t* Bt = (mode == 0) ? p.WinT + (size_t)layer * NWIN * 1024 : p.WoutT + (size_t)layer * 1024 * 2048;
  const int tm = M / 64, tn = N / 64;
  const int tid = opq_tid(), tx = tid & 15, ty = tid >> 4;
  float* As = smem;
  float* Bs = smem + 16 * 68;
  for (int t = opq_bid(); t < tm * tn; t += gridDim.x) {
    int m0 = (t / tn) * 64, n0 = (t % tn) * 64;
    float acc[4][4];
#pragma unroll
    for (int i = 0; i < 4; ++i)
#pragma unroll
      for (int j = 0; j < 4; ++j) acc[i][j] = 0.f;
    int lr = tid >> 2, kq = (tid & 3) * 4;
    for (int k0 = 0; k0 < K; k0 += 16) {
      bf16x4 av = *(const bf16x4*)(A + (size_t)(m0 + lr) * K + k0 + kq);
      bf16x4 bv = *(const bf16x4*)(Bt + (size_t)(n0 + lr) * K + k0 + kq);
#pragma unroll
      for (int j = 0; j < 4; ++j) {
        As[(kq + j) * 68 + lr] = bf2f((bf16_t)av[j]);
        Bs[(kq + j) * 68 + lr] = bf2f((bf16_t)bv[j]);
      }
      __syncthreads();
#pragma unroll
      for (int kk = 0; kk < 16; ++kk) {
        float4 a4 = *(const float4*)(As + kk * 68 + ty * 4);
        float4 b4 = *(const float4*)(Bs + kk * 68 + tx * 4);
        float a[4] = {a4.x, a4.y, a4.z, a4.w}, b[4] = {b4.x, b4.y, b4.z, b4.w};
#pragma unroll
        for (int i = 0; i < 4; ++i)
#pragma unroll
          for (int j = 0; j < 4; ++j) acc[i][j] += a[i] * b[j];
      }
      __syncthreads();
    }
#pragma unroll
    for (int i = 0; i < 4; ++i)
#pragma unroll
      for (int j = 0; j < 4; ++j) epi_store(p, mode, layer, pass, m0 + ty * 4 + i, n0 + tx * 4 + j, acc[i][j]);
  }
}

__device__ void phase_gemm_mfma(const Params& p, int mode, int layer, int pass, bf16_t* smem) {
  const bool do_split = (mode == 1 && layer == 0);
  const bool ctx_sparse = (mode == 0 && layer == 1);
  const int M = (mode == 0 && !ctx_sparse) ? NT : NTL;
  const int N = (mode == 0) ? NWIN : 1024;
  const int K = (mode == 0) ? 1024 : 2048;
  const bf16_t* A = (mode == 0) ? p.H : p.Y;
  const bf16_t* Bt = (mode == 0) ? p.WinT + (size_t)layer * NWIN * 1024 : p.WoutT + (size_t)layer * 1024 * 2048;
  const int tm = M / 128, tn = N / 128, T_main = tm * tn, T = T_main + (ctx_sparse ? 60 : 0);
  const int tid = opq_tid(), lane = tid & 63, wid = tid >> 6, wm = wid >> 1, wn = wid & 1;
  const int lr = lane & 31, lh = lane >> 5;
  bf16_t* As = smem;
  bf16_t* Bs = smem + 128 * 72;
  float* rsS = (float*)(smem + 2 * 128 * 72);
  const int bid = opq_bid();
  int tstart = 0, tend = T, lb = bid, nbx = gridDim.x;
  if ((gridDim.x & 7) == 0) {
    int xcd = bid & 7; lb = bid >> 3; nbx = gridDim.x >> 3;
    tstart = (int)((long)T * xcd / 8); tend = (int)((long)T * (xcd + 1) / 8);
  }
  const int ng_full = tn / 8, rem = tn % 8, per_group = tm * 8;
  const int nk = K / 64;
  const int sr = tid >> 3, sc = (tid & 7) * 8;
  const int b0 = pass * NB;
  auto tile = [&](const int mi, const int ni, auto split_tag, const int ks) __attribute__((always_inline)) {
    constexpr bool SPLIT = decltype(split_tag)::value;
    const int kt0 = SPLIT ? ks * 4 : 0;
    const int kt1 = SPLIT ? kt0 + 4 : nk;
    const int m0 = mi * 128, n0 = ni * 128;
    f32x16 acc[2][2];
#pragma unroll
    for (int i = 0; i < 2; ++i)
#pragma unroll
      for (int j = 0; j < 2; ++j)
#pragma unroll
        for (int r = 0; r < 16; ++r) acc[i][j][r] = 0.f;
    const bf16_t* ga = A + (size_t)(m0 + sr) * K + sc + kt0 * 64;
    const bf16_t* gb = Bt + (size_t)(n0 + sr) * K + sc + kt0 * 64;
    bf16x8 ra[4], rb[4];
#pragma unroll
    for (int i = 0; i < 4; ++i) { ra[i] = *(const bf16x8*)(ga + (size_t)i * 32 * K); rb[i] = *(const bf16x8*)(gb + (size_t)i * 32 * K); }
    if (mode == 1) {
      int row = m0 + (tid >> 1), grp = tid & 1;
      const float* sp = p.SSQ + (size_t)row * 16 + grp * 8;
      f32x4 s0 = *(const f32x4*)sp, s1 = *(const f32x4*)(sp + 4);
      float ss = s0[0] + s0[1] + s0[2] + s0[3] + s1[0] + s1[1] + s1[2] + s1[3];
      rsS[tid] = rsqrtf(ss * (1.f / 512.f) + EPS);
    }
    if (mode == 1 && !SPLIT) {
      bf16x8 ra2[4], rb2[4];
#pragma unroll
      for (int i = 0; i < 4; ++i) {
        ra2[i] = *(const bf16x8*)(ga + (size_t)i * 32 * K + 64);
        rb2[i] = *(const bf16x8*)(gb + (size_t)i * 32 * K + 64);
      }
      auto mma4 = [&]() __attribute__((always_inline)) {
#pragma unroll
        for (int kk = 0; kk < 4; ++kk) {
          bf16x8 a0 = *(const bf16x8*)(As + (wm * 64 + lr) * 72 + kk * 16 + lh * 8);
          bf16x8 a1 = *(const bf16x8*)(As + (wm * 64 + 32 + lr) * 72 + kk * 16 + lh * 8);
          bf16x8 b0v = *(const bf16x8*)(Bs + (wn * 64 + lr) * 72 + kk * 16 + lh * 8);
          bf16x8 b1v = *(const bf16x8*)(Bs + (wn * 64 + 32 + lr) * 72 + kk * 16 + lh * 8);
          acc[0][0] = __builtin_amdgcn_mfma_f32_32x32x16_bf16(a0, b0v, acc[0][0], 0, 0, 0);
          acc[0][1] = __builtin_amdgcn_mfma_f32_32x32x16_bf16(a0, b1v, acc[0][1], 0, 0, 0);
          acc[1][0] = __builtin_amdgcn_mfma_f32_32x32x16_bf16(a1, b0v, acc[1][0], 0, 0, 0);
          acc[1][1] = __builtin_amdgcn_mfma_f32_32x32x16_bf16(a1, b1v, acc[1][1], 0, 0, 0);
        }
      };
      for (int kt = 0; kt < 32; kt += 2) {
        __syncthreads();
#pragma unroll
        for (int i = 0; i < 4; ++i) {
          *(bf16x8*)(As + (sr + i * 32) * 72 + sc) = ra[i];
          *(bf16x8*)(Bs + (sr + i * 32) * 72 + sc) = rb[i];
        }
        __syncthreads();
        if (kt + 2 < 32) {
#pragma unroll
          for (int i = 0; i < 4; ++i) {
            ra[i] = *(const bf16x8*)(ga + (size_t)i * 32 * K + (kt + 2) * 64);
            rb[i] = *(const bf16x8*)(gb + (size_t)i * 32 * K + (kt + 2) * 64);
          }
        }
        mma4();
        __syncthreads();
#pragma unroll
        for (int i = 0; i < 4; ++i) {
          *(bf16x8*)(As + (sr + i * 32) * 72 + sc) = ra2[i];
          *(bf16x8*)(Bs + (sr + i * 32) * 72 + sc) = rb2[i];
        }
        __syncthreads();
        if (kt + 3 < 32) {
#pragma unroll
          for (int i = 0; i < 4; ++i) {
            ra2[i] = *(const bf16x8*)(ga + (size_t)i * 32 * K + (kt + 3) * 64);
            rb2[i] = *(const bf16x8*)(gb + (size_t)i * 32 * K + (kt + 3) * 64);
          }
        }
        mma4();
        if (kt == 6 || kt == 14) {
#pragma unroll
          for (int i = 0; i < 2; ++i)
#pragma unroll
            for (int r = 0; r < 16; ++r) {
              int lrow = wm * 64 + i * 32 + (r & 3) + 8 * (r >> 2) + 4 * lh;
              float r0 = rsS[lrow * 2], r1 = rsS[lrow * 2 + 1];
              float f = (kt == 6) ? r0 * __builtin_amdgcn_rcpf(r1) : r1;
              acc[i][0][r] *= f; acc[i][1][r] *= f;
            }
        }
      }
    } else
    for (int kt = kt0; kt < kt1; ++kt) {
      __syncthreads();
#pragma unroll
      for (int i = 0; i < 4; ++i) {
        *(bf16x8*)(As + (sr + i * 32) * 72 + sc) = ra[i];
        *(bf16x8*)(Bs + (sr + i * 32) * 72 + sc) = rb[i];
      }
      __syncthreads();
      if (kt + 1 < kt1) {
#pragma unroll
        for (int i = 0; i < 4; ++i) {
          ra[i] = *(const bf16x8*)(ga + (size_t)i * 32 * K + (kt + 1 - kt0) * 64);
          rb[i] = *(const bf16x8*)(gb + (size_t)i * 32 * K + (kt + 1 - kt0) * 64);
        }
      }
#pragma unroll
      for (int kk = 0; kk < 4; ++kk) {
        bf16x8 a0 = *(const bf16x8*)(As + (wm * 64 + lr) * 72 + kk * 16 + lh * 8);
        bf16x8 a1 = *(const bf16x8*)(As + (wm * 64 + 32 + lr) * 72 + kk * 16 + lh * 8);
        bf16x8 b0v = *(const bf16x8*)(Bs + (wn * 64 + lr) * 72 + kk * 16 + lh * 8);
        bf16x8 b1v = *(const bf16x8*)(Bs + (wn * 64 + 32 + lr) * 72 + kk * 16 + lh * 8);
        acc[0][0] = __builtin_amdgcn_mfma_f32_32x32x16_bf16(a0, b0v, acc[0][0], 0, 0, 0);
        acc[0][1] = __builtin_amdgcn_mfma_f32_32x32x16_bf16(a0, b1v, acc[0][1], 0, 0, 0);
        acc[1][0] = __builtin_amdgcn_mfma_f32_32x32x16_bf16(a1, b0v, acc[1][0], 0, 0, 0);
        acc[1][1] = __builtin_amdgcn_mfma_f32_32x32x16_bf16(a1, b1v, acc[1][1], 0, 0, 0);
      }
      if (mode == 1 && !SPLIT && (kt == 7 || kt == 15)) {
#pragma unroll
        for (int i = 0; i < 2; ++i)
#pragma unroll
          for (int r = 0; r < 16; ++r) {
            int lrow = wm * 64 + i * 32 + (r & 3) + 8 * (r >> 2) + 4 * lh;
            float r0 = rsS[lrow * 2], r1 = rsS[lrow * 2 + 1];
            float f = (kt == 7) ? r0 * __builtin_amdgcn_rcpf(r1) : r1;
            acc[i][0][r] *= f; acc[i][1][r] *= f;
          }
      }
    }
    if (mode == 0) {
      if (ni < 46) {
        bf16_t* dst; int ld, cb;
        if (ni < 8) { dst = p.PZ; ld = 1024; cb = ni * 128; }
        else if (ni < 20) { dst = p.PXBC; ld = 1536; cb = (ni - 8) * 128; }
        else if (ni < 36) { dst = p.PSC; ld = 2048; cb = (ni - 20) * 128; }
        else { dst = p.PATT; ld = 1280; cb = (ni - 36) * 128; }
#pragma unroll
        for (int i = 0; i < 2; ++i)
#pragma unroll
          for (int j = 0; j < 2; ++j)
#pragma unroll
            for (int r = 0; r < 16; ++r) {
              int row = m0 + wm * 64 + i * 32 + (r & 3) + 8 * (r >> 2) + 4 * lh;
              int col = cb + wn * 64 + j * 32 + lr;
              dst[(size_t)row * ld + col] = f2bf(acc[i][j][r]);
            }
      } else if (wn == 0) {
#pragma unroll
        for (int i = 0; i < 2; ++i)
#pragma unroll
          for (int r = 0; r < 16; ++r) {
            int row = m0 + wm * 64 + i * 32 + (r & 3) + 8 * (r >> 2) + 4 * lh;
            p.DTRAW[(size_t)row * 32 + lr] = acc[i][0][r];
          }
      }
    } else if (!SPLIT) {
      float* Os = (float*)smem;
      const int ocol4 = (tid & 31) * 4, orow = tid >> 5;
      const int b = b0 + m0 / SEQ;
      const float4 g4 = *(const float4*)(p.MOD + ((size_t)layer * 5 + b) * 3072 + 2048 + n0 + ocol4);
      __syncthreads();
#pragma unroll
      for (int half = 0; half < 2; ++half) {
        if (wm == half) {
#pragma unroll
          for (int i = 0; i < 2; ++i)
#pragma unroll
            for (int j = 0; j < 2; ++j)
#pragma unroll
              for (int r = 0; r < 16; ++r)
                Os[(i * 32 + (r & 3) + 8 * (r >> 2) + 4 * lh) * 132 + wn * 64 + j * 32 + lr] = acc[i][j][r];
        }
        __syncthreads();
#pragma unroll 4
        for (int k = 0; k < 8; ++k) {
          int row = orow + 8 * k;
          float4 v = *(const float4*)(Os + row * 132 + ocol4);
          size_t idx = ((size_t)b0 * SEQ + m0 + half * 64 + row) * D + n0 + ocol4;
          float4 x4 = (layer == 0) ? *(const float4*)(p.x + idx) : *(const float4*)(p.out + idx);
          float4 o = {x4.x + g4.x * v.x, x4.y + g4.y * v.y, x4.z + g4.z * v.z, x4.w + g4.w * v.w};
          *(float4*)(p.out + idx) = o;
        }
        __syncthreads();
      }
    } else {
#pragma unroll
      for (int i = 0; i < 2; ++i)
#pragma unroll
        for (int j = 0; j < 2; ++j)
#pragma unroll
          for (int r = 0; r < 16; ++r) {
            int row = m0 + wm * 64 + i * 32 + (r & 3) + 8 * (r >> 2) + 4 * lh;
            int col = n0 + wn * 64 + j * 32 + lr;
            int lrow = row - m0;
            float f = (ks < 4) ? rsS[lrow * 2 + (ks >> 1)] : 1.f;
            p.PART[((size_t)ks * NTC + (row - NTL)) * D + col] = acc[i][j][r] * f;
          }
    }
  };
  for (int t = tstart + lb; t < tend; t += nbx) {
    int mi, ni;
    if (t >= T_main) { int e = t - T_main, j = e % 15; mi = 64 + e / 15; ni = (j < 12) ? 8 + j : ((j < 14) ? 28 + j : 46); }
    else if (t < ng_full * per_group) { int ng = t / per_group, r = t % per_group; mi = r >> 3; ni = ng * 8 + (r & 7); }
    else { int r = t - ng_full * per_group; mi = r / rem; ni = ng_full * 8 + r % rem; }
    tile(mi, ni, std::integral_constant<bool, false>{}, -1);
  }
  if (do_split) {
    for (int s = bid; s < 256; s += gridDim.x) {
      int ct = s >> 3, ks = s & 7;
      tile(64 + (ct >> 3), ct & 7, std::integral_constant<bool, true>{}, ks);
    }
  }
}

__device__ void phase_gemm_in256(const Params& p, int layer, int pass, bf16_t* smem) {
  constexpr int K = 1024, nk = 16;
  const bf16_t* A = p.H;
  const bf16_t* Bt = p.WinT + (size_t)layer * NWIN * 1024;
  const bool ctx_sparse = (layer == 1);
  const int tm = (ctx_sparse ? NTL : NT) / 256, tn = NWIN / 128, T_main = tm * tn, T = T_main + (ctx_sparse ? 30 : 0);
  const int tid = opq_tid(), lane = tid & 63, wid = tid >> 6, wm = wid >> 1, wn = wid & 1;
  const int lr = lane & 31, lh = lane >> 5;
  bf16_t* As = smem;
  bf16_t* Bs = smem + 256 * 72;
  const int bid = opq_bid();
  int tstart = 0, tend = T, lb = bid, nbx = gridDim.x;
  if ((gridDim.x & 7) == 0) {
    int xcd = bid & 7; lb = bid >> 3; nbx = gridDim.x >> 3;
    tstart = (int)((long)T * xcd / 8); tend = (int)((long)T * (xcd + 1) / 8);
  }
  const int ng_full = tn / 8, rem = tn % 8, per_group = tm * 8;
  const int sr = tid >> 3, sc = (tid & 7) * 8;
  for (int t = tstart + lb; t < tend; t += nbx) {
    int mi, ni;
    if (t >= T_main) { int e = t - T_main, j = e % 15; mi = 32 + e / 15; ni = (j < 12) ? 8 + j : ((j < 14) ? 28 + j : 46); }
    else if (t < ng_full * per_group) { int ng = t / per_group, r = t % per_group; mi = r >> 3; ni = ng * 8 + (r & 7); }
    else { int r = t - ng_full * per_group; mi = r / rem; ni = ng_full * 8 + r % rem; }
    const int m0 = mi * 256, n0 = ni * 128;
    f32x16 acc[4][2];
#pragma unroll
    for (int i = 0; i < 4; ++i)
#pragma unroll
      for (int j = 0; j < 2; ++j)
#pragma unroll
        for (int r = 0; r < 16; ++r) acc[i][j][r] = 0.f;
    const bf16_t* ga = A + (size_t)(m0 + sr) * K + sc;
    const bf16_t* gb = Bt + (size_t)(n0 + sr) * K + sc;
    bf16x8 ra[8], rb[4];
#pragma unroll
    for (int i = 0; i < 8; ++i) ra[i] = *(const bf16x8*)(ga + (size_t)i * 32 * K);
#pragma unroll
    for (int i = 0; i < 4; ++i) rb[i] = *(const bf16x8*)(gb + (size_t)i * 32 * K);
    for (int kt = 0; kt < nk; ++kt) {
      __syncthreads();
#pragma unroll
      for (int i = 0; i < 8; ++i) *(bf16x8*)(As + (sr + i * 32) * 72 + sc) = ra[i];
#pragma unroll
      for (int i = 0; i < 4; ++i) *(bf16x8*)(Bs + (sr + i * 32) * 72 + sc) = rb[i];
      __syncthreads();
      if (kt + 1 < nk) {
#pragma unroll
        for (int i = 0; i < 8; ++i) ra[i] = *(const bf16x8*)(ga + (size_t)i * 32 * K + (kt + 1) * 64);
#pragma unroll
        for (int i = 0; i < 4; ++i) rb[i] = *(const bf16x8*)(gb + (size_t)i * 32 * K + (kt + 1) * 64);
      }
#pragma unroll
      for (int kk = 0; kk < 4; ++kk) {
        bf16x8 b0v = *(const bf16x8*)(Bs + (wn * 64 + lr) * 72 + kk * 16 + lh * 8);
        bf16x8 b1v = *(const bf16x8*)(Bs + (wn * 64 + 32 + lr) * 72 + kk * 16 + lh * 8);
#pragma unroll
        for (int i = 0; i < 4; ++i) {
          bf16x8 av = *(const bf16x8*)(As + (wm * 128 + i * 32 + lr) * 72 + kk * 16 + lh * 8);
          acc[i][0] = __builtin_amdgcn_mfma_f32_32x32x16_bf16(av, b0v, acc[i][0], 0, 0, 0);
          acc[i][1] = __builtin_amdgcn_mfma_f32_32x32x16_bf16(av, b1v, acc[i][1], 0, 0, 0);
        }
      }
    }
    if (ni < 46) {
      bf16_t* dst; int ld, cb;
      if (ni < 8) { dst = p.PZ; ld = 1024; cb = ni * 128; }
      else if (ni < 20) { dst = p.PXBC; ld = 1536; cb = (ni - 8) * 128; }
      else if (ni < 36) { dst = p.PSC; ld = 2048; cb = (ni - 20) * 128; }
      else { dst = p.PATT; ld = 1280; cb = (ni - 36) * 128; }
      bf16_t* Os = smem;
      __syncthreads();
#pragma unroll
      for (int half = 0; half < 2; ++half) {
        if (wm == half) {
          bf16_t* q = Os + (4 * lh) * 136 + wn * 64 + lr;
#pragma unroll
          for (int i = 0; i < 4; ++i)
#pragma unroll
            for (int j = 0; j < 2; ++j)
#pragma unroll
              for (int r = 0; r < 16; ++r) q[(i * 32 + (r & 3) + 8 * (r >> 2)) * 136 + j * 32] = f2bf(acc[i][j][r]);
        }
        __syncthreads();
        {
          const int orow = tid >> 4, ocol = (tid & 15) * 8;
          bf16_t* gd = dst + (size_t)(m0 + half * 128 + orow) * ld + cb + ocol;
#pragma unroll
          for (int k = 0; k < 8; ++k) {
            bf16x8 v = *(const bf16x8*)(Os + (orow + 16 * k) * 136 + ocol);
            *(bf16x8*)(gd + (size_t)(16 * k) * ld) = v;
          }
        }
        __syncthreads();
      }
    } else if (wn == 0) {
#pragma unroll
      for (int i = 0; i < 4; ++i)
#pragma unroll
        for (int r = 0; r < 16; ++r) {
          int row = m0 + wm * 128 + i * 32 + (r & 3) + 8 * (r >> 2) + 4 * lh;
          p.DTRAW[(size_t)row * 32 + lr] = acc[i][0][r];
        }
    }
  }
}

__device__ void phase_prep(const Params& p, int layer, int pass, float* smem) {
  const int tid = opq_tid(), lane = tid & 63;
  const int gw = opq_bid() * 4 + (tid >> 6), nw = gridDim.x * 4;
  for (int gc = opq_bid(); gc < NCH; gc += gridDim.x) {
    float* sda = smem; float* sdt = smem + 4224;
    for (int e = tid; e < 4096; e += 256) {
      int l = e >> 5, dh = e & 31;
      float raw = p.DTRAW[((size_t)gc * 128 + l) * 32 + dh] + p.ssd_dt_bias[layer * 32 + dh];
      float dt = raw > 20.f ? raw : log1pf(expf(raw));
      float A = -expf(p.ssd_a_log[layer * 32 + dh]);
      sdt[l * 33 + dh] = dt;
      sda[l * 33 + dh] = dt * A;
    }
    __syncthreads();
    {
      const int dh = tid & 31, seg = tid >> 5;
      float* segtot = smem + 8448;
      float loc[16]; float s = 0.f;
      if (dh < 16) {
#pragma unroll
        for (int j = 0; j < 16; ++j) { s += sda[(seg * 16 + j) * 33 + dh]; loc[j] = s; }
      } else {
#pragma unroll
        for (int j = 15; j >= 0; --j) { s += sda[(seg * 16 + j) * 33 + dh]; loc[j] = s; }
      }
      segtot[seg * 32 + dh] = s;
      __syncthreads();
      float off = 0.f;
      if (dh < 16) { for (int k = 0; k < seg; ++k) off += segtot[k * 32 + dh]; }
      else { for (int k = 7; k > seg; --k) off += segtot[k * 32 + dh]; }
#pragma unroll
      for (int j = 0; j < 16; ++j) sda[(seg * 16 + j) * 33 + dh] = loc[j] + off;
    }
    __syncthreads();
    for (int e = tid; e < 4096; e += 256) {
      int dh = e >> 7, l = e & 127;
      float cum = sda[l * 33 + dh], dt = sdt[l * 33 + dh];
      float tot = (dh < 16) ? sda[127 * 33 + dh] : sda[dh];
      size_t idx = ((size_t)gc * 32 + dh) * 128 + l;
      p.CUMT[idx] = cum;
      p.VV[idx] = cum - logf(fmaxf(dt, 1e-30f));
      p.EC[idx] = expf(cum);
      p.WW[idx] = dt * expf(tot - cum);
    }
    __syncthreads();
  }
  const int nchc = (layer == 0) ? NCH : 64;
  const int Nb = NCH * 4 * 24, Nc = nchc * 16, Nd = (NT * 40) / 64, Ne = NCH * 16 * 2;
  for (int uu = gw; uu < Nb + Nc + Nd + Ne; uu += nw) {
  if (uu < Nb) {
    const int u = uu;
    int cblk = u % 24, l32 = (u / 24) & 3, gc = u / (24 * 4);
    int c = cblk * 64 + lane;
    bool first, last;
    if (gc < 64) { first = (gc % 32 == 0) && l32 == 0; last = (gc % 32 == 31) && l32 == 3; }
    else { first = ((gc - 64) % 2 == 0) && l32 == 0; last = ((gc - 64) % 2 == 1) && l32 == 3; }
    int t0 = gc * 128 + l32 * 32;
    float w0 = p.ssd_conv_w[((size_t)layer * 3 + 0) * 1536 + c], w1 = p.ssd_conv_w[((size_t)layer * 3 + 1) * 1536 + c],
          w2 = p.ssd_conv_w[((size_t)layer * 3 + 2) * 1536 + c], bs = p.ssd_conv_b[layer * 1536 + c];
    bf16_t raw[34];
#pragma unroll
    for (int i = 0; i < 34; ++i) {
      bool ok = !((i == 0 && first) || (i == 33 && last));
      raw[i] = ok ? p.PXBC[(size_t)(t0 + i - 1) * 1536 + c] : (bf16_t)0;
    }
    bf16x8 o[4];
#pragma unroll
    for (int j = 0; j < 32; ++j)
      o[j >> 3][j & 7] = (short)f2bf(silu_f(w0 * bf2f(raw[j]) + w1 * bf2f(raw[j + 1]) + w2 * bf2f(raw[j + 2]) + bs));
    if (c < 1024) {
#pragma unroll
      for (int k = 0; k < 4; ++k) *(bf16x8*)(p.XT + ((size_t)gc * 1024 + c) * 128 + l32 * 32 + k * 8) = o[k];
    } else if (c < 1280) {
      int n = c - 1024;
#pragma unroll
      for (int k = 0; k < 4; ++k) *(bf16x8*)(p.BT + ((size_t)gc * 256 + n) * 128 + l32 * 32 + k * 8) = o[k];
#pragma unroll
      for (int j = 0; j < 32; ++j) p.BR[(size_t)(t0 + j) * 256 + n] = (bf16_t)o[j >> 3][j & 7];
    } else {
      int n = c - 1280;
#pragma unroll
      for (int j = 0; j < 32; ++j) p.CR[(size_t)(t0 + j) * 256 + n] = (bf16_t)o[j >> 3][j & 7];
    }
  } else if (uu < Nb + Nc) {
    {
      const int u = uu - Nb;
      const int l8 = u & 15, gc = u >> 4;
      const int c0 = lane * 8;
      bool first, last;
      if (gc < 64) { first = (gc % 32 == 0) && l8 == 0; last = (gc % 32 == 31) && l8 == 15; }
      else { first = ((gc - 64) % 2 == 0) && l8 == 0; last = ((gc - 64) % 2 == 1) && l8 == 15; }
      const int t0 = gc * 128 + l8 * 8;
      float w0[8], w1[8], w2[8];
      {
        const float* wp = p.sc_conv_w + (size_t)layer * 3 * 512 + c0;
        f32x4 a0 = *(const f32x4*)wp, a1 = *(const f32x4*)(wp + 4);
        f32x4 b0 = *(const f32x4*)(wp + 512), b1 = *(const f32x4*)(wp + 516);
        f32x4 d0 = *(const f32x4*)(wp + 1024), d1 = *(const f32x4*)(wp + 1028);
#pragma unroll
        for (int k = 0; k < 4; ++k) { w0[k] = a0[k]; w0[4 + k] = a1[k]; w1[k] = b0[k]; w1[4 + k] = b1[k]; w2[k] = d0[k]; w2[4 + k] = d1[k]; }
      }
      float up[10][8];
#pragma unroll
      for (int i = 0; i < 10; ++i) {
        bool ok = !((i == 0 && first) || (i == 9 && last));
        const bf16_t* r = p.PSC + (size_t)(t0 + i - 1) * 2048 + c0;
        bf16x8 v8 = ok ? *(const bf16x8*)r : bf16x8{0, 0, 0, 0, 0, 0, 0, 0};
        bf16x8 g8 = ok ? *(const bf16x8*)(r + 512) : bf16x8{0, 0, 0, 0, 0, 0, 0, 0};
#pragma unroll
        for (int k = 0; k < 8; ++k) up[i][k] = bf2f((bf16_t)v8[k]) * bf2f((bf16_t)g8[k]);
      }
#pragma unroll
      for (int j = 0; j < 8; ++j) {
        const bf16_t* r = p.PSC + (size_t)(t0 + j) * 2048 + c0;
        bf16x8 b8 = *(const bf16x8*)(r + 1024), z8 = *(const bf16x8*)(r + 1536);
        f32x4 lo, hi;
#pragma unroll
        for (int k = 0; k < 8; ++k) {
          float cv = w0[k] * up[j][k] + w1[k] * up[j + 1][k] + w2[k] * up[j + 2][k];
          float o = bf2f((bf16_t)b8[k]) * cv * silu_f(bf2f((bf16_t)z8[k]));
          if (k < 4) lo[k] = o; else hi[k - 4] = o;
        }
        *(bf16x8*)(p.Y + (size_t)(t0 + j) * 2048 + 1024 + c0) = pack8(lo, hi);
      }
    }
  } else if (uu < Nb + Nc + Nd) {
    {
      const int idx = (uu - Nb - Nc) * 64 + lane;
      int row = idx / 40, r = idx % 40;
      int slot = r >> 2, a = (r >> 1) & 1, i0 = (r & 1) * 8;
      const bf16_t* src = p.PATT + (size_t)row * 1280 + (slot < 8 ? slot * 64 : 512 + (slot - 8) * 64) + a * 32 + i0;
      bf16x8 x1 = *(const bf16x8*)src, x2 = *(const bf16x8*)(src + 16);
      bf16x8 o1, o2;
      if (row < NTL) {
        int t = row & (SEQ - 1);
        int pos = (a == 0) ? (t >> 6) : (t & 63);
        const float* tb = p.ROPE + (pos * 16 + i0) * 2;
#pragma unroll
        for (int j = 0; j < 8; ++j) {
          float cs = tb[2 * j], sn = tb[2 * j + 1];
          float a1 = bf2f((bf16_t)x1[j]), a2 = bf2f((bf16_t)x2[j]);
          o1[j] = (short)f2bf(a1 * cs - a2 * sn);
          o2[j] = (short)f2bf(a1 * sn + a2 * cs);
        }
      } else { o1 = x1; o2 = x2; }
      bf16_t* dst = (slot < 8) ? p.QR + (size_t)row * 512 + slot * 64 + a * 32 + i0
                               : p.KR + (size_t)row * 128 + (slot - 8) * 64 + a * 32 + i0;
      *(bf16x8*)dst = o1; *(bf16x8*)(dst + 16) = o2;
    }
  } else {
    const int u = uu - Nb - Nc - Nd;
    int half = u & 1, l8 = (u >> 1) & 15, gc = u >> 5;
    int c = half * 64 + lane;
    int t0 = gc * 128 + l8 * 8;
    bf16x8 o;
#pragma unroll
    for (int j = 0; j < 8; ++j) o[j] = (short)p.PATT[(size_t)(t0 + j) * 1280 + 640 + c];
    *(bf16x8*)(p.VT + ((size_t)gc * 128 + c) * 128 + l8 * 8) = o;
  }
  }
}

__device__ void phase_attn_naive(const Params& p, int layer, int pass) {
  const int lane = opq_tid() & 63;
  const int gw = opq_bid() * 4 + (opq_tid() >> 6), nw = gridDim.x * 4;
  const int nrows = (layer == 0) ? NT : NTL;
  for (int u = gw; u < nrows * 8; u += nw) {
    int h = u & 7, row = u >> 3, kvh = h >> 2;
    float q = bf2f(p.QR[(size_t)row * 512 + h * 64 + lane]);
    float m = p.attn_sink[layer * 8 + h], l = 1.f, o = 0.f;
    int bl, k0 = 0, k1 = 0;
    if (row < NTL) {
      bl = row / SEQ; int t = row % SEQ;
      int lo = t - 128 < 0 ? 0 : t - 128, hi = t + 128 > SEQ - 1 ? SEQ - 1 : t + 128;
      k0 = bl * SEQ + lo; k1 = bl * SEQ + hi + 1;
    } else bl = (row - NTL) / CTXL;
    int nband = k1 - k0;
    for (int kk = 0; kk < nband + CTXL; ++kk) {
      int kr = (kk < nband) ? k0 + kk : NTL + bl * CTXL + (kk - nband);
      float kv = bf2f(p.KR[(size_t)kr * 128 + kvh * 64 + lane]);
      float vv = bf2f(p.VT[((size_t)(kr >> 7) * 128 + kvh * 64 + lane) * 128 + (kr & 127)]);
      float s = wave_sum(q * kv) * 0.125f;
      float mn = fmaxf(m, s);
      float corr = expf(m - mn), pe = expf(s - mn);
      l = l * corr + pe; o = o * corr + pe * vv; m = mn;
    }
    float z = bf2f(p.PATT[(size_t)row * 1280 + 768 + h * 64 + lane]);
    p.Y[(size_t)row * 2048 + 1536 + h * 64 + lane] = f2bf(o / l * silu_f(z));
  }
}

__device__ void phase_attn(const Params& p, int layer, int pass, bf16_t* smem) {
  const int tid = opq_tid(), lane = tid & 63, wid = tid >> 6, lr = lane & 31, lh = lane >> 5;
  const int nqt = ((layer == 0) ? NT : NTL) / 32;
  const int srow = tid >> 3, scol = (tid & 7) * 8;
  for (int u = (opq_bid() + (int)gridDim.x - 64) % (int)gridDim.x; u < nqt * 2; u += gridDim.x) {
    const int kvh = u & 1, qt = u >> 1, h = kvh * 4 + wid;
    const int q0 = qt * 32;
    int bl, nband = 0, tb0 = 0, t0 = 0;
    if (q0 < NTL) {
      bl = q0 >> 12; t0 = q0 & 4095;
      tb0 = (t0 - 128 < 0) ? 0 : ((t0 - 128) >> 6);
      int tb1 = (t0 + 159) >> 6; if (tb1 > 63) tb1 = 63;
      nband = tb1 - tb0 + 1;
    } else bl = (q0 - NTL) >> 8;
    const int ntile = nband + 4;
    bf16x8 qf[4];
    {
      const bf16_t* qp = p.QR + (size_t)(q0 + lr) * 512 + h * 64 + lh * 8;
#pragma unroll
      for (int kk = 0; kk < 4; ++kk) qf[kk] = *(const bf16x8*)(qp + kk * 16);
    }
    float m = p.attn_sink[layer * 8 + h], l = 1.f;
    f32x16 o[2];
#pragma unroll
    for (int r = 0; r < 16; ++r) { o[0][r] = 0.f; o[1][r] = 0.f; }
    const int qpos = t0 + lr;
    bf16x8 rk[2], rv[2];
    auto fetch = [&](int ti) __attribute__((always_inline)) {
      const int kr0 = (ti < nband) ? bl * 4096 + (tb0 + ti) * 64 : NTL + bl * 256 + (ti - nband) * 64;
      const bf16_t* kp = p.KR + (size_t)(kr0 + srow) * 128 + kvh * 64 + scol;
      const bf16_t* vp = p.VT + ((size_t)(kr0 >> 7) * 128 + kvh * 64 + srow) * 128 + (kr0 & 127) + scol;
      rk[0] = *(const bf16x8*)kp; rk[1] = *(const bf16x8*)(kp + 32 * 128);
      rv[0] = *(const bf16x8*)vp; rv[1] = *(const bf16x8*)(vp + 32 * 128);
    };
    auto stash = [&](bf16_t* buf) __attribute__((always_inline)) {
      *(bf16x8*)(buf + srow * 72 + scol) = rk[0];
      *(bf16x8*)(buf + (srow + 32) * 72 + scol) = rk[1];
      *(bf16x8*)(buf + 4608 + srow * 72 + scol) = rv[0];
      *(bf16x8*)(buf + 4608 + (srow + 32) * 72 + scol) = rv[1];
    };
    fetch(0);
    __syncthreads();
    stash(smem);
    if (1 < ntile) fetch(1);
    __syncthreads();
    for (int ti = 0; ti < ntile; ++ti) {
      const bf16_t* Kc = smem + (ti & 1) * 9216;
      const bf16_t* Vc = Kc + 4608;
      if (ti + 1 < ntile) {
        stash(smem + ((ti + 1) & 1) * 9216);
        if (ti + 2 < ntile) fetch(ti + 2);
      }
      f32x16 st[2];
#pragma unroll
      for (int r = 0; r < 16; ++r) { st[0][r] = 0.f; st[1][r] = 0.f; }
#pragma unroll
      for (int kk = 0; kk < 4; ++kk) {
        bf16x8 kf0 = *(const bf16x8*)(Kc + lr * 72 + kk * 16 + lh * 8);
        bf16x8 kf1 = *(const bf16x8*)(Kc + (32 + lr) * 72 + kk * 16 + lh * 8);
        st[0] = __builtin_amdgcn_mfma_f32_32x32x16_bf16(kf0, qf[kk], st[0], 0, 0, 0);
        st[1] = __builtin_amdgcn_mfma_f32_32x32x16_bf16(kf1, qf[kk], st[1], 0, 0, 0);
      }
      float mx = -3.0e38f;
      const bool band = ti < nband;
      const int kbase = (tb0 + ti) * 64 + 4 * lh;
#pragma unroll
      for (int hh = 0; hh < 2; ++hh)
#pragma unroll
        for (int r = 0; r < 16; ++r) {
          float s = st[hh][r] * 0.125f;
          if (band) {
            int dd = qpos - (kbase + hh * 32 + (r & 3) + 8 * (r >> 2));
            if (dd > 128 || dd < -128) s = -1e30f;
          }
          st[hh][r] = s; mx = fmaxf(mx, s);
        }
      mx = fmaxf(mx, __shfl_xor(mx, 32));
      const float mn = fmaxf(m, mx);
      const float corr = __expf(m - mn);
      m = mn;
      float ls = 0.f;
#pragma unroll
      for (int hh = 0; hh < 2; ++hh)
#pragma unroll
        for (int r = 0; r < 16; ++r) { st[hh][r] = __expf(st[hh][r] - mn); ls += st[hh][r]; }
      ls += __shfl_xor(ls, 32);
      l = l * corr + ls;
#pragma unroll
      for (int r = 0; r < 16; ++r) { o[0][r] *= corr; o[1][r] *= corr; }
#pragma unroll
      for (int hh = 0; hh < 2; ++hh)
#pragma unroll
        for (int s2 = 0; s2 < 2; ++s2) {
          f32x4 pa = {st[hh][8 * s2 + 0], st[hh][8 * s2 + 1], st[hh][8 * s2 + 2], st[hh][8 * s2 + 3]};
          f32x4 pb = {st[hh][8 * s2 + 4], st[hh][8 * s2 + 5], st[hh][8 * s2 + 6], st[hh][8 * s2 + 7]};
          bf16x8 pf = pack8(pa, pb);
#pragma unroll
          for (int mt = 0; mt < 2; ++mt) {
            const bf16_t* vp = Vc + (mt * 32 + lr) * 72 + hh * 32 + 16 * s2 + 4 * lh;
            bf16x4 x0 = *(const bf16x4*)vp, x1 = *(const bf16x4*)(vp + 8);
            bf16x8 vfr = {x0[0], x0[1], x0[2], x0[3], x1[0], x1[1], x1[2], x1[3]};
            o[mt] = __builtin_amdgcn_mfma_f32_32x32x16_bf16(vfr, pf, o[mt], 0, 0, 0);
          }
        }
      __syncthreads();
    }
    const float inv = 1.f / l;
    {
      bf16_t* Zw = smem + 2 * 9216 + wid * (32 * 72);
      const int er = lane >> 3, ec = (lane & 7) * 8;
      const bf16_t* zg = p.PATT + (size_t)(q0 + er) * 1280 + 768 + h * 64 + ec;
      bf16x8 zr[4];
#pragma unroll
      for (int i = 0; i < 4; ++i) zr[i] = *(const bf16x8*)(zg + (size_t)i * 8 * 1280);
#pragma unroll
      for (int i = 0; i < 4; ++i) *(bf16x8*)(Zw + (er + 8 * i) * 72 + ec) = zr[i];
#pragma unroll
      for (int mt = 0; mt < 2; ++mt)
#pragma unroll
        for (int qq = 0; qq < 4; ++qq) {
          int d0 = mt * 32 + 8 * qq + 4 * lh;
          bf16x4 z4 = *(const bf16x4*)(Zw + lr * 72 + d0);
          bf16x4 o4;
#pragma unroll
          for (int t = 0; t < 4; ++t) o4[t] = (short)f2bf(o[mt][qq * 4 + t] * inv * silu_f(bf2f((bf16_t)z4[t])));
          *(bf16x4*)(Zw + lr * 72 + d0) = o4;
        }
      bf16_t* yg = p.Y + (size_t)(q0 + er) * 2048 + 1536 + h * 64 + ec;
#pragma unroll
      for (int i = 0; i < 4; ++i) *(bf16x8*)(yg + (size_t)i * 8 * 2048) = *(const bf16x8*)(Zw + (er + 8 * i) * 72 + ec);
    }
  }
}

__device__ void phase_s1(const Params& p, int layer, int pass, bf16_t* smem) {
  const int tid = opq_tid(), lane = tid & 63, nt = tid >> 6, lr = lane & 31, lh = lane >> 5;
  constexpr int RS = 136;
  bf16_t* Xs = smem;
  bf16_t* Bts = smem + 64 * RS;
  float* Ws = (float*)(smem + 192 * RS);
  const int srow = tid >> 4, scol = (tid & 15) * 8;
  for (int u = opq_bid(); u < NCH * 16; u += gridDim.x) {
    const int h = u & 15, gc = u >> 4, g = h >> 3;
    bf16x8 rx[4], rb[8];
    {
      const bf16_t* Xg = p.XT + ((size_t)gc * 1024 + h * 64 + srow) * 128 + scol;
#pragma unroll
      for (int i = 0; i < 4; ++i) rx[i] = *(const bf16x8*)(Xg + i * 2048);
      const bf16_t* Bg = p.BT + ((size_t)gc * 256 + g * 128 + srow) * 128 + scol;
#pragma unroll
      for (int i = 0; i < 8; ++i) rb[i] = *(const bf16x8*)(Bg + i * 2048);
    }
    const float wv = p.WW[((size_t)gc * 32 + (tid >> 7) * 16 + h) * 128 + (tid & 127)];
    __syncthreads();
#pragma unroll
    for (int i = 0; i < 4; ++i) *(bf16x8*)(Xs + (srow + 16 * i) * RS + scol) = rx[i];
#pragma unroll
    for (int i = 0; i < 8; ++i) *(bf16x8*)(Bts + (srow + 16 * i) * RS + scol) = rb[i];
    Ws[tid] = wv;
    __syncthreads();
#pragma unroll 1
    for (int d = 0; d < 2; ++d) {
      f32x16 acc0, acc1;
#pragma unroll
      for (int r = 0; r < 16; ++r) { acc0[r] = 0.f; acc1[r] = 0.f; }
#pragma unroll
      for (int kk = 0; kk < 8; ++kk) {
        bf16x8 bfr = *(const bf16x8*)(Bts + (nt * 32 + lr) * RS + kk * 16 + lh * 8);
        bf16x8 x0 = *(const bf16x8*)(Xs + lr * RS + kk * 16 + lh * 8);
        bf16x8 x1 = *(const bf16x8*)(Xs + (32 + lr) * RS + kk * 16 + lh * 8);
        f32x4 wa = *(const f32x4*)(Ws + d * 128 + kk * 16 + lh * 8), wb = *(const f32x4*)(Ws + d * 128 + kk * 16 + lh * 8 + 4);
        f32x4 a0, a1, c0, c1;
#pragma unroll
        for (int j = 0; j < 4; ++j) {
          a0[j] = bf2f((bf16_t)x0[j]) * wa[j]; a1[j] = bf2f((bf16_t)x0[4 + j]) * wb[j];
          c0[j] = bf2f((bf16_t)x1[j]) * wa[j]; c1[j] = bf2f((bf16_t)x1[4 + j]) * wb[j];
        }
        acc0 = __builtin_amdgcn_mfma_f32_32x32x16_bf16(pack8(a0, a1), bfr, acc0, 0, 0, 0);
        acc1 = __builtin_amdgcn_mfma_f32_32x32x16_bf16(pack8(c0, c1), bfr, acc1, 0, 0, 0);
      }
      float* dst = p.LST + ((((size_t)gc * 16 + h) * 2 + d) * 64) * 128 + nt * 32 + lr;
#pragma unroll
      for (int r = 0; r < 16; ++r) {
        int pp = (r & 3) + 8 * (r >> 2) + 4 * lh;
        dst[(size_t)pp * 128] = acc0[r];
        dst[(size_t)(32 + pp) * 128] = acc1[r];
      }
    }
  }
}

__device__ __forceinline__ int scan_chunk(int ci, int bl, int d) {
  if (ci < 2) return 64 + bl * 2 + (d == 0 ? ci : 1 - ci);
  int cc = ci - 2;
  return bl * 32 + (d == 0 ? cc : 31 - cc);
}
__device__ void phase_s2(const Params& p, int layer, int pass) {
  const int nth = gridDim.x * 256;
  for (int e = opq_bid() * 256 + opq_tid(); e < 64 * 2048; e += nth) {
    int seq = e >> 11, q = e & 2047, pp = q >> 5, n4 = (q & 31) * 4;
    int d = seq & 1, h = (seq >> 1) & 15, bl = seq >> 5;
    f32x4 s = {0.f, 0.f, 0.f, 0.f};
    const size_t eoff = ((size_t)h * 2 + d) * 8192 + (size_t)pp * 128 + n4;
    const int toff = (d == 0) ? h * 128 + 127 : (16 + h) * 128;
#pragma unroll
    for (int half = 0; half < 2; ++half) {
      f32x4 loc[17]; float tot[17];
#pragma unroll
      for (int i = 0; i < 17; ++i) {
        int gc = scan_chunk(half * 17 + i, bl, d);
        loc[i] = *(const f32x4*)(p.LST + (size_t)gc * 262144 + eoff);
        tot[i] = p.CUMT[(size_t)gc * 4096 + toff];
      }
#pragma unroll
      for (int i = 0; i < 17; ++i) {
        int gc = scan_chunk(half * 17 + i, bl, d);
        uint2 o; o.x = pk2(s[0], s[1]); o.y = pk2(s[2], s[3]);
        *(uint2*)(p.SIN + (size_t)gc * 262144 + eoff) = o;
        float dec = expf(tot[i]);
        s = s * dec + loc[i];
      }
    }
  }
}

__device__ void phase_s3(const Params& p, int layer, int pass, bf16_t* smem) {
  const int tid = opq_tid(), lane = tid & 63, w = tid >> 6, lr = lane & 31, lh = lane >> 5;
  const int nch = (layer == 0) ? NCH : 64;
  constexpr int RS = 136;
  bf16_t* Ss = smem;
  bf16_t* Bs = smem;
  bf16_t* Xs = smem + 128 * RS;
  float* Vs = (float*)(smem + 192 * RS);
  bf16_t* Zs = smem + 192 * RS + 1536;
  bf16_t* Os = smem;
  const int srow = tid >> 4, scol = (tid & 15) * 8;
  for (int u = opq_bid(); u < nch * 16; u += gridDim.x) {
    const int h = u & 15, gc = u >> 4, g = h >> 3;
    const int i_own = 32 * w + lr;
    bf16x8 rs[8];
    {
      const bf16_t* Sg = p.SIN + ((size_t)gc * 16 + h) * 16384 + srow * 128 + scol;
#pragma unroll
      for (int i = 0; i < 8; ++i) rs[i] = *(const bf16x8*)(Sg + i * 2048);
    }
    bf16x8 cf[8];
    {
      const bf16_t* crow = p.CR + ((size_t)gc * 128 + i_own) * 256 + g * 128 + lh * 8;
#pragma unroll
      for (int kk = 0; kk < 8; ++kk) cf[kk] = *(const bf16x8*)(crow + kk * 16);
    }
    bf16x8 rz[4];
    {
      const bf16_t* Zg = p.PZ + ((size_t)gc * 128 + (tid >> 3)) * 1024 + h * 64 + (tid & 7) * 8;
#pragma unroll
      for (int i = 0; i < 4; ++i) rz[i] = *(const bf16x8*)(Zg + (size_t)i * 32 * 1024);
    }
    const size_t vidx = ((size_t)gc * 32 + (tid >> 7) * 16 + h) * 128 + (tid & 127);
    const float v_vv = p.VV[vidx], v_ec = p.EC[vidx], v_cu = p.CUMT[vidx];
    __syncthreads();
#pragma unroll
    for (int i = 0; i < 8; ++i) *(bf16x8*)(Ss + (srow + 16 * i) * RS + scol) = rs[i];
    Vs[tid] = v_vv; Vs[256 + tid] = v_ec; Vs[512 + tid] = v_cu;
#pragma unroll
    for (int i = 0; i < 4; ++i) *(bf16x8*)(Zs + ((tid >> 3) + 32 * i) * 72 + (tid & 7) * 8) = rz[i];
    bf16x8 rb[8], rx[4];
    {
      const bf16_t* Bg = p.BR + ((size_t)gc * 128 + srow) * 256 + g * 128 + scol;
#pragma unroll
      for (int i = 0; i < 8; ++i) rb[i] = *(const bf16x8*)(Bg + i * 16 * 256);
      const bf16_t* Xg = p.XT + ((size_t)gc * 1024 + h * 64 + srow) * 128 + scol;
#pragma unroll
      for (int i = 0; i < 4; ++i) rx[i] = *(const bf16x8*)(Xg + i * 2048);
    }
    __syncthreads();
    f32x16 y[2];
#pragma unroll
    for (int r = 0; r < 16; ++r) { y[0][r] = 0.f; y[1][r] = 0.f; }
#pragma unroll
    for (int d = 0; d < 2; ++d) {
      const float* ec = Vs + 256 + d * 128 + 32 * w + 4 * lh;
#pragma unroll
      for (int pt = 0; pt < 2; ++pt) {
        f32x16 tmp;
#pragma unroll
        for (int r = 0; r < 16; ++r) tmp[r] = 0.f;
        const bf16_t* sl = Ss + (d * 64 + pt * 32 + lr) * RS + lh * 8;
#pragma unroll
        for (int kk = 0; kk < 8; ++kk) {
          bf16x8 sf = *(const bf16x8*)(sl + kk * 16);
          tmp = __builtin_amdgcn_mfma_f32_32x32x16_bf16(cf[kk], sf, tmp, 0, 0, 0);
        }
#pragma unroll
        for (int q = 0; q < 4; ++q) {
          f32x4 e4 = *(const f32x4*)(ec + 8 * q);
#pragma unroll
          for (int t = 0; t < 4; ++t) y[pt][q * 4 + t] += tmp[q * 4 + t] * e4[t];
        }
      }
    }
    __syncthreads();
#pragma unroll
    for (int i = 0; i < 8; ++i) *(bf16x8*)(Bs + (srow + 16 * i) * RS + scol) = rb[i];
#pragma unroll
    for (int i = 0; i < 4; ++i) *(bf16x8*)(Xs + (srow + 16 * i) * RS + scol) = rx[i];
    __syncthreads();
    const float cum_f = Vs[512 + i_own];
    const float cum_b = Vs[512 + 128 + i_own];
#pragma unroll 1
    for (int jt = 0; jt < 4; ++jt) {
      f32x16 cb;
#pragma unroll
      for (int r = 0; r < 16; ++r) cb[r] = 0.f;
      const bf16_t* bl_ = Bs + (jt * 32 + lr) * RS + lh * 8;
#pragma unroll
      for (int kk = 0; kk < 8; ++kk) {
        bf16x8 bfr = *(const bf16x8*)(bl_ + kk * 16);
        cb = __builtin_amdgcn_mfma_f32_32x32x16_bf16(bfr, cf[kk], cb, 0, 0, 0);
      }
      bf16x8 xb[2][2];
#pragma unroll
      for (int s = 0; s < 2; ++s)
#pragma unroll
        for (int pt = 0; pt < 2; ++pt) {
          const bf16_t* xp = Xs + (pt * 32 + lr) * RS + jt * 32 + 16 * s + 4 * lh;
          bf16x4 x0 = *(const bf16x4*)xp, x1 = *(const bf16x4*)(xp + 8);
          bf16x8 t8 = {x0[0], x0[1], x0[2], x0[3], x1[0], x1[1], x1[2], x1[3]};
          xb[s][pt] = t8;
        }
#pragma unroll
      for (int d = 0; d < 2; ++d) {
        bool need = (d == 0) ? (jt <= w) : (jt >= w);
        if (!need) continue;
        const float* vv = Vs + d * 128 + jt * 32 + 4 * lh;
        const float ci = (d == 0) ? cum_f : cum_b;
        f32x16 gq;
#pragma unroll
        for (int q = 0; q < 4; ++q) {
          f32x4 v4 = *(const f32x4*)(vv + 8 * q);
#pragma unroll
          for (int t = 0; t < 4; ++t) {
            int j = jt * 32 + 8 * q + 4 * lh + t;
            float val = cb[q * 4 + t] * __expf(ci - v4[t]);
            bool ok = (jt != w) || ((d == 0) ? (j <= i_own) : (j >= i_own));
            gq[q * 4 + t] = ok ? val : 0.f;
          }
        }
#pragma unroll
        for (int s = 0; s < 2; ++s) {
          f32x4 ga = {gq[8 * s + 0], gq[8 * s + 1], gq[8 * s + 2], gq[8 * s + 3]};
          f32x4 gb = {gq[8 * s + 4], gq[8 * s + 5], gq[8 * s + 6], gq[8 * s + 7]};
          bf16x8 afr = pack8(ga, gb);
          y[0] = __builtin_amdgcn_mfma_f32_32x32x16_bf16(afr, xb[s][0], y[0], 0, 0, 0);
          y[1] = __builtin_amdgcn_mfma_f32_32x32x16_bf16(afr, xb[s][1], y[1], 0, 0, 0);
        }
      }
    }
    const float Dh = p.ssd_d[layer * 16 + h];
    float ssq[16];
#pragma unroll
    for (int r = 0; r < 16; ++r) ssq[r] = 0.f;
    __syncthreads();
#pragma unroll
    for (int pt = 0; pt < 2; ++pt)
#pragma unroll
      for (int q = 0; q < 4; ++q) {
        bf16x4 x4 = *(const bf16x4*)(Xs + (pt * 32 + lr) * RS + 32 * w + 8 * q + 4 * lh);
#pragma unroll
        for (int t = 0; t < 4; ++t) {
          int li = 32 * w + 8 * q + 4 * lh + t;
          float yv = y[pt][q * 4 + t] + Dh * bf2f((bf16_t)x4[t]);
          float z = bf2f(Zs[li * 72 + pt * 32 + lr]);
          float gv = yv * silu_f(z);
          ssq[q * 4 + t] += gv * gv;
          Os[li * 72 + pt * 32 + lr] = f2bf(gv);
        }
      }
    __syncthreads();
    {
      bf16_t* Yg = p.Y + ((size_t)gc * 128 + (tid >> 3)) * 2048 + h * 64 + (tid & 7) * 8;
#pragma unroll
      for (int i = 0; i < 4; ++i)
        *(bf16x8*)(Yg + (size_t)i * 32 * 2048) = *(const bf16x8*)(Os + ((tid >> 3) + 32 * i) * 72 + (tid & 7) * 8);
    }
#pragma unroll
    for (int r = 0; r < 16; ++r) {
      float v = ssq[r];
      v += __shfl_xor(v, 1); v += __shfl_xor(v, 2); v += __shfl_xor(v, 4); v += __shfl_xor(v, 8); v += __shfl_xor(v, 16);
      ssq[r] = v;
    }
    if (lr == 0) {
#pragma unroll
      for (int r = 0; r < 16; ++r) {
        int row = gc * 128 + 32 * w + (r & 3) + 8 * (r >> 2) + 4 * lh;
        p.SSQ[(size_t)row * 16 + h] = ssq[r];
      }
    }
  }
}

__device__ void phase_final(const Params& p) {
  const int lane = opq_tid() & 63;
  const int gw = opq_bid() * 4 + (opq_tid() >> 6), nw = gridDim.x * 4;
  for (int row = gw; row < 4 * SEQ; row += nw) {
    float* src = p.out + (size_t)row * D;
    float4 v[4]; float ss = 0.f;
#pragma unroll
    for (int i = 0; i < 4; ++i) {
      v[i] = *(const float4*)(src + (i * 64 + lane) * 4);
      ss += v[i].x * v[i].x + v[i].y * v[i].y + v[i].z * v[i].z + v[i].w * v[i].w;
    }
    ss = wave_sum(ss);
    float rstd = rsqrtf(ss * (1.f / D) + EPS);
#pragma unroll
    for (int i = 0; i < 4; ++i) {
      int k = (i * 64 + lane) * 4;
      float4 w = *(const float4*)(p.final_norm_w + k);
      float4 o = {v[i].x * rstd * w.x, v[i].y * rstd * w.y, v[i].z * rstd * w.z, v[i].w * rstd * w.w};
      *(float4*)(src + k) = o;
    }
  }
}

#ifndef REP_W
#define REP_W 1
#endif
#ifndef REP_GOUT0
#define REP_GOUT0 1
#endif
#ifndef REP_NORM
#define REP_NORM 1
#endif
#ifndef REP_GIN
#define REP_GIN 1
#endif
#ifndef REP_PREP
#define REP_PREP 1
#endif
#ifndef REP_S1
#define REP_S1 1
#endif
#ifndef REP_ATTN
#define REP_ATTN 1
#endif
#ifndef REP_S3
#define REP_S3 1
#endif
__global__ void __launch_bounds__(256, 2) mega(Params p, int lo, int hi) {
  __shared__ __attribute__((aligned(16))) float smem[18432];
  __shared__ uint4 xb_words;
  if (threadIdx.x == 0) xb_words = make_uint4(0u, 0u, 0u, 0u);
  __syncthreads();
  XcdBarrier xb = xcd_barrier_post(p.bar, (volatile LAS unsigned*)&xb_words);
  if (lo < 0) cg::this_grid().sync();
  for (int step = lo; step < hi; ++step) {
    if (step == 0) { for (int rp = 0; rp < REP_W; ++rp) phase_weights(p, smem); }
    else if (step == NSTEP - 1) phase_final(p);
    else {
      int s = step - 1;
      int pass = s / 14, r = s % 14, layer = r / 7, ph = r % 7;
      switch (ph) {
        case ST_NORM: for (int rp = 0; rp < REP_NORM; ++rp) phase_norm(p, layer, pass); break;
        case ST_GIN: for (int rp = 0; rp < REP_GIN; ++rp) phase_gemm_in256(p, layer, pass, (bf16_t*)smem); break;
        case ST_PREP: for (int rp = 0; rp < REP_PREP; ++rp) phase_prep(p, layer, pass, smem); break;
        case ST_MIX:
          for (int rp = 0; rp < REP_S1; ++rp) phase_s1(p, layer, pass, (bf16_t*)smem);
          for (int rp = 0; rp < REP_ATTN; ++rp) phase_attn(p, layer, pass, (bf16_t*)smem);
          break;
        case ST_S2: phase_s2(p, layer, pass); break;
        case ST_S3: for (int rp = 0; rp < REP_S3; ++rp) phase_s3(p, layer, pass, (bf16_t*)smem); break;
        case ST_GOUT: for (int rp = 0; rp < (layer == 0 ? REP_GOUT0 : 1); ++rp) phase_gemm_mfma(p, 1, layer, pass, (bf16_t*)smem); break;
      }
    }
    if (step + 1 < hi) xcd_barrier(xb);
  }
}

extern "C" void kernel_launch(void* const* d_in, const int* in_sizes, int n_in, void* d_out, int out_size, void* d_ws,
                              size_t ws_size, hipStream_t stream) {
  Params p{};
  p.x = (const float*)d_in[0]; p.c = (const float*)d_in[1]; p.ctx = (const float*)d_in[2]; p.c_ctx = (const float*)d_in[3];
  p.norm_w = (const float*)d_in[4]; p.w_mod = (const float*)d_in[5]; p.b_mod = (const float*)d_in[6];
  p.w_in = (const float*)d_in[7]; p.ssd_conv_w = (const float*)d_in[8]; p.ssd_conv_b = (const float*)d_in[9];
  p.ssd_dt_bias = (const float*)d_in[10]; p.ssd_a_log = (const float*)d_in[11]; p.ssd_d = (const float*)d_in[12];
  p.ssd_norm_w = (const float*)d_in[13]; p.sc_conv_w = (const float*)d_in[14]; p.attn_sink = (const float*)d_in[15];
  p.w_out = (const float*)d_in[16]; p.final_norm_w = (const float*)d_in[17];
  p.out = (float*)d_out;
  char* w = (char*)d_ws; size_t off = 0;
  auto take = [&](size_t bytes) { char* r = w + off; off += (bytes + 255) & ~(size_t)255; return r; };
  p.WinT = (bf16_t*)take((size_t)2 * NWIN * 1024 * 2);
  p.WoutT = (bf16_t*)take((size_t)2 * 1024 * 2048 * 2);
  p.MOD = (float*)take((size_t)2 * 5 * 3072 * 4);
  p.CTX1 = (float*)take((size_t)4 * CTXL * D * 4);
  p.ROPE = (float*)take((size_t)64 * 16 * 2 * 4);
  char* big = take((size_t)NT * (1024 + 1536 + 2048) * 2);
  p.H = (bf16_t*)big;
  p.PXBC = (bf16_t*)(big + (size_t)NT * 1024 * 2);
  p.PSC = (bf16_t*)(big + (size_t)NT * (1024 + 1536) * 2);
  p.LST = (float*)big;
  p.PART = (float*)(big + (size_t)24 * 1024 * 1024);
  p.PZ = (bf16_t*)take((size_t)NT * 1024 * 2);
  p.PATT = (bf16_t*)take((size_t)NT * 1280 * 2);
  p.QR = (bf16_t*)take((size_t)NT * 512 * 2);
  p.KR = (bf16_t*)take((size_t)NT * 128 * 2);
  p.VT = (bf16_t*)take((size_t)NT * 128 * 2);
  p.SIN = p.PATT;
  p.DTRAW = (float*)take((size_t)NT * 32 * 4);
  p.CUMT = (float*)take((size_t)NT * 32 * 4);
  p.VV = (float*)take((size_t)NT * 32 * 4);
  p.EC = (float*)take((size_t)NT * 32 * 4);
  p.WW = (float*)take((size_t)NT * 32 * 4);
  p.SSQ = (float*)take((size_t)NT * 16 * 4);
  p.XT = (bf16_t*)take((size_t)NT * 1024 * 2);
  p.BR = (bf16_t*)take((size_t)NT * 256 * 2);
  p.CR = (bf16_t*)take((size_t)NT * 256 * 2);
  p.BT = (bf16_t*)take((size_t)NT * 256 * 2);
  p.Y = (bf16_t*)take((size_t)NT * 2048 * 2);
  p.bar = (unsigned*)take((size_t)XCD_BAR_WORDS * 4);
  if (off > ws_size) { fprintf(stderr, "workspace too small: need %zu have %zu\n", off, ws_size); return; }
  static int grid_blocks = 0;
  if (!grid_blocks) {
    int dev = 0, cus = 0, per_cu = 0;
    hipGetDevice(&dev);
    hipDeviceGetAttribute(&cus, hipDeviceAttributeMultiprocessorCount, dev);
    hipOccupancyMaxActiveBlocksPerMultiprocessor(&per_cu, mega, 256, 0);
    if (per_cu > 2) per_cu = 2;
    if (per_cu < 1) per_cu = 1;
    grid_blocks = cus * per_cu;
  }
  hipMemsetAsync(p.bar, 0, (size_t)XCD_BAR_WORDS * 4, stream);
  int lo = 0, hi = NSTEP;
  void* args[] = {&p, &lo, &hi};
  hipError_t e = hipLaunchCooperativeKernel((void*)mega, dim3(grid_blocks), dim3(256), args, 0, stream);
  if (e != hipSuccess) fprintf(stderr, "cooperative launch failed: %s (grid %d)\n", hipGetErrorString(e), grid_blocks);
}
```

```cpp
#include <hip/hip_runtime.h>
#include <hip/hip_cooperative_groups.h>
#include <cstdio>
#include <type_traits>
namespace cg = cooperative_groups;

typedef unsigned short bf16_t;
typedef __attribute__((ext_vector_type(8))) short bf16x8;
typedef __attribute__((ext_vector_type(4))) short bf16x4;
typedef __attribute__((ext_vector_type(4))) float f32x4;
typedef __attribute__((ext_vector_type(16))) float f32x16;

constexpr int D = 1024, SEQ = 4096, CTXL = 256;
constexpr int NB = 2;
constexpr int NPASS = 2;
constexpr int NTL = NB * SEQ;
constexpr int NTC = NB * CTXL;
constexpr int NT = NTL + NTC;
constexpr int NCH = NT / 128;
constexpr int NWIN = 6016;
constexpr float EPS = 1e-6f;

constexpr int ST_NORM = 0, ST_GIN = 1, ST_PREP = 2, ST_MIX = 3, ST_S2 = 4, ST_S3 = 5, ST_GOUT = 6;
constexpr int NSTEP = 1 + NPASS * 2 * 7 + 1;

struct Params {
  const float *x, *c, *ctx, *c_ctx, *norm_w, *w_mod, *b_mod, *w_in, *ssd_conv_w, *ssd_conv_b, *ssd_dt_bias,
      *ssd_a_log, *ssd_d, *ssd_norm_w, *sc_conv_w, *attn_sink, *w_out, *final_norm_w;
  float* out;
  bf16_t *WinT, *WoutT, *H, *PXBC, *PSC, *PZ, *PATT, *XT, *BR, *CR, *BT, *QR, *KR, *VT, *Y, *SIN;
  float *MOD, *CTX1, *DTRAW, *CUMT, *VV, *EC, *WW, *SSQ, *LST, *ROPE, *PART;
  unsigned* bar;
};

__device__ __forceinline__ int opq_tid() { int t = threadIdx.x; asm volatile("" : "+v"(t)); return t; }
__device__ __forceinline__ int opq_bid() { int b = blockIdx.x; asm volatile("" : "+s"(b)); return b; }
typedef __attribute__((ext_vector_type(2))) __bf16 bfv2;
typedef __attribute__((ext_vector_type(2))) float f32x2;
typedef __attribute__((ext_vector_type(4))) unsigned u32x4;
__device__ __forceinline__ unsigned pk2(float a, float b) {
  f32x2 v = {a, b};
  bfv2 r = __builtin_convertvector(v, bfv2);
  return *(unsigned*)&r;
}
__device__ __forceinline__ bf16_t f2bf(float f) { return (bf16_t)(pk2(f, 0.f) & 0xffffu); }
__device__ __forceinline__ bf16x8 pack8(f32x4 a, f32x4 b) {
  u32x4 u = {pk2(a[0], a[1]), pk2(a[2], a[3]), pk2(b[0], b[1]), pk2(b[2], b[3])};
  return *(bf16x8*)&u;
}
__device__ __forceinline__ float bf2f(bf16_t h) { return __uint_as_float(((unsigned)h) << 16); }
__device__ __forceinline__ float silu_f(float v) { return v * __builtin_amdgcn_rcpf(1.f + __expf(-v)); }
__device__ __forceinline__ float wave_sum(float v) {
#pragma unroll
  for (int o = 32; o > 0; o >>= 1) v += __shfl_xor(v, o);
  return v;
}

#define XB_TMO      128
#define XB_XCNT(j)  (256  + 64 * (j))
#define XB_XSUB(j)  (1280 + 64 * (j))
#define XB_XGEN(j)  (2304 + 64 * (j))
#define XB_TOP      3328
#define XB_TOPGEN   3392
#define XCD_BAR_WORDS 3456
#define XB_SPIN_CAP (1u << 18)
#define LAS __attribute__((address_space(3)))

__device__ __forceinline__ unsigned xb_ld(unsigned* p)              { return __hip_atomic_load(p, __ATOMIC_RELAXED, __HIP_MEMORY_SCOPE_AGENT); }
__device__ __forceinline__ unsigned xb_add(unsigned* p, unsigned v) { return __hip_atomic_fetch_add(p, v, __ATOMIC_RELAXED, __HIP_MEMORY_SCOPE_AGENT); }
__device__ __forceinline__ unsigned xb_xcc_id() { return (unsigned)__builtin_amdgcn_s_getreg((3 << 11) | 20) & 0xFu; }
#define XB_SPIN(cond, bar) do { unsigned _sp = 0; while (cond) { __builtin_amdgcn_s_sleep(1); \
    if ((++_sp & 255u) == 0u) { if (xb_ld(&(bar)[XB_TMO])) break; if (_sp > XB_SPIN_CAP) { atomicAdd(&(bar)[XB_TMO], 1u); break; } } } } while (0)

struct XcdBarrier {
    unsigned* bar; unsigned x;
    volatile LAS unsigned* st;
};

__device__ __forceinline__ XcdBarrier xcd_barrier_post(unsigned* bar, volatile LAS unsigned* st) {
    XcdBarrier b; b.bar = bar; b.x = xb_xcc_id(); b.st = st;
    if (threadIdx.x == 0) (void)xb_add(&bar[XB_XCNT(b.x)], 1u);
    return b;
}
__device__ __forceinline__ void xcd_barrier_complete(unsigned* bar, unsigned x, unsigned& nloc, unsigned& nx) {
    const unsigned G = gridDim.x * gridDim.y * gridDim.z;
    unsigned sum, cnt, mine, sp = 0u;
    for (;;) {
        sum = 0u; cnt = 0u; mine = 0u;
#pragma unroll
        for (unsigned j = 0; j < 16; ++j) { const unsigned c = xb_ld(&bar[XB_XCNT(j)]); sum += c; cnt += (c > 0u) ? 1u : 0u; mine = (j == x) ? c : mine; }
        if (sum == G) break;
        __builtin_amdgcn_s_sleep(1);
        if ((++sp & 255u) == 0u) { if (xb_ld(&bar[XB_TMO])) break; if (sp > XB_SPIN_CAP) { atomicAdd(&bar[XB_TMO], 1u); break; } }
    }
    nloc = mine > 0u ? mine : 1u; nx = cnt > 0u ? cnt : 1u;
}

__device__ __forceinline__ void xcd_barrier(const XcdBarrier& b) {
    asm volatile("s_waitcnt vmcnt(0)" ::: "memory");
    __syncthreads();
    if (threadIdx.x == 0) {
        unsigned* bar = b.bar;
        __builtin_amdgcn_s_waitcnt(0);
        unsigned nloc = b.st[0], nx = b.st[1];
        if (nloc == 0u) { xcd_barrier_complete(bar, b.x, nloc, nx); b.st[0] = nloc; b.st[1] = nx; }
        const unsigned old = xb_add(&bar[XB_XSUB(b.x)], 1u);
        const unsigned gen = old / nloc;
        if (old + 1u == (gen + 1u) * nloc) {
            __builtin_amdgcn_fence(__ATOMIC_RELEASE, "agent");
            asm volatile("s_waitcnt vmcnt(0)" ::: "memory");
            const unsigned og = xb_add(&bar[XB_TOP], 1u);
            const unsigned tg = og / nx;
            if (og + 1u == (tg + 1u) * nx) xb_add(&bar[XB_TOPGEN], 1u);
            else XB_SPIN(xb_ld(&bar[XB_TOPGEN]) == tg, bar);
            __builtin_amdgcn_fence(__ATOMIC_ACQUIRE, "agent");
            xb_add(&bar[XB_XGEN(b.x)], 1u);
            asm volatile("s_waitcnt vmcnt(0)" ::: "memory");
        } else {
            XB_SPIN(xb_ld(&bar[XB_XGEN(b.x)]) == gen, bar);
            __builtin_amdgcn_fence(__ATOMIC_ACQUIRE, "agent");
            asm volatile("s_waitcnt vmcnt(0)" ::: "memory");
        }
    }
    __syncthreads();
}


__device__ void phase_weights(const Params& p, float* smem) {
  const int tid = opq_tid();
  const int NW1 = 2 * 94 * 16, NW2 = 2 * 16 * 32, NM = 192;
  auto load_tile = [&](int it, float* sm) __attribute__((always_inline)) {
    float v[16];
    if (it < NW1) {
      int l = it / (94 * 16), r = it % (94 * 16), nt = r / 16, kt = r % 16;
#pragma unroll
      for (int j = 0; j < 16; ++j) {
        int e = tid + 256 * j, kk = e >> 6, nn = e & 63;
        int n = nt * 64 + nn;
        int oc = (n < 2560) ? n : (n < 5888 ? n + 32 : (n < 5920 ? n - 5888 + 2560 : -1));
        v[j] = (oc >= 0) ? p.w_in[((size_t)l * 1024 + kt * 64 + kk) * 5920 + oc] : 0.f;
      }
    } else {
      int i2 = it - NW1;
      int l = i2 / 512, r = i2 % 512, nt = r / 32, kt = r % 32;
#pragma unroll
      for (int j = 0; j < 16; ++j) {
        int e = tid + 256 * j, kk = e >> 6, nn = e & 63;
        int k = kt * 64 + kk;
        float w = p.w_out[((size_t)l * 2048 + k) * 1024 + nt * 64 + nn];
        v[j] = (k < 1024) ? w * p.ssd_norm_w[l * 1024 + k] : w;
      }
    }
#pragma unroll
    for (int j = 0; j < 16; ++j) { int e = tid + 256 * j; sm[(e >> 6) * 65 + (e & 63)] = v[j]; }
  };
  auto store_tile = [&](int it, const float* sm) __attribute__((always_inline)) {
    if (it < NW1) {
      int l = it / (94 * 16), r = it % (94 * 16), nt = r / 16, kt = r % 16;
#pragma unroll
      for (int j = 0; j < 16; ++j) {
        int e = tid + 256 * j, nn = e >> 6, kk = e & 63;
        p.WinT[((size_t)l * NWIN + nt * 64 + nn) * 1024 + kt * 64 + kk] = f2bf(sm[kk * 65 + nn]);
      }
    } else {
      int i2 = it - NW1;
      int l = i2 / 512, r = i2 % 512, nt = r / 32, kt = r % 32;
#pragma unroll
      for (int j = 0; j < 16; ++j) {
        int e = tid + 256 * j, nn = e >> 6, kk = e & 63;
        p.WoutT[((size_t)l * 1024 + nt * 64 + nn) * 2048 + kt * 64 + kk] = f2bf(sm[kk * 65 + nn]);
      }
    }
  };
  for (int it = opq_bid(); it < NW1 + NW2; it += 4 * gridDim.x) {
#pragma unroll
    for (int q = 0; q < 4; ++q) { int itq = it + q * (int)gridDim.x; if (itq < NW1 + NW2) load_tile(itq, smem + q * 4224); }
    __syncthreads();
#pragma unroll
    for (int q = 0; q < 4; ++q) { int itq = it + q * (int)gridDim.x; if (itq < NW1 + NW2) store_tile(itq, smem + q * 4224); }
    __syncthreads();
  }
  for (int it = opq_bid(); it < NW1 + NW2 + NM; it += gridDim.x) {
    if (it < NW1 + NW2) continue;
    {
      int i3 = it - NW1 - NW2;
      int l = i3 / 96, jb = i3 % 96;
      float* sc = smem;
      float* part = smem + 5120;
      for (int e = tid; e < 5120; e += 256) {
        int r = e >> 10, k = e & 1023;
        float v = (r < 4) ? p.c[r * 1024 + k] : p.c_ctx[k];
        sc[e] = silu_f(v);
      }
      __syncthreads();
      int col = tid & 31, kg = tid >> 5;
      float a0 = 0, a1 = 0, a2 = 0, a3 = 0, a4 = 0;
      const float* wp = p.w_mod + ((size_t)l * 1024 + kg * 128) * 3072 + jb * 32 + col;
      for (int k0 = 0; k0 < 128; k0 += 16) {
        float wv[16];
#pragma unroll
        for (int j = 0; j < 16; ++j) wv[j] = wp[(size_t)(k0 + j) * 3072];
#pragma unroll
        for (int j = 0; j < 16; ++j) {
          int k = kg * 128 + k0 + j;
          a0 += sc[k] * wv[j]; a1 += sc[1024 + k] * wv[j]; a2 += sc[2048 + k] * wv[j]; a3 += sc[3072 + k] * wv[j]; a4 += sc[4096 + k] * wv[j];
        }
      }
      part[(kg * 5 + 0) * 32 + col] = a0; part[(kg * 5 + 1) * 32 + col] = a1; part[(kg * 5 + 2) * 32 + col] = a2;
      part[(kg * 5 + 3) * 32 + col] = a3; part[(kg * 5 + 4) * 32 + col] = a4;
      __syncthreads();
      if (tid < 160) {
        int r = tid >> 5, cc = tid & 31;
        float s = 0.f;
#pragma unroll
        for (int g8 = 0; g8 < 8; ++g8) s += part[(g8 * 5 + r) * 32 + cc];
        p.MOD[((size_t)l * 5 + r) * 3072 + jb * 32 + cc] = s + p.b_mod[l * 3072 + jb * 32 + cc];
      }
      if (i3 == 0) {
        for (int e = tid; e < 1024; e += 256) {
          int pos = e >> 4, i = e & 15;
          float inv = powf(10000.f, -(float)i * (1.f / 16.f));
          float ang = (float)pos * inv;
          p.ROPE[2 * e] = cosf(ang); p.ROPE[2 * e + 1] = sinf(ang);
        }
      }
      __syncthreads();
    }
  }
}

__device__ void phase_norm(const Params& p, int layer, int pass) {
  const int lane = opq_tid() & 63;
  const int gw = opq_bid() * 4 + (opq_tid() >> 6), nw = gridDim.x * 4;
  const int b0 = pass * NB;
  for (int row = gw; row < NT; row += nw) {
    const float* src; int mrow;
    if (row < NTL) { src = (layer == 0 ? p.x : p.out) + ((size_t)b0 * SEQ + row) * D; mrow = b0 + row / SEQ; }
    else { src = (layer == 0 ? p.ctx : p.CTX1) + ((size_t)b0 * CTXL + (row - NTL)) * D; mrow = 4; }
    const float* mod = p.MOD + ((size_t)layer * 5 + mrow) * 3072;
    float4 v[4]; float ss = 0.f;
    const bool from_parts = (layer == 1 && row >= NTL);
    if (from_parts) src = p.ctx + ((size_t)b0 * CTXL + (row - NTL)) * D;
#pragma unroll
    for (int i = 0; i < 4; ++i) {
      v[i] = *(const float4*)(src + (i * 64 + lane) * 4);
      if (from_parts) {
        int k = (i * 64 + lane) * 4;
        float4 a = {0.f, 0.f, 0.f, 0.f};
#pragma unroll
        for (int ks = 0; ks < 8; ++ks) {
          float4 q = *(const float4*)(p.PART + ((size_t)ks * NTC + (row - NTL)) * D + k);
          a.x += q.x; a.y += q.y; a.z += q.z; a.w += q.w;
        }
        float4 gt = *(const float4*)(p.MOD + ((size_t)0 * 5 + 4) * 3072 + 2048 + k);
        v[i].x += gt.x * a.x; v[i].y += gt.y * a.y; v[i].z += gt.z * a.z; v[i].w += gt.w * a.w;
      }
      ss += v[i].x * v[i].x + v[i].y * v[i].y + v[i].z * v[i].z + v[i].w * v[i].w;
    }
    ss = wave_sum(ss);
    float rstd = rsqrtf(ss * (1.f / D) + EPS);
#pragma unroll
    for (int i = 0; i < 4; ++i) {
      int k = (i * 64 + lane) * 4;
      float4 nwv = *(const float4*)(p.norm_w + layer * D + k);
      float4 sh = *(const float4*)(mod + k);
      float4 scl = *(const float4*)(mod + 1024 + k);
      bf16x4 o;
      o[0] = (short)f2bf(v[i].x * rstd * nwv.x * (1.f + scl.x) + sh.x);
      o[1] = (short)f2bf(v[i].y * rstd * nwv.y * (1.f + scl.y) + sh.y);
      o[2] = (short)f2bf(v[i].z * rstd * nwv.z * (1.f + scl.z) + sh.z);
      o[3] = (short)f2bf(v[i].w * rstd * nwv.w * (1.f + scl.w) + sh.w);
      *(bf16x4*)(p.H + (size_t)row * D + k) = o;
    }
  }
}

__device__ __forceinline__ void epi_store(const Params& p, int mode, int layer, int pass, int m, int n, float v) {
  if (mode == 0) {
    if (n < 1024) p.PZ[(size_t)m * 1024 + n] = f2bf(v);
    else if (n < 2560) p.PXBC[(size_t)m * 1536 + (n - 1024)] = f2bf(v);
    else if (n < 4608) p.PSC[(size_t)m * 2048 + (n - 2560)] = f2bf(v);
    else if (n < 5888) p.PATT[(size_t)m * 1280 + (n - 4608)] = f2bf(v);
    else if (n < 5920) p.DTRAW[(size_t)m * 32 + (n - 5888)] = v;
  } else {
    const int b0 = pass * NB;
    if (m < NTL) {
      int b = b0 + m / SEQ;
      float g = p.MOD[((size_t)layer * 5 + b) * 3072 + 2048 + n];
      size_t idx = ((size_t)b0 * SEQ + m) * D + n;
      float xo = (layer == 0) ? p.x[idx] : p.out[idx];
      p.out[idx] = xo + g * v;
    } else {
      float g = p.MOD[((size_t)layer * 5 + 4) * 3072 + 2048 + n];
      size_t idx = ((size_t)b0 * CTXL + (m - NTL)) * D + n;
      p.CTX1[idx] = p.ctx[idx] + g * v;
    }
  }
}

__device__ void phase_gemm_naive(const Params& p, int mode, int layer, int pass, float* smem) {
  const int M = (mode == 0) ? NT : (layer == 0 ? NT : NTL);
  const int N = (mode == 0) ? NWIN : 1024;
  const int K = (mode == 0) ? 1024 : 2048;
  const bf16_t* A = (mode == 0) ? p.H : p.Y;
  const bf16_t* Bt = (mode == 0) ? p.WinT + (size_t)layer * NWIN * 1024 : p.WoutT + (size_t)layer * 1024 * 2048;
  const int tm = M / 64, tn = N / 64;
  const int tid = opq_tid(), tx = tid & 15, ty = tid >> 4;
  float* As = smem;
  float* Bs = smem + 16 * 68;
  for (int t = opq_bid(); t < tm * tn; t += gridDim.x) {
    int m0 = (t / tn) * 64, n0 = (t % tn) * 64;
    float acc[4][4];
#pragma unroll
    for (int i = 0; i < 4; ++i)
#pragma unroll
      for (int j = 0; j < 4; ++j) acc[i][j] = 0.f;
    int lr = tid >> 2, kq = (tid & 3) * 4;
    for (int k0 = 0; k0 < K; k0 += 16) {
      bf16x4 av = *(const bf16x4*)(A + (size_t)(m0 + lr) * K + k0 + kq);
      bf16x4 bv = *(const bf16x4*)(Bt + (size_t)(n0 + lr) * K + k0 + kq);
#pragma unroll
      for (int j = 0; j < 4; ++j) {
        As[(kq + j) * 68 + lr] = bf2f((bf16_t)av[j]);
        Bs[(kq + j) * 68 + lr] = bf2f((bf16_t)bv[j]);
      }
      __syncthreads();
#pragma unroll
      for (int kk = 0; kk < 16; ++kk) {
        float4 a4 = *(const float4*)(As + kk * 68 + ty * 4);
        float4 b4 = *(const float4*)(Bs + kk * 68 + tx * 4);
        float a[4] = {a4.x, a4.y, a4.z, a4.w}, b[4] = {b4.x, b4.y, b4.z, b4.w};
#pragma unroll
        for (int i = 0; i < 4; ++i)
#pragma unroll
          for (int j = 0; j < 4; ++j) acc[i][j] += a[i] * b[j];
      }
      __syncthreads();
    }
#pragma unroll
    for (int i = 0; i < 4; ++i)
#pragma unroll
      for (int j = 0; j < 4; ++j) epi_store(p, mode, layer, pass, m0 + ty * 4 + i, n0 + tx * 4 + j, acc[i][j]);
  }
}

__device__ void phase_gemm_mfma(const Params& p, int mode, int layer, int pass, bf16_t* smem) {
  const bool do_split = (mode == 1 && layer == 0);
  const bool ctx_sparse = (mode == 0 && layer == 1);
  const int M = (mode == 0 && !ctx_sparse) ? NT : NTL;
  const int N = (mode == 0) ? NWIN : 1024;
  const int K = (mode == 0) ? 1024 : 2048;
  const bf16_t* A = (mode == 0) ? p.H : p.Y;
  const bf16_t* Bt = (mode == 0) ? p.WinT + (size_t)layer * NWIN * 1024 : p.WoutT + (size_t)layer * 1024 * 2048;
  const int tm = M / 128, tn = N / 128, T_main = tm * tn, T = T_main + (ctx_sparse ? 60 : 0);
  const int tid = opq_tid(), lane = tid & 63, wid = tid >> 6, wm = wid >> 1, wn = wid & 1;
  const int lr = lane & 31, lh = lane >> 5;
  bf16_t* As = smem;
  bf16_t* Bs = smem + 128 * 72;
  float* rsS = (float*)(smem + 2 * 128 * 72);
  const int bid = opq_bid();
  int tstart = 0, tend = T, lb = bid, nbx = gridDim.x;
  if ((gridDim.x & 7) == 0) {
    int xcd = bid & 7; lb = bid >> 3; nbx = gridDim.x >> 3;
    tstart = (int)((long)T * xcd / 8); tend = (int)((long)T * (xcd + 1) / 8);
  }
  const int ng_full = tn / 8, rem = tn % 8, per_group = tm * 8;
  const int nk = K / 64;
  const int sr = tid >> 3, sc = (tid & 7) * 8;
  const int b0 = pass * NB;
  auto tile = [&](const int mi, const int ni, auto split_tag, const int ks) __attribute__((always_inline)) {
    constexpr bool SPLIT = decltype(split_tag)::value;
    const int kt0 = SPLIT ? ks * 4 : 0;
    const int kt1 = SPLIT ? kt0 + 4 : nk;
    const int m0 = mi * 128, n0 = ni * 128;
    f32x16 acc[2][2];
#pragma unroll
    for (int i = 0; i < 2; ++i)
#pragma unroll
      for (int j = 0; j < 2; ++j)
#pragma unroll
        for (int r = 0; r < 16; ++r) acc[i][j][r] = 0.f;
    const bf16_t* ga = A + (size_t)(m0 + sr) * K + sc + kt0 * 64;
    const bf16_t* gb = Bt + (size_t)(n0 + sr) * K + sc + kt0 * 64;
    bf16x8 ra[4], rb[4];
#pragma unroll
    for (int i = 0; i < 4; ++i) { ra[i] = *(const bf16x8*)(ga + (size_t)i * 32 * K); rb[i] = *(const bf16x8*)(gb + (size_t)i * 32 * K); }
    if (mode == 1) {
      int row = m0 + (tid >> 1), grp = tid & 1;
      const float* sp = p.SSQ + (size_t)row * 16 + grp * 8;
      f32x4 s0 = *(const f32x4*)sp, s1 = *(const f32x4*)(sp + 4);
      float ss = s0[0] + s0[1] + s0[2] + s0[3] + s1[0] + s1[1] + s1[2] + s1[3];
      rsS[tid] = rsqrtf(ss * (1.f / 512.f) + EPS);
    }
    if (mode == 1 && !SPLIT) {
      bf16x8 ra2[4], rb2[4];
#pragma unroll
      for (int i = 0; i < 4; ++i) {
        ra2[i] = *(const bf16x8*)(ga + (size_t)i * 32 * K + 64);
        rb2[i] = *(const bf16x8*)(gb + (size_t)i * 32 * K + 64);
      }
      auto mma4 = [&]() __attribute__((always_inline)) {
#pragma unroll
        for (int kk = 0; kk < 4; ++kk) {
          bf16x8 a0 = *(const bf16x8*)(As + (wm * 64 + lr) * 72 + kk * 16 + lh * 8);
          bf16x8 a1 = *(const bf16x8*)(As + (wm * 64 + 32 + lr) * 72 + kk * 16 + lh * 8);
          bf16x8 b0v = *(const bf16x8*)(Bs + (wn * 64 + lr) * 72 + kk * 16 + lh * 8);
          bf16x8 b1v = *(const bf16x8*)(Bs + (wn * 64 + 32 + lr) * 72 + kk * 16 + lh * 8);
          acc[0][0] = __builtin_amdgcn_mfma_f32_32x32x16_bf16(a0, b0v, acc[0][0], 0, 0, 0);
          acc[0][1] = __builtin_amdgcn_mfma_f32_32x32x16_bf16(a0, b1v, acc[0][1], 0, 0, 0);
          acc[1][0] = __builtin_amdgcn_mfma_f32_32x32x16_bf16(a1, b0v, acc[1][0], 0, 0, 0);
          acc[1][1] = __builtin_amdgcn_mfma_f32_32x32x16_bf16(a1, b1v, acc[1][1], 0, 0, 0);
        }
      };
      for (int kt = 0; kt < 32; kt += 2) {
        __syncthreads();
#pragma unroll
        for (int i = 0; i < 4; ++i) {
          *(bf16x8*)(As + (sr + i * 32) * 72 + sc) = ra[i];
          *(bf16x8*)(Bs + (sr + i * 32) * 72 + sc) = rb[i];
        }
        __syncthreads();
        if (kt + 2 < 32) {
#pragma unroll
          for (int i = 0; i < 4; ++i) {
            ra[i] = *(const bf16x8*)(ga + (size_t)i * 32 * K + (kt + 2) * 64);
            rb[i] = *(const bf16x8*)(gb + (size_t)i * 32 * K + (kt + 2) * 64);
          }
        }
        mma4();
        __syncthreads();
#pragma unroll
        for (int i = 0; i < 4; ++i) {
          *(bf16x8*)(As + (sr + i * 32) * 72 + sc) = ra2[i];
          *(bf16x8*)(Bs + (sr + i * 32) * 72 + sc) = rb2[i];
        }
        __syncthreads();
        if (kt + 3 < 32) {
#pragma unroll
          for (int i = 0; i < 4; ++i) {
            ra2[i] = *(const bf16x8*)(ga + (size_t)i * 32 * K + (kt + 3) * 64);
            rb2[i] = *(const bf16x8*)(gb + (size_t)i * 32 * K + (kt + 3) * 64);
          }
        }
        mma4();
        if (kt == 6 || kt == 14) {
#pragma unroll
          for (int i = 0; i < 2; ++i)
#pragma unroll
            for (int r = 0; r < 16; ++r) {
              int lrow = wm * 64 + i * 32 + (r & 3) + 8 * (r >> 2) + 4 * lh;
              float r0 = rsS[lrow * 2], r1 = rsS[lrow * 2 + 1];
              float f = (kt == 6) ? r0 * __builtin_amdgcn_rcpf(r1) : r1;
              acc[i][0][r] *= f; acc[i][1][r] *= f;
            }
        }
      }
    } else
    for (int kt = kt0; kt < kt1; ++kt) {
      __syncthreads();
#pragma unroll
      for (int i = 0; i < 4; ++i) {
        *(bf16x8*)(As + (sr + i * 32) * 72 + sc) = ra[i];
        *(bf16x8*)(Bs + (sr + i * 32) * 72 + sc) = rb[i];
      }
      __syncthreads();
      if (kt + 1 < kt1) {
#pragma unroll
        for (int i = 0; i < 4; ++i) {
          ra[i] = *(const bf16x8*)(ga + (size_t)i * 32 * K + (kt + 1 - kt0) * 64);
          rb[i] = *(const bf16x8*)(gb + (size_t)i * 32 * K + (kt + 1 - kt0) * 64);
        }
      }
#pragma unroll
      for (int kk = 0; kk < 4; ++kk) {
        bf16x8 a0 = *(const bf16x8*)(As + (wm * 64 + lr) * 72 + kk * 16 + lh * 8);
        bf16x8 a1 = *(const bf16x8*)(As + (wm * 64 + 32 + lr) * 72 + kk * 16 + lh * 8);
        bf16x8 b0v = *(const bf16x8*)(Bs + (wn * 64 + lr) * 72 + kk * 16 + lh * 8);
        bf16x8 b1v = *(const bf16x8*)(Bs + (wn * 64 + 32 + lr) * 72 + kk * 16 + lh * 8);
        acc[0][0] = __builtin_amdgcn_mfma_f32_32x32x16_bf16(a0, b0v, acc[0][0], 0, 0, 0);
        acc[0][1] = __builtin_amdgcn_mfma_f32_32x32x16_bf16(a0, b1v, acc[0][1], 0, 0, 0);
        acc[1][0] = __builtin_amdgcn_mfma_f32_32x32x16_bf16(a1, b0v, acc[1][0], 0, 0, 0);
        acc[1][1] = __builtin_amdgcn_mfma_f32_32x32x16_bf16(a1, b1v, acc[1][1], 0, 0, 0);
      }
      if (mode == 1 && !SPLIT && (kt == 7 || kt == 15)) {
#pragma unroll
        for (int i = 0; i < 2; ++i)
#pragma unroll
          for (int r = 0; r < 16; ++r) {
            int lrow = wm * 64 + i * 32 + (r & 3) + 8 * (r >> 2) + 4 * lh;
            float r0 = rsS[lrow * 2], r1 = rsS[lrow * 2 + 1];
            float f = (kt == 7) ? r0 * __builtin_amdgcn_rcpf(r1) : r1;
            acc[i][0][r] *= f; acc[i][1][r] *= f;
          }
      }
    }
    if (mode == 0) {
      if (ni < 46) {
        bf16_t* dst; int ld, cb;
        if (ni < 8) { dst = p.PZ; ld = 1024; cb = ni * 128; }
        else if (ni < 20) { dst = p.PXBC; ld = 1536; cb = (ni - 8) * 128; }
        else if (ni < 36) { dst = p.PSC; ld = 2048; cb = (ni - 20) * 128; }
        else { dst = p.PATT; ld = 1280; cb = (ni - 36) * 128; }
#pragma unroll
        for (int i = 0; i < 2; ++i)
#pragma unroll
          for (int j = 0; j < 2; ++j)
#pragma unroll
            for (int r = 0; r < 16; ++r) {
              int row = m0 + wm * 64 + i * 32 + (r & 3) + 8 * (r >> 2) + 4 * lh;
              int col = cb + wn * 64 + j * 32 + lr;
              dst[(size_t)row * ld + col] = f2bf(acc[i][j][r]);
            }
      } else if (wn == 0) {
#pragma unroll
        for (int i = 0; i < 2; ++i)
#pragma unroll
          for (int r = 0; r < 16; ++r) {
            int row = m0 + wm * 64 + i * 32 + (r & 3) + 8 * (r >> 2) + 4 * lh;
            p.DTRAW[(size_t)row * 32 + lr] = acc[i][0][r];
          }
      }
    } else if (!SPLIT) {
      float* Os = (float*)smem;
      const int ocol4 = (tid & 31) * 4, orow = tid >> 5;
      const int b = b0 + m0 / SEQ;
      const float4 g4 = *(const float4*)(p.MOD + ((size_t)layer * 5 + b) * 3072 + 2048 + n0 + ocol4);
      __syncthreads();
#pragma unroll
      for (int half = 0; half < 2; ++half) {
        if (wm == half) {
#pragma unroll
          for (int i = 0; i < 2; ++i)
#pragma unroll
            for (int j = 0; j < 2; ++j)
#pragma unroll
              for (int r = 0; r < 16; ++r)
                Os[(i * 32 + (r & 3) + 8 * (r >> 2) + 4 * lh) * 132 + wn * 64 + j * 32 + lr] = acc[i][j][r];
        }
        __syncthreads();
#pragma unroll 4
        for (int k = 0; k < 8; ++k) {
          int row = orow + 8 * k;
          float4 v = *(const float4*)(Os + row * 132 + ocol4);
          size_t idx = ((size_t)b0 * SEQ + m0 + half * 64 + row) * D + n0 + ocol4;
          float4 x4 = (layer == 0) ? *(const float4*)(p.x + idx) : *(const float4*)(p.out + idx);
          float4 o = {x4.x + g4.x * v.x, x4.y + g4.y * v.y, x4.z + g4.z * v.z, x4.w + g4.w * v.w};
          *(float4*)(p.out + idx) = o;
        }
        __syncthreads();
      }
    } else {
#pragma unroll
      for (int i = 0; i < 2; ++i)
#pragma unroll
        for (int j = 0; j < 2; ++j)
#pragma unroll
          for (int r = 0; r < 16; ++r) {
            int row = m0 + wm * 64 + i * 32 + (r & 3) + 8 * (r >> 2) + 4 * lh;
            int col = n0 + wn * 64 + j * 32 + lr;
            int lrow = row - m0;
            float f = (ks < 4) ? rsS[lrow * 2 + (ks >> 1)] : 1.f;
            p.PART[((size_t)ks * NTC + (row - NTL)) * D + col] = acc[i][j][r] * f;
          }
    }
  };
  for (int t = tstart + lb; t < tend; t += nbx) {
    int mi, ni;
    if (t >= T_main) { int e = t - T_main, j = e % 15; mi = 64 + e / 15; ni = (j < 12) ? 8 + j : ((j < 14) ? 28 + j : 46); }
    else if (t < ng_full * per_group) { int ng = t / per_group, r = t % per_group; mi = r >> 3; ni = ng * 8 + (r & 7); }
    else { int r = t - ng_full * per_group; mi = r / rem; ni = ng_full * 8 + r % rem; }
    tile(mi, ni, std::integral_constant<bool, false>{}, -1);
  }
  if (do_split) {
    for (int s = bid; s < 256; s += gridDim.x) {
      int ct = s >> 3, ks = s & 7;
      tile(64 + (ct >> 3), ct & 7, std::integral_constant<bool, true>{}, ks);
    }
  }
}

__device__ void phase_gemm_in256(const Params& p, int layer, int pass, bf16_t* smem) {
  constexpr int K = 1024, nk = 16;
  const bf16_t* A = p.H;
  const bf16_t* Bt = p.WinT + (size_t)layer * NWIN * 1024;
  const bool ctx_sparse = (layer == 1);
  const int tm = (ctx_sparse ? NTL : NT) / 256, tn = NWIN / 128, T_main = tm * tn, T = T_main + (ctx_sparse ? 30 : 0);
  const int tid = opq_tid(), lane = tid & 63, wid = tid >> 6, wm = wid >> 1, wn = wid & 1;
  const int lr = lane & 31, lh = lane >> 5;
  bf16_t* As = smem;
  bf16_t* Bs = smem + 256 * 72;
  const int bid = opq_bid();
  int tstart = 0, tend = T, lb = bid, nbx = gridDim.x;
  if ((gridDim.x & 7) == 0) {
    int xcd = bid & 7; lb = bid >> 3; nbx = gridDim.x >> 3;
    tstart = (int)((long)T * xcd / 8); tend = (int)((long)T * (xcd + 1) / 8);
  }
  const int ng_full = tn / 8, rem = tn % 8, per_group = tm * 8;
  const int sr = tid >> 3, sc = (tid & 7) * 8;
  for (int t = tstart + lb; t < tend; t += nbx) {
    int mi, ni;
    if (t >= T_main) { int e = t - T_main, j = e % 15; mi = 32 + e / 15; ni = (j < 12) ? 8 + j : ((j < 14) ? 28 + j : 46); }
    else if (t < ng_full * per_group) { int ng = t / per_group, r = t % per_group; mi = r >> 3; ni = ng * 8 + (r & 7); }
    else { int r = t - ng_full * per_group; mi = r / rem; ni = ng_full * 8 + r % rem; }
    const int m0 = mi * 256, n0 = ni * 128;
    f32x16 acc[4][2];
#pragma unroll
    for (int i = 0; i < 4; ++i)
#pragma unroll
      for (int j = 0; j < 2; ++j)
#pragma unroll
        for (int r = 0; r < 16; ++r) acc[i][j][r] = 0.f;
    const bf16_t* ga = A + (size_t)(m0 + sr) * K + sc;
    const bf16_t* gb = Bt + (size_t)(n0 + sr) * K + sc;
    bf16x8 ra[8], rb[4];
#pragma unroll
    for (int i = 0; i < 8; ++i) ra[i] = *(const bf16x8*)(ga + (size_t)i * 32 * K);
#pragma unroll
    for (int i = 0; i < 4; ++i) rb[i] = *(const bf16x8*)(gb + (size_t)i * 32 * K);
    for (int kt = 0; kt < nk; ++kt) {
      __syncthreads();
#pragma unroll
      for (int i = 0; i < 8; ++i) *(bf16x8*)(As + (sr + i * 32) * 72 + sc) = ra[i];
#pragma unroll
      for (int i = 0; i < 4; ++i) *(bf16x8*)(Bs + (sr + i * 32) * 72 + sc) = rb[i];
      __syncthreads();
      if (kt + 1 < nk) {
#pragma unroll
        for (int i = 0; i < 8; ++i) ra[i] = *(const bf16x8*)(ga + (size_t)i * 32 * K + (kt + 1) * 64);
#pragma unroll
        for (int i = 0; i < 4; ++i) rb[i] = *(const bf16x8*)(gb + (size_t)i * 32 * K + (kt + 1) * 64);
      }
#pragma unroll
      for (int kk = 0; kk < 4; ++kk) {
        bf16x8 b0v = *(const bf16x8*)(Bs + (wn * 64 + lr) * 72 + kk * 16 + lh * 8);
        bf16x8 b1v = *(const bf16x8*)(Bs + (wn * 64 + 32 + lr) * 72 + kk * 16 + lh * 8);
#pragma unroll
        for (int i = 0; i < 4; ++i) {
          bf16x8 av = *(const bf16x8*)(As + (wm * 128 + i * 32 + lr) * 72 + kk * 16 + lh * 8);
          acc[i][0] = __builtin_amdgcn_mfma_f32_32x32x16_bf16(av, b0v, acc[i][0], 0, 0, 0);
          acc[i][1] = __builtin_amdgcn_mfma_f32_32x32x16_bf16(av, b1v, acc[i][1], 0, 0, 0);
        }
      }
    }
    if (ni < 46) {
      bf16_t* dst; int ld, cb;
      if (ni < 8) { dst = p.PZ; ld = 1024; cb = ni * 128; }
      else if (ni < 20) { dst = p.PXBC; ld = 1536; cb = (ni - 8) * 128; }
      else if (ni < 36) { dst = p.PSC; ld = 2048; cb = (ni - 20) * 128; }
      else { dst = p.PATT; ld = 1280; cb = (ni - 36) * 128; }
      bf16_t* Os = smem;
      __syncthreads();
#pragma unroll
      for (int half = 0; half < 2; ++half) {
        if (wm == half) {
          bf16_t* q = Os + (4 * lh) * 136 + wn * 64 + lr;
#pragma unroll
          for (int i = 0; i < 4; ++i)
#pragma unroll
            for (int j = 0; j < 2; ++j)
#pragma unroll
              for (int r = 0; r < 16; ++r) q[(i * 32 + (r & 3) + 8 * (r >> 2)) * 136 + j * 32] = f2bf(acc[i][j][r]);
        }
        __syncthreads();
        {
          const int orow = tid >> 4, ocol = (tid & 15) * 8;
          bf16_t* gd = dst + (size_t)(m0 + half * 128 + orow) * ld + cb + ocol;
#pragma unroll
          for (int k = 0; k < 8; ++k) {
            bf16x8 v = *(const bf16x8*)(Os + (orow + 16 * k) * 136 + ocol);
            *(bf16x8*)(gd + (size_t)(16 * k) * ld) = v;
          }
        }
        __syncthreads();
      }
    } else if (wn == 0) {
#pragma unroll
      for (int i = 0; i < 4; ++i)
#pragma unroll
        for (int r = 0; r < 16; ++r) {
          int row = m0 + wm * 128 + i * 32 + (r & 3) + 8 * (r >> 2) + 4 * lh;
          p.DTRAW[(size_t)row * 32 + lr] = acc[i][0][r];
        }
    }
  }
}

__device__ void phase_prep(const Params& p, int layer, int pass, float* smem) {
  const int tid = opq_tid(), lane = tid & 63;
  const int gw = opq_bid() * 4 + (tid >> 6), nw = gridDim.x * 4;
  for (int gc = opq_bid(); gc < NCH; gc += gridDim.x) {
    float* sda = smem; float* sdt = smem + 4224;
    for (int e = tid; e < 4096; e += 256) {
      int l = e >> 5, dh = e & 31;
      float raw = p.DTRAW[((size_t)gc * 128 + l) * 32 + dh] + p.ssd_dt_bias[layer * 32 + dh];
      float dt = raw > 20.f ? raw : log1pf(expf(raw));
      float A = -expf(p.ssd_a_log[layer * 32 + dh]);
      sdt[l * 33 + dh] = dt;
      sda[l * 33 + dh] = dt * A;
    }
    __syncthreads();
    {
      const int dh = tid & 31, seg = tid >> 5;
      float* segtot = smem + 8448;
      float loc[16]; float s = 0.f;
      if (dh < 16) {
#pragma unroll
        for (int j = 0; j < 16; ++j) { s += sda[(seg * 16 + j) * 33 + dh]; loc[j] = s; }
      } else {
#pragma unroll
        for (int j = 15; j >= 0; --j) { s += sda[(seg * 16 + j) * 33 + dh]; loc[j] = s; }
      }
      segtot[seg * 32 + dh] = s;
      __syncthreads();
      float off = 0.f;
      if (dh < 16) { for (int k = 0; k < seg; ++k) off += segtot[k * 32 + dh]; }
      else { for (int k = 7; k > seg; --k) off += segtot[k * 32 + dh]; }
#pragma unroll
      for (int j = 0; j < 16; ++j) sda[(seg * 16 + j) * 33 + dh] = loc[j] + off;
    }
    __syncthreads();
    for (int e = tid; e < 4096; e += 256) {
      int dh = e >> 7, l = e & 127;
      float cum = sda[l * 33 + dh], dt = sdt[l * 33 + dh];
      float tot = (dh < 16) ? sda[127 * 33 + dh] : sda[dh];
      size_t idx = ((size_t)gc * 32 + dh) * 128 + l;
      p.CUMT[idx] = cum;
      p.VV[idx] = cum - logf(fmaxf(dt, 1e-30f));
      p.EC[idx] = expf(cum);
      p.WW[idx] = dt * expf(tot - cum);
    }
    __syncthreads();
  }
  const int nchc = (layer == 0) ? NCH : 64;
  const int Nb = NCH * 4 * 24, Nc = nchc * 16, Nd = (NT * 40) / 64, Ne = NCH * 16 * 2;
  for (int uu = gw; uu < Nb + Nc + Nd + Ne; uu += nw) {
  if (uu < Nb) {
    const int u = uu;
    int cblk = u % 24, l32 = (u / 24) & 3, gc = u / (24 * 4);
    int c = cblk * 64 + lane;
    bool first, last;
    if (gc < 64) { first = (gc % 32 == 0) && l32 == 0; last = (gc % 32 == 31) && l32 == 3; }
    else { first = ((gc - 64) % 2 == 0) && l32 == 0; last = ((gc - 64) % 2 == 1) && l32 == 3; }
    int t0 = gc * 128 + l32 * 32;
    float w0 = p.ssd_conv_w[((size_t)layer * 3 + 0) * 1536 + c], w1 = p.ssd_conv_w[((size_t)layer * 3 + 1) * 1536 + c],
          w2 = p.ssd_conv_w[((size_t)layer * 3 + 2) * 1536 + c], bs = p.ssd_conv_b[layer * 1536 + c];
    bf16_t raw[34];
#pragma unroll
    for (int i = 0; i < 34; ++i) {
      bool ok = !((i == 0 && first) || (i == 33 && last));
      raw[i] = ok ? p.PXBC[(size_t)(t0 + i - 1) * 1536 + c] : (bf16_t)0;
    }
    bf16x8 o[4];
#pragma unroll
    for (int j = 0; j < 32; ++j)
      o[j >> 3][j & 7] = (short)f2bf(silu_f(w0 * bf2f(raw[j]) + w1 * bf2f(raw[j + 1]) + w2 * bf2f(raw[j + 2]) + bs));
    if (c < 1024) {
#pragma unroll
      for (int k = 0; k < 4; ++k) *(bf16x8*)(p.XT + ((size_t)gc * 1024 + c) * 128 + l32 * 32 + k * 8) = o[k];
    } else if (c < 1280) {
      int n = c - 1024;
#pragma unroll
      for (int k = 0; k < 4; ++k) *(bf16x8*)(p.BT + ((size_t)gc * 256 + n) * 128 + l32 * 32 + k * 8) = o[k];
#pragma unroll
      for (int j = 0; j < 32; ++j) p.BR[(size_t)(t0 + j) * 256 + n] = (bf16_t)o[j >> 3][j & 7];
    } else {
      int n = c - 1280;
#pragma unroll
      for (int j = 0; j < 32; ++j) p.CR[(size_t)(t0 + j) * 256 + n] = (bf16_t)o[j >> 3][j & 7];
    }
  } else if (uu < Nb + Nc) {
    {
      const int u = uu - Nb;
      const int l8 = u & 15, gc = u >> 4;
      const int c0 = lane * 8;
      bool first, last;
      if (gc < 64) { first = (gc % 32 == 0) && l8 == 0; last = (gc % 32 == 31) && l8 == 15; }
      else { first = ((gc - 64) % 2 == 0) && l8 == 0; last = ((gc - 64) % 2 == 1) && l8 == 15; }
      const int t0 = gc * 128 + l8 * 8;
      float w0[8], w1[8], w2[8];
      {
        const float* wp = p.sc_conv_w + (size_t)layer * 3 * 512 + c0;
        f32x4 a0 = *(const f32x4*)wp, a1 = *(const f32x4*)(wp + 4);
        f32x4 b0 = *(const f32x4*)(wp + 512), b1 = *(const f32x4*)(wp + 516);
        f32x4 d0 = *(const f32x4*)(wp + 1024), d1 = *(const f32x4*)(wp + 1028);
#pragma unroll
        for (int k = 0; k < 4; ++k) { w0[k] = a0[k]; w0[4 + k] = a1[k]; w1[k] = b0[k]; w1[4 + k] = b1[k]; w2[k] = d0[k]; w2[4 + k] = d1[k]; }
      }
      float up[10][8];
#pragma unroll
      for (int i = 0; i < 10; ++i) {
        bool ok = !((i == 0 && first) || (i == 9 && last));
        const bf16_t* r = p.PSC + (size_t)(t0 + i - 1) * 2048 + c0;
        bf16x8 v8 = ok ? *(const bf16x8*)r : bf16x8{0, 0, 0, 0, 0, 0, 0, 0};
        bf16x8 g8 = ok ? *(const bf16x8*)(r + 512) : bf16x8{0, 0, 0, 0, 0, 0, 0, 0};
#pragma unroll
        for (int k = 0; k < 8; ++k) up[i][k] = bf2f((bf16_t)v8[k]) * bf2f((bf16_t)g8[k]);
      }
#pragma unroll
      for (int j = 0; j < 8; ++j) {
        const bf16_t* r = p.PSC + (size_t)(t0 + j) * 2048 + c0;
        bf16x8 b8 = *(const bf16x8*)(r + 1024), z8 = *(const bf16x8*)(r + 1536);
        f32x4 lo, hi;
#pragma unroll
        for (int k = 0; k < 8; ++k) {
          float cv = w0[k] * up[j][k] + w1[k] * up[j + 1][k] + w2[k] * up[j + 2][k];
          float o = bf2f((bf16_t)b8[k]) * cv * silu_f(bf2f((bf16_t)z8[k]));
          if (k < 4) lo[k] = o; else hi[k - 4] = o;
        }
        *(bf16x8*)(p.Y + (size_t)(t0 + j) * 2048 + 1024 + c0) = pack8(lo, hi);
      }
    }
  } else if (uu < Nb + Nc + Nd) {
    {
      const int idx = (uu - Nb - Nc) * 64 + lane;
      int row = idx / 40, r = idx % 40;
      int slot = r >> 2, a = (r >> 1) & 1, i0 = (r & 1) * 8;
      const bf16_t* src = p.PATT + (size_t)row * 1280 + (slot < 8 ? slot * 64 : 512 + (slot - 8) * 64) + a * 32 + i0;
      bf16x8 x1 = *(const bf16x8*)src, x2 = *(const bf16x8*)(src + 16);
      bf16x8 o1, o2;
      if (row < NTL) {
        int t = row & (SEQ - 1);
        int pos = (a == 0) ? (t >> 6) : (t & 63);
        const float* tb = p.ROPE + (pos * 16 + i0) * 2;
#pragma unroll
        for (int j = 0; j < 8; ++j) {
          float cs = tb[2 * j], sn = tb[2 * j + 1];
          float a1 = bf2f((bf16_t)x1[j]), a2 = bf2f((bf16_t)x2[j]);
          o1[j] = (short)f2bf(a1 * cs - a2 * sn);
          o2[j] = (short)f2bf(a1 * sn + a2 * cs);
        }
      } else { o1 = x1; o2 = x2; }
      bf16_t* dst = (slot < 8) ? p.QR + (size_t)row * 512 + slot * 64 + a * 32 + i0
                               : p.KR + (size_t)row * 128 + (slot - 8) * 64 + a * 32 + i0;
      *(bf16x8*)dst = o1; *(bf16x8*)(dst + 16) = o2;
    }
  } else {
    const int u = uu - Nb - Nc - Nd;
    int half = u & 1, l8 = (u >> 1) & 15, gc = u >> 5;
    int c = half * 64 + lane;
    int t0 = gc * 128 + l8 * 8;
    bf16x8 o;
#pragma unroll
    for (int j = 0; j < 8; ++j) o[j] = (short)p.PATT[(size_t)(t0 + j) * 1280 + 640 + c];
    *(bf16x8*)(p.VT + ((size_t)gc * 128 + c) * 128 + l8 * 8) = o;
  }
  }
}

__device__ void phase_attn_naive(const Params& p, int layer, int pass) {
  const int lane = opq_tid() & 63;
  const int gw = opq_bid() * 4 + (opq_tid() >> 6), nw = gridDim.x * 4;
  const int nrows = (layer == 0) ? NT : NTL;
  for (int u = gw; u < nrows * 8; u += nw) {
    int h = u & 7, row = u >> 3, kvh = h >> 2;
    float q = bf2f(p.QR[(size_t)row * 512 + h * 64 + lane]);
    float m = p.attn_sink[layer * 8 + h], l = 1.f, o = 0.f;
    int bl, k0 = 0, k1 = 0;
    if (row < NTL) {
      bl = row / SEQ; int t = row % SEQ;
      int lo = t - 128 < 0 ? 0 : t - 128, hi = t + 128 > SEQ - 1 ? SEQ - 1 : t + 128;
      k0 = bl * SEQ + lo; k1 = bl * SEQ + hi + 1;
    } else bl = (row - NTL) / CTXL;
    int nband = k1 - k0;
    for (int kk = 0; kk < nband + CTXL; ++kk) {
      int kr = (kk < nband) ? k0 + kk : NTL + bl * CTXL + (kk - nband);
      float kv = bf2f(p.KR[(size_t)kr * 128 + kvh * 64 + lane]);
      float vv = bf2f(p.VT[((size_t)(kr >> 7) * 128 + kvh * 64 + lane) * 128 + (kr & 127)]);
      float s = wave_sum(q * kv) * 0.125f;
      float mn = fmaxf(m, s);
      float corr = expf(m - mn), pe = expf(s - mn);
      l = l * corr + pe; o = o * corr + pe * vv; m = mn;
    }
    float z = bf2f(p.PATT[(size_t)row * 1280 + 768 + h * 64 + lane]);
    p.Y[(size_t)row * 2048 + 1536 + h * 64 + lane] = f2bf(o / l * silu_f(z));
  }
}

__device__ void phase_attn(const Params& p, int layer, int pass, bf16_t* smem) {
  const int tid = opq_tid(), lane = tid & 63, wid = tid >> 6, lr = lane & 31, lh = lane >> 5;
  const int nqt = ((layer == 0) ? NT : NTL) / 32;
  const int srow = tid >> 3, scol = (tid & 7) * 8;
  for (int u = (opq_bid() + (int)gridDim.x - 64) % (int)gridDim.x; u < nqt * 2; u += gridDim.x) {
    const int kvh = u & 1, qt = u >> 1, h = kvh * 4 + wid;
    const int q0 = qt * 32;
    int bl, nband = 0, tb0 = 0, t0 = 0;
    if (q0 < NTL) {
      bl = q0 >> 12; t0 = q0 & 4095;
      tb0 = (t0 - 128 < 0) ? 0 : ((t0 - 128) >> 6);
      int tb1 = (t0 + 159) >> 6; if (tb1 > 63) tb1 = 63;
      nband = tb1 - tb0 + 1;
    } else bl = (q0 - NTL) >> 8;
    const int ntile = nband + 4;
    bf16x8 qf[4];
    {
      const bf16_t* qp = p.QR + (size_t)(q0 + lr) * 512 + h * 64 + lh * 8;
#pragma unroll
      for (int kk = 0; kk < 4; ++kk) qf[kk] = *(const bf16x8*)(qp + kk * 16);
    }
    float m = p.attn_sink[layer * 8 + h], l = 1.f;
    f32x16 o[2];
#pragma unroll
    for (int r = 0; r < 16; ++r) { o[0][r] = 0.f; o[1][r] = 0.f; }
    const int qpos = t0 + lr;
    bf16x8 rk[2], rv[2];
    auto fetch = [&](int ti) __attribute__((always_inline)) {
      const int kr0 = (ti < nband) ? bl * 4096 + (tb0 + ti) * 64 : NTL + bl * 256 + (ti - nband) * 64;
      const bf16_t* kp = p.KR + (size_t)(kr0 + srow) * 128 + kvh * 64 + scol;
      const bf16_t* vp = p.VT + ((size_t)(kr0 >> 7) * 128 + kvh * 64 + srow) * 128 + (kr0 & 127) + scol;
      rk[0] = *(const bf16x8*)kp; rk[1] = *(const bf16x8*)(kp + 32 * 128);
      rv[0] = *(const bf16x8*)vp; rv[1] = *(const bf16x8*)(vp + 32 * 128);
    };
    auto stash = [&](bf16_t* buf) __attribute__((always_inline)) {
      *(bf16x8*)(buf + srow * 72 + scol) = rk[0];
      *(bf16x8*)(buf + (srow + 32) * 72 + scol) = rk[1];
      *(bf16x8*)(buf + 4608 + srow * 72 + scol) = rv[0];
      *(bf16x8*)(buf + 4608 + (srow + 32) * 72 + scol) = rv[1];
    };
    fetch(0);
    __syncthreads();
    stash(smem);
    if (1 < ntile) fetch(1);
    __syncthreads();
    for (int ti = 0; ti < ntile; ++ti) {
      const bf16_t* Kc = smem + (ti & 1) * 9216;
      const bf16_t* Vc = Kc + 4608;
      if (ti + 1 < ntile) {
        stash(smem + ((ti + 1) & 1) * 9216);
        if (ti + 2 < ntile) fetch(ti + 2);
      }
      f32x16 st[2];
#pragma unroll
      for (int r = 0; r < 16; ++r) { st[0][r] = 0.f; st[1][r] = 0.f; }
#pragma unroll
      for (int kk = 0; kk < 4; ++kk) {
        bf16x8 kf0 = *(const bf16x8*)(Kc + lr * 72 + kk * 16 + lh * 8);
        bf16x8 kf1 = *(const bf16x8*)(Kc + (32 + lr) * 72 + kk * 16 + lh * 8);
        st[0] = __builtin_amdgcn_mfma_f32_32x32x16_bf16(kf0, qf[kk], st[0], 0, 0, 0);
        st[1] = __builtin_amdgcn_mfma_f32_32x32x16_bf16(kf1, qf[kk], st[1], 0, 0, 0);
      }
      float mx = -3.0e38f;
      const bool band = ti < nband;
      const int kbase = (tb0 + ti) * 64 + 4 * lh;
#pragma unroll
      for (int hh = 0; hh < 2; ++hh)
#pragma unroll
        for (int r = 0; r < 16; ++r) {
          float s = st[hh][r] * 0.125f;
          if (band) {
            int dd = qpos - (kbase + hh * 32 + (r & 3) + 8 * (r >> 2));
            if (dd > 128 || dd < -128) s = -1e30f;
          }
          st[hh][r] = s; mx = fmaxf(mx, s);
        }
      mx = fmaxf(mx, __shfl_xor(mx, 32));
      const float mn = fmaxf(m, mx);
      const float corr = __expf(m - mn);
      m = mn;
      float ls = 0.f;
#pragma unroll
      for (int hh = 0; hh < 2; ++hh)
#pragma unroll
        for (int r = 0; r < 16; ++r) { st[hh][r] = __expf(st[hh][r] - mn); ls += st[hh][r]; }
      ls += __shfl_xor(ls, 32);
      l = l * corr + ls;
#pragma unroll
      for (int r = 0; r < 16; ++r) { o[0][r] *= corr; o[1][r] *= corr; }
#pragma unroll
      for (int hh = 0; hh < 2; ++hh)
#pragma unroll
        for (int s2 = 0; s2 < 2; ++s2) {
          f32x4 pa = {st[hh][8 * s2 + 0], st[hh][8 * s2 + 1], st[hh][8 * s2 + 2], st[hh][8 * s2 + 3]};
          f32x4 pb = {st[hh][8 * s2 + 4], st[hh][8 * s2 + 5], st[hh][8 * s2 + 6], st[hh][8 * s2 + 7]};
          bf16x8 pf = pack8(pa, pb);
#pragma unroll
          for (int mt = 0; mt < 2; ++mt) {
            const bf16_t* vp = Vc + (mt * 32 + lr) * 72 + hh * 32 + 16 * s2 + 4 * lh;
            bf16x4 x0 = *(const bf16x4*)vp, x1 = *(const bf16x4*)(vp + 8);
            bf16x8 vfr = {x0[0], x0[1], x0[2], x0[3], x1[0], x1[1], x1[2], x1[3]};
            o[mt] = __builtin_amdgcn_mfma_f32_32x32x16_bf16(vfr, pf, o[mt], 0, 0, 0);
          }
        }
      __syncthreads();
    }
    const float inv = 1.f / l;
    {
      bf16_t* Zw = smem + 2 * 9216 + wid * (32 * 72);
      const int er = lane >> 3, ec = (lane & 7) * 8;
      const bf16_t* zg = p.PATT + (size_t)(q0 + er) * 1280 + 768 + h * 64 + ec;
      bf16x8 zr[4];
#pragma unroll
      for (int i = 0; i < 4; ++i) zr[i] = *(const bf16x8*)(zg + (size_t)i * 8 * 1280);
#pragma unroll
      for (int i = 0; i < 4; ++i) *(bf16x8*)(Zw + (er + 8 * i) * 72 + ec) = zr[i];
#pragma unroll
      for (int mt = 0; mt < 2; ++mt)
#pragma unroll
        for (int qq = 0; qq < 4; ++qq) {
          int d0 = mt * 32 + 8 * qq + 4 * lh;
          bf16x4 z4 = *(const bf16x4*)(Zw + lr * 72 + d0);
          bf16x4 o4;
#pragma unroll
          for (int t = 0; t < 4; ++t) o4[t] = (short)f2bf(o[mt][qq * 4 + t] * inv * silu_f(bf2f((bf16_t)z4[t])));
          *(bf16x4*)(Zw + lr * 72 + d0) = o4;
        }
      bf16_t* yg = p.Y + (size_t)(q0 + er) * 2048 + 1536 + h * 64 + ec;
#pragma unroll
      for (int i = 0; i < 4; ++i) *(bf16x8*)(yg + (size_t)i * 8 * 2048) = *(const bf16x8*)(Zw + (er + 8 * i) * 72 + ec);
    }
  }
}

__device__ void phase_s1(const Params& p, int layer, int pass, bf16_t* smem) {
  const int tid = opq_tid(), lane = tid & 63, nt = tid >> 6, lr = lane & 31, lh = lane >> 5;
  constexpr int RS = 136;
  bf16_t* Xs = smem;
  bf16_t* Bts = smem + 64 * RS;
  float* Ws = (float*)(smem + 192 * RS);
  const int srow = tid >> 4, scol = (tid & 15) * 8;
  for (int u = opq_bid(); u < NCH * 16; u += gridDim.x) {
    const int h = u & 15, gc = u >> 4, g = h >> 3;
    bf16x8 rx[4], rb[8];
    {
      const bf16_t* Xg = p.XT + ((size_t)gc * 1024 + h * 64 + srow) * 128 + scol;
#pragma unroll
      for (int i = 0; i < 4; ++i) rx[i] = *(const bf16x8*)(Xg + i * 2048);
      const bf16_t* Bg = p.BT + ((size_t)gc * 256 + g * 128 + srow) * 128 + scol;
#pragma unroll
      for (int i = 0; i < 8; ++i) rb[i] = *(const bf16x8*)(Bg + i * 2048);
    }
    const float wv = p.WW[((size_t)gc * 32 + (tid >> 7) * 16 + h) * 128 + (tid & 127)];
    __syncthreads();
#pragma unroll
    for (int i = 0; i < 4; ++i) *(bf16x8*)(Xs + (srow + 16 * i) * RS + scol) = rx[i];
#pragma unroll
    for (int i = 0; i < 8; ++i) *(bf16x8*)(Bts + (srow + 16 * i) * RS + scol) = rb[i];
    Ws[tid] = wv;
    __syncthreads();
#pragma unroll 1
    for (int d = 0; d < 2; ++d) {
      f32x16 acc0, acc1;
#pragma unroll
      for (int r = 0; r < 16; ++r) { acc0[r] = 0.f; acc1[r] = 0.f; }
#pragma unroll
      for (int kk = 0; kk < 8; ++kk) {
        bf16x8 bfr = *(const bf16x8*)(Bts + (nt * 32 + lr) * RS + kk * 16 + lh * 8);
        bf16x8 x0 = *(const bf16x8*)(Xs + lr * RS + kk * 16 + lh * 8);
        bf16x8 x1 = *(const bf16x8*)(Xs + (32 + lr) * RS + kk * 16 + lh * 8);
        f32x4 wa = *(const f32x4*)(Ws + d * 128 + kk * 16 + lh * 8), wb = *(const f32x4*)(Ws + d * 128 + kk * 16 + lh * 8 + 4);
        f32x4 a0, a1, c0, c1;
#pragma unroll
        for (int j = 0; j < 4; ++j) {
          a0[j] = bf2f((bf16_t)x0[j]) * wa[j]; a1[j] = bf2f((bf16_t)x0[4 + j]) * wb[j];
          c0[j] = bf2f((bf16_t)x1[j]) * wa[j]; c1[j] = bf2f((bf16_t)x1[4 + j]) * wb[j];
        }
        acc0 = __builtin_amdgcn_mfma_f32_32x32x16_bf16(pack8(a0, a1), bfr, acc0, 0, 0, 0);
        acc1 = __builtin_amdgcn_mfma_f32_32x32x16_bf16(pack8(c0, c1), bfr, acc1, 0, 0, 0);
      }
      float* dst = p.LST + ((((size_t)gc * 16 + h) * 2 + d) * 64) * 128 + nt * 32 + lr;
#pragma unroll
      for (int r = 0; r < 16; ++r) {
        int pp = (r & 3) + 8 * (r >> 2) + 4 * lh;
        dst[(size_t)pp * 128] = acc0[r];
        dst[(size_t)(32 + pp) * 128] = acc1[r];
      }
    }
  }
}

__device__ __forceinline__ int scan_chunk(int ci, int bl, int d) {
  if (ci < 2) return 64 + bl * 2 + (d == 0 ? ci : 1 - ci);
  int cc = ci - 2;
  return bl * 32 + (d == 0 ? cc : 31 - cc);
}
__device__ void phase_s2(const Params& p, int layer, int pass) {
  const int nth = gridDim.x * 256;
  for (int e = opq_bid() * 256 + opq_tid(); e < 64 * 2048; e += nth) {
    int seq = e >> 11, q = e & 2047, pp = q >> 5, n4 = (q & 31) * 4;
    int d = seq & 1, h = (seq >> 1) & 15, bl = seq >> 5;
    f32x4 s = {0.f, 0.f, 0.f, 0.f};
    const size_t eoff = ((size_t)h * 2 + d) * 8192 + (size_t)pp * 128 + n4;
    const int toff = (d == 0) ? h * 128 + 127 : (16 + h) * 128;
#pragma unroll
    for (int half = 0; half < 2; ++half) {
      f32x4 loc[17]; float tot[17];
#pragma unroll
      for (int i = 0; i < 17; ++i) {
        int gc = scan_chunk(half * 17 + i, bl, d);
        loc[i] = *(const f32x4*)(p.LST + (size_t)gc * 262144 + eoff);
        tot[i] = p.CUMT[(size_t)gc * 4096 + toff];
      }
#pragma unroll
      for (int i = 0; i < 17; ++i) {
        int gc = scan_chunk(half * 17 + i, bl, d);
        uint2 o; o.x = pk2(s[0], s[1]); o.y = pk2(s[2], s[3]);
        *(uint2*)(p.SIN + (size_t)gc * 262144 + eoff) = o;
        float dec = expf(tot[i]);
        s = s * dec + loc[i];
      }
    }
  }
}

__device__ void phase_s3(const Params& p, int layer, int pass, bf16_t* smem) {
  const int tid = opq_tid(), lane = tid & 63, w = tid >> 6, lr = lane & 31, lh = lane >> 5;
  const int nch = (layer == 0) ? NCH : 64;
  constexpr int RS = 136;
  bf16_t* Ss = smem;
  bf16_t* Bs = smem;
  bf16_t* Xs = smem + 128 * RS;
  float* Vs = (float*)(smem + 192 * RS);
  bf16_t* Zs = smem + 192 * RS + 1536;
  bf16_t* Os = smem;
  const int srow = tid >> 4, scol = (tid & 15) * 8;
  for (int u = opq_bid(); u < nch * 16; u += gridDim.x) {
    const int h = u & 15, gc = u >> 4, g = h >> 3;
    const int i_own = 32 * w + lr;
    bf16x8 rs[8];
    {
      const bf16_t* Sg = p.SIN + ((size_t)gc * 16 + h) * 16384 + srow * 128 + scol;
#pragma unroll
      for (int i = 0; i < 8; ++i) rs[i] = *(const bf16x8*)(Sg + i * 2048);
    }
    bf16x8 cf[8];
    {
      const bf16_t* crow = p.CR + ((size_t)gc * 128 + i_own) * 256 + g * 128 + lh * 8;
#pragma unroll
      for (int kk = 0; kk < 8; ++kk) cf[kk] = *(const bf16x8*)(crow + kk * 16);
    }
    bf16x8 rz[4];
    {
      const bf16_t* Zg = p.PZ + ((size_t)gc * 128 + (tid >> 3)) * 1024 + h * 64 + (tid & 7) * 8;
#pragma unroll
      for (int i = 0; i < 4; ++i) rz[i] = *(const bf16x8*)(Zg + (size_t)i * 32 * 1024);
    }
    const size_t vidx = ((size_t)gc * 32 + (tid >> 7) * 16 + h) * 128 + (tid & 127);
    const float v_vv = p.VV[vidx], v_ec = p.EC[vidx], v_cu = p.CUMT[vidx];
    __syncthreads();
#pragma unroll
    for (int i = 0; i < 8; ++i) *(bf16x8*)(Ss + (srow + 16 * i) * RS + scol) = rs[i];
    Vs[tid] = v_vv; Vs[256 + tid] = v_ec; Vs[512 + tid] = v_cu;
#pragma unroll
    for (int i = 0; i < 4; ++i) *(bf16x8*)(Zs + ((tid >> 3) + 32 * i) * 72 + (tid & 7) * 8) = rz[i];
    bf16x8 rb[8], rx[4];
    {
      const bf16_t* Bg = p.BR + ((size_t)gc * 128 + srow) * 256 + g * 128 + scol;
#pragma unroll
      for (int i = 0; i < 8; ++i) rb[i] = *(const bf16x8*)(Bg + i * 16 * 256);
      const bf16_t* Xg = p.XT + ((size_t)gc * 1024 + h * 64 + srow) * 128 + scol;
#pragma unroll
      for (int i = 0; i < 4; ++i) rx[i] = *(const bf16x8*)(Xg + i * 2048);
    }
    __syncthreads();
    f32x16 y[2];
#pragma unroll
    for (int r = 0; r < 16; ++r) { y[0][r] = 0.f; y[1][r] = 0.f; }
#pragma unroll
    for (int d = 0; d < 2; ++d) {
      const float* ec = Vs + 256 + d * 128 + 32 * w + 4 * lh;
#pragma unroll
      for (int pt = 0; pt < 2; ++pt) {
        f32x16 tmp;
#pragma unroll
        for (int r = 0; r < 16; ++r) tmp[r] = 0.f;
        const bf16_t* sl = Ss + (d * 64 + pt * 32 + lr) * RS + lh * 8;
#pragma unroll
        for (int kk = 0; kk < 8; ++kk) {
          bf16x8 sf = *(const bf16x8*)(sl + kk * 16);
          tmp = __builtin_amdgcn_mfma_f32_32x32x16_bf16(cf[kk], sf, tmp, 0, 0, 0);
        }
#pragma unroll
        for (int q = 0; q < 4; ++q) {
          f32x4 e4 = *(const f32x4*)(ec + 8 * q);
#pragma unroll
          for (int t = 0; t < 4; ++t) y[pt][q * 4 + t] += tmp[q * 4 + t] * e4[t];
        }
      }
    }
    __syncthreads();
#pragma unroll
    for (int i = 0; i < 8; ++i) *(bf16x8*)(Bs + (srow + 16 * i) * RS + scol) = rb[i];
#pragma unroll
    for (int i = 0; i < 4; ++i) *(bf16x8*)(Xs + (srow + 16 * i) * RS + scol) = rx[i];
    __syncthreads();
    const float cum_f = Vs[512 + i_own];
    const float cum_b = Vs[512 + 128 + i_own];
#pragma unroll 1
    for (int jt = 0; jt < 4; ++jt) {
      f32x16 cb;
#pragma unroll
      for (int r = 0; r < 16; ++r) cb[r] = 0.f;
      const bf16_t* bl_ = Bs + (jt * 32 + lr) * RS + lh * 8;
#pragma unroll
      for (int kk = 0; kk < 8; ++kk) {
        bf16x8 bfr = *(const bf16x8*)(bl_ + kk * 16);
        cb = __builtin_amdgcn_mfma_f32_32x32x16_bf16(bfr, cf[kk], cb, 0, 0, 0);
      }
      bf16x8 xb[2][2];
#pragma unroll
      for (int s = 0; s < 2; ++s)
#pragma unroll
        for (int pt = 0; pt < 2; ++pt) {
          const bf16_t* xp = Xs + (pt * 32 + lr) * RS + jt * 32 + 16 * s + 4 * lh;
          bf16x4 x0 = *(const bf16x4*)xp, x1 = *(const bf16x4*)(xp + 8);
          bf16x8 t8 = {x0[0], x0[1], x0[2], x0[3], x1[0], x1[1], x1[2], x1[3]};
          xb[s][pt] = t8;
        }
#pragma unroll
      for (int d = 0; d < 2; ++d) {
        bool need = (d == 0) ? (jt <= w) : (jt >= w);
        if (!need) continue;
        const float* vv = Vs + d * 128 + jt * 32 + 4 * lh;
        const float ci = (d == 0) ? cum_f : cum_b;
        f32x16 gq;
#pragma unroll
        for (int q = 0; q < 4; ++q) {
          f32x4 v4 = *(const f32x4*)(vv + 8 * q);
#pragma unroll
          for (int t = 0; t < 4; ++t) {
            int j = jt * 32 + 8 * q + 4 * lh + t;
            float val = cb[q * 4 + t] * __expf(ci - v4[t]);
            bool ok = (jt != w) || ((d == 0) ? (j <= i_own) : (j >= i_own));
            gq[q * 4 + t] = ok ? val : 0.f;
          }
        }
#pragma unroll
        for (int s = 0; s < 2; ++s) {
          f32x4 ga = {gq[8 * s + 0], gq[8 * s + 1], gq[8 * s + 2], gq[8 * s + 3]};
          f32x4 gb = {gq[8 * s + 4], gq[8 * s + 5], gq[8 * s + 6], gq[8 * s + 7]};
          bf16x8 afr = pack8(ga, gb);
          y[0] = __builtin_amdgcn_mfma_f32_32x32x16_bf16(afr, xb[s][0], y[0], 0, 0, 0);
          y[1] = __builtin_amdgcn_mfma_f32_32x32x16_bf16(afr, xb[s][1], y[1], 0, 0, 0);
        }
      }
    }
    const float Dh = p.ssd_d[layer * 16 + h];
    float ssq[16];
#pragma unroll
    for (int r = 0; r < 16; ++r) ssq[r] = 0.f;
    __syncthreads();
#pragma unroll
    for (int pt = 0; pt < 2; ++pt)
#pragma unroll
      for (int q = 0; q < 4; ++q) {
        bf16x4 x4 = *(const bf16x4*)(Xs + (pt * 32 + lr) * RS + 32 * w + 8 * q + 4 * lh);
#pragma unroll
        for (int t = 0; t < 4; ++t) {
          int li = 32 * w + 8 * q + 4 * lh + t;
          float yv = y[pt][q * 4 + t] + Dh * bf2f((bf16_t)x4[t]);
          float z = bf2f(Zs[li * 72 + pt * 32 + lr]);
          float gv = yv * silu_f(z);
          ssq[q * 4 + t] += gv * gv;
          Os[li * 72 + pt * 32 + lr] = f2bf(gv);
        }
      }
    __syncthreads();
    {
      bf16_t* Yg = p.Y + ((size_t)gc * 128 + (tid >> 3)) * 2048 + h * 64 + (tid & 7) * 8;
#pragma unroll
      for (int i = 0; i < 4; ++i)
        *(bf16x8*)(Yg + (size_t)i * 32 * 2048) = *(const bf16x8*)(Os + ((tid >> 3) + 32 * i) * 72 + (tid & 7) * 8);
    }
#pragma unroll
    for (int r = 0; r < 16; ++r) {
      float v = ssq[r];
      v += __shfl_xor(v, 1); v += __shfl_xor(v, 2); v += __shfl_xor(v, 4); v += __shfl_xor(v, 8); v += __shfl_xor(v, 16);
      ssq[r] = v;
    }
    if (lr == 0) {
#pragma unroll
      for (int r = 0; r < 16; ++r) {
        int row = gc * 128 + 32 * w + (r & 3) + 8 * (r >> 2) + 4 * lh;
        p.SSQ[(size_t)row * 16 + h] = ssq[r];
      }
    }
  }
}

__device__ void phase_final(const Params& p) {
  const int lane = opq_tid() & 63;
  const int gw = opq_bid() * 4 + (opq_tid() >> 6), nw = gridDim.x * 4;
  float4 w[4];
#pragma unroll
  for (int i = 0; i < 4; ++i) w[i] = *(const float4*)(p.final_norm_w + (i * 64 + lane) * 4);
  for (int row0 = gw; row0 < 4 * SEQ; row0 += 4 * nw) {
    float4 v[4][4];
#pragma unroll
    for (int q = 0; q < 4; ++q) {
      const int row = row0 + q * nw;
      if (row < 4 * SEQ) {
        const float* src = p.out + (size_t)row * D;
#pragma unroll
        for (int i = 0; i < 4; ++i) v[q][i] = *(const float4*)(src + (i * 64 + lane) * 4);
      }
    }
#pragma unroll
    for (int q = 0; q < 4; ++q) {
      const int row = row0 + q * nw;
      if (row < 4 * SEQ) {
        float ss = 0.f;
#pragma unroll
        for (int i = 0; i < 4; ++i) ss += v[q][i].x * v[q][i].x + v[q][i].y * v[q][i].y + v[q][i].z * v[q][i].z + v[q][i].w * v[q][i].w;
        ss = wave_sum(ss);
        const float rstd = rsqrtf(ss * (1.f / D) + EPS);
        float* dst = p.out + (size_t)row * D;
#pragma unroll
        for (int i = 0; i < 4; ++i) {
          float4 o = {v[q][i].x * rstd * w[i].x, v[q][i].y * rstd * w[i].y, v[q][i].z * rstd * w[i].z, v[q][i].w * rstd * w[i].w};
          *(float4*)(dst + (i * 64 + lane) * 4) = o;
        }
      }
    }
  }
}

#ifndef REP_W
#define REP_W 1
#endif
#ifndef REP_GOUT0
#define REP_GOUT0 1
#endif
#ifndef REP_NORM
#define REP_NORM 1
#endif
#ifndef REP_GIN
#define REP_GIN 1
#endif
#ifndef REP_PREP
#define REP_PREP 1
#endif
#ifndef REP_S1
#define REP_S1 1
#endif
#ifndef REP_ATTN
#define REP_ATTN 1
#endif
#ifndef REP_S3
#define REP_S3 1
#endif
__global__ void __launch_bounds__(256, 2) mega(Params p, int lo, int hi) {
  __shared__ __attribute__((aligned(16))) float smem[18432];
  __shared__ uint4 xb_words;
  if (threadIdx.x == 0) xb_words = make_uint4(0u, 0u, 0u, 0u);
  __syncthreads();
  XcdBarrier xb = xcd_barrier_post(p.bar, (volatile LAS unsigned*)&xb_words);
  if (lo < 0) cg::this_grid().sync();
  for (int step = lo; step < hi; ++step) {
    if (step == 0) { for (int rp = 0; rp < REP_W; ++rp) phase_weights(p, smem); }
    else if (step == NSTEP - 1) phase_final(p);
    else {
      int s = step - 1;
      int pass = s / 14, r = s % 14, layer = r / 7, ph = r % 7;
      switch (ph) {
        case ST_NORM: for (int rp = 0; rp < REP_NORM; ++rp) phase_norm(p, layer, pass); break;
        case ST_GIN: for (int rp = 0; rp < REP_GIN; ++rp) phase_gemm_in256(p, layer, pass, (bf16_t*)smem); break;
        case ST_PREP: for (int rp = 0; rp < REP_PREP; ++rp) phase_prep(p, layer, pass, smem); break;
        case ST_MIX:
          for (int rp = 0; rp < REP_S1; ++rp) phase_s1(p, layer, pass, (bf16_t*)smem);
          for (int rp = 0; rp < REP_ATTN; ++rp) phase_attn(p, layer, pass, (bf16_t*)smem);
          break;
        case ST_S2: phase_s2(p, layer, pass); break;
        case ST_S3: for (int rp = 0; rp < REP_S3; ++rp) phase_s3(p, layer, pass, (bf16_t*)smem); break;
        case ST_GOUT: for (int rp = 0; rp < (layer == 0 ? REP_GOUT0 : 1); ++rp) phase_gemm_mfma(p, 1, layer, pass, (bf16_t*)smem); break;
      }
    }
    if (step + 1 < hi) xcd_barrier(xb);
  }
}

extern "C" void kernel_launch(void* const* d_in, const int* in_sizes, int n_in, void* d_out, int out_size, void* d_ws,
                              size_t ws_size, hipStream_t stream) {
  Params p{};
  p.x = (const float*)d_in[0]; p.c = (const float*)d_in[1]; p.ctx = (const float*)d_in[2]; p.c_ctx = (const float*)d_in[3];
  p.norm_w = (const float*)d_in[4]; p.w_mod = (const float*)d_in[5]; p.b_mod = (const float*)d_in[6];
  p.w_in = (const float*)d_in[7]; p.ssd_conv_w = (const float*)d_in[8]; p.ssd_conv_b = (const float*)d_in[9];
  p.ssd_dt_bias = (const float*)d_in[10]; p.ssd_a_log = (const float*)d_in[11]; p.ssd_d = (const float*)d_in[12];
  p.ssd_norm_w = (const float*)d_in[13]; p.sc_conv_w = (const float*)d_in[14]; p.attn_sink = (const float*)d_in[15];
  p.w_out = (const float*)d_in[16]; p.final_norm_w = (const float*)d_in[17];
  p.out = (float*)d_out;
  char* w = (char*)d_ws; size_t off = 0;
  auto take = [&](size_t bytes) { char* r = w + off; off += (bytes + 255) & ~(size_t)255; return r; };
  p.WinT = (bf16_t*)take((size_t)2 * NWIN * 1024 * 2);
  p.WoutT = (bf16_t*)take((size_t)2 * 1024 * 2048 * 2);
  p.MOD = (float*)take((size_t)2 * 5 * 3072 * 4);
  p.CTX1 = (float*)take((size_t)4 * CTXL * D * 4);
  p.ROPE = (float*)take((size_t)64 * 16 * 2 * 4);
  char* big = take((size_t)NT * (1024 + 1536 + 2048) * 2);
  p.H = (bf16_t*)big;
  p.PXBC = (bf16_t*)(big + (size_t)NT * 1024 * 2);
  p.PSC = (bf16_t*)(big + (size_t)NT * (1024 + 1536) * 2);
  p.LST = (float*)big;
  p.PART = (float*)(big + (size_t)24 * 1024 * 1024);
  p.PZ = (bf16_t*)take((size_t)NT * 1024 * 2);
  p.PATT = (bf16_t*)take((size_t)NT * 1280 * 2);
  p.QR = (bf16_t*)take((size_t)NT * 512 * 2);
  p.KR = (bf16_t*)take((size_t)NT * 128 * 2);
  p.VT = (bf16_t*)take((size_t)NT * 128 * 2);
  p.SIN = p.PATT;
  p.DTRAW = (float*)take((size_t)NT * 32 * 4);
  p.CUMT = (float*)take((size_t)NT * 32 * 4);
  p.VV = (float*)take((size_t)NT * 32 * 4);
  p.EC = (float*)take((size_t)NT * 32 * 4);
  p.WW = (float*)take((size_t)NT * 32 * 4);
  p.SSQ = (float*)take((size_t)NT * 16 * 4);
  p.XT = (bf16_t*)take((size_t)NT * 1024 * 2);
  p.BR = (bf16_t*)take((size_t)NT * 256 * 2);
  p.CR = (bf16_t*)take((size_t)NT * 256 * 2);
  p.BT = (bf16_t*)take((size_t)NT * 256 * 2);
  p.Y = (bf16_t*)take((size_t)NT * 2048 * 2);
  p.bar = (unsigned*)take((size_t)XCD_BAR_WORDS * 4);
  if (off > ws_size) { fprintf(stderr, "workspace too small: need %zu have %zu\n", off, ws_size); return; }
  static int grid_blocks = 0;
  if (!grid_blocks) {
    int dev = 0, cus = 0, per_cu = 0;
    hipGetDevice(&dev);
    hipDeviceGetAttribute(&cus, hipDeviceAttributeMultiprocessorCount, dev);
    hipOccupancyMaxActiveBlocksPerMultiprocessor(&per_cu, mega, 256, 0);
    if (per_cu > 2) per_cu = 2;
    if (per_cu < 1) per_cu = 1;
    grid_blocks = cus * per_cu;
  }
  hipMemsetAsync(p.bar, 0, (size_t)XCD_BAR_WORDS * 4, stream);
  int lo = 0, hi = NSTEP;
  void* args[] = {&p, &lo, &hi};
  hipError_t e = hipLaunchCooperativeKernel((void*)mega, dim3(grid_blocks), dim3(256), args, 0, stream);
  if (e != hipSuccess) fprintf(stderr, "cooperative launch failed: %s (grid %d)\n", hipGetErrorString(e), grid_blocks);
}
```

```cpp
#include <hip/hip_runtime.h>
#include <hip/hip_cooperative_groups.h>
#include <cstdio>
#include <type_traits>
namespace cg = cooperative_groups;

typedef unsigned short bf16_t;
typedef __attribute__((ext_vector_type(8))) short bf16x8;
typedef __attribute__((ext_vector_type(4))) short bf16x4;
typedef __attribute__((ext_vector_type(4))) float f32x4;
typedef __attribute__((ext_vector_type(16))) float f32x16;

constexpr int D = 1024, SEQ = 4096, CTXL = 256;
constexpr int NB = 2;
constexpr int NPASS = 2;
constexpr int NTL = NB * SEQ;
constexpr int NTC = NB * CTXL;
constexpr int NT = NTL + NTC;
constexpr int NCH = NT / 128;
constexpr int NWIN = 6016;
constexpr float EPS = 1e-6f;

constexpr int ST_NORM = 0, ST_GIN = 1, ST_PREP = 2, ST_MIX = 3, ST_S2 = 4, ST_S3 = 5, ST_GOUT = 6;
constexpr int NSTEP = 1 + NPASS * 2 * 7 + 1;

struct Params {
  const float *x, *c, *ctx, *c_ctx, *norm_w, *w_mod, *b_mod, *w_in, *ssd_conv_w, *ssd_conv_b, *ssd_dt_bias,
      *ssd_a_log, *ssd_d, *ssd_norm_w, *sc_conv_w, *attn_sink, *w_out, *final_norm_w;
  float* out;
  bf16_t *WinT, *WoutT, *H, *PXBC, *PSC, *PZ, *PATT, *XT, *BR, *CR, *BT, *QR, *KR, *VT, *Y, *SIN;
  float *MOD, *CTX1, *DTRAW, *CUMT, *VV, *EC, *WW, *SSQ, *LST, *ROPE, *PART;
  unsigned* bar;
};

__device__ __forceinline__ int opq_tid() { int t = threadIdx.x; asm volatile("" : "+v"(t)); return t; }
__device__ __forceinline__ int opq_bid() { int b = blockIdx.x; asm volatile("" : "+s"(b)); return b; }
typedef __attribute__((ext_vector_type(2))) __bf16 bfv2;
typedef __attribute__((ext_vector_type(2))) float f32x2;
typedef __attribute__((ext_vector_type(4))) unsigned u32x4;
__device__ __forceinline__ unsigned pk2(float a, float b) {
  f32x2 v = {a, b};
  bfv2 r = __builtin_convertvector(v, bfv2);
  return *(unsigned*)&r;
}
__device__ __forceinline__ bf16_t f2bf(float f) { return (bf16_t)(pk2(f, 0.f) & 0xffffu); }
__device__ __forceinline__ bf16x8 pack8(f32x4 a, f32x4 b) {
  u32x4 u = {pk2(a[0], a[1]), pk2(a[2], a[3]), pk2(b[0], b[1]), pk2(b[2], b[3])};
  return *(bf16x8*)&u;
}
__device__ __forceinline__ float bf2f(bf16_t h) { return __uint_as_float(((unsigned)h) << 16); }
__device__ __forceinline__ float silu_f(float v) { return v * __builtin_amdgcn_rcpf(1.f + __expf(-v)); }
__device__ __forceinline__ float wave_sum(float v) {
#pragma unroll
  for (int o = 32; o > 0; o >>= 1) v += __shfl_xor(v, o);
  return v;
}

#define XB_TMO      128
#define XB_XCNT(j)  (256  + 64 * (j))
#define XB_XSUB(j)  (1280 + 64 * (j))
#define XB_XGEN(j)  (2304 + 64 * (j))
#define XB_TOP      3328
#define XB_TOPGEN   3392
#define XCD_BAR_WORDS 3456
#define XB_SPIN_CAP (1u << 18)
#define LAS __attribute__((address_space(3)))

__device__ __forceinline__ unsigned xb_ld(unsigned* p)              { return __hip_atomic_load(p, __ATOMIC_RELAXED, __HIP_MEMORY_SCOPE_AGENT); }
__device__ __forceinline__ unsigned xb_add(unsigned* p, unsigned v) { return __hip_atomic_fetch_add(p, v, __ATOMIC_RELAXED, __HIP_MEMORY_SCOPE_AGENT); }
__device__ __forceinline__ unsigned xb_xcc_id() { return (unsigned)__builtin_amdgcn_s_getreg((3 << 11) | 20) & 0xFu; }
#define XB_SPIN(cond, bar) do { unsigned _sp = 0; while (cond) { __builtin_amdgcn_s_sleep(1); \
    if ((++_sp & 255u) == 0u) { if (xb_ld(&(bar)[XB_TMO])) break; if (_sp > XB_SPIN_CAP) { atomicAdd(&(bar)[XB_TMO], 1u); break; } } } } while (0)

struct XcdBarrier {
    unsigned* bar; unsigned x;
    volatile LAS unsigned* st;
};

__device__ __forceinline__ XcdBarrier xcd_barrier_post(unsigned* bar, volatile LAS unsigned* st) {
    XcdBarrier b; b.bar = bar; b.x = xb_xcc_id(); b.st = st;
    if (threadIdx.x == 0) (void)xb_add(&bar[XB_XCNT(b.x)], 1u);
    return b;
}
__device__ __forceinline__ void xcd_barrier_complete(unsigned* bar, unsigned x, unsigned& nloc, unsigned& nx) {
    const unsigned G = gridDim.x * gridDim.y * gridDim.z;
    unsigned sum, cnt, mine, sp = 0u;
    for (;;) {
        sum = 0u; cnt = 0u; mine = 0u;
#pragma unroll
        for (unsigned j = 0; j < 16; ++j) { const unsigned c = xb_ld(&bar[XB_XCNT(j)]); sum += c; cnt += (c > 0u) ? 1u : 0u; mine = (j == x) ? c : mine; }
        if (sum == G) break;
        __builtin_amdgcn_s_sleep(1);
        if ((++sp & 255u) == 0u) { if (xb_ld(&bar[XB_TMO])) break; if (sp > XB_SPIN_CAP) { atomicAdd(&bar[XB_TMO], 1u); break; } }
    }
    nloc = mine > 0u ? mine : 1u; nx = cnt > 0u ? cnt : 1u;
}

__device__ __forceinline__ void xcd_barrier(const XcdBarrier& b) {
    asm volatile("s_waitcnt vmcnt(0)" ::: "memory");
    __syncthreads();
    if (threadIdx.x == 0) {
        unsigned* bar = b.bar;
        __builtin_amdgcn_s_waitcnt(0);
        unsigned nloc = b.st[0], nx = b.st[1];
        if (nloc == 0u) { xcd_barrier_complete(bar, b.x, nloc, nx); b.st[0] = nloc; b.st[1] = nx; }
        const unsigned old = xb_add(&bar[XB_XSUB(b.x)], 1u);
        const unsigned gen = old / nloc;
        if (old + 1u == (gen + 1u) * nloc) {
            __builtin_amdgcn_fence(__ATOMIC_RELEASE, "agent");
            asm volatile("s_waitcnt vmcnt(0)" ::: "memory");
            const unsigned og = xb_add(&bar[XB_TOP], 1u);
            const unsigned tg = og / nx;
            if (og + 1u == (tg + 1u) * nx) xb_add(&bar[XB_TOPGEN], 1u);
            else XB_SPIN(xb_ld(&bar[XB_TOPGEN]) == tg, bar);
            __builtin_amdgcn_fence(__ATOMIC_ACQUIRE, "agent");
            xb_add(&bar[XB_XGEN(b.x)], 1u);
            asm volatile("s_waitcnt vmcnt(0)" ::: "memory");
        } else {
            XB_SPIN(xb_ld(&bar[XB_XGEN(b.x)]) == gen, bar);
            __builtin_amdgcn_fence(__ATOMIC_ACQUIRE, "agent");
            asm volatile("s_waitcnt vmcnt(0)" ::: "memory");
        }
    }
    __syncthreads();
}


__device__ void phase_weights(const Params& p, float* smem) {
  const int tid = opq_tid();
  const int NW1 = 2 * 94 * 16, NW2 = 2 * 16 * 32, NM = 192;
  auto load_tile = [&](int it, float* sm) __attribute__((always_inline)) {
    float v[16];
    if (it < NW1) {
      int l = it / (94 * 16), r = it % (94 * 16), nt = r / 16, kt = r % 16;
#pragma unroll
      for (int j = 0; j < 16; ++j) {
        int e = tid + 256 * j, kk = e >> 6, nn = e & 63;
        int n = nt * 64 + nn;
        int oc = (n < 2560) ? n : (n < 5888 ? n + 32 : (n < 5920 ? n - 5888 + 2560 : -1));
        v[j] = (oc >= 0) ? p.w_in[((size_t)l * 1024 + kt * 64 + kk) * 5920 + oc] : 0.f;
      }
    } else {
      int i2 = it - NW1;
      int l = i2 / 512, r = i2 % 512, nt = r / 32, kt = r % 32;
#pragma unroll
      for (int j = 0; j < 16; ++j) {
        int e = tid + 256 * j, kk = e >> 6, nn = e & 63;
        int k = kt * 64 + kk;
        float w = p.w_out[((size_t)l * 2048 + k) * 1024 + nt * 64 + nn];
        v[j] = (k < 1024) ? w * p.ssd_norm_w[l * 1024 + k] : w;
      }
    }
#pragma unroll
    for (int j = 0; j < 16; ++j) { int e = tid + 256 * j; sm[(e >> 6) * 65 + (e & 63)] = v[j]; }
  };
  auto store_tile = [&](int it, const float* sm) __attribute__((always_inline)) {
    if (it < NW1) {
      int l = it / (94 * 16), r = it % (94 * 16), nt = r / 16, kt = r % 16;
#pragma unroll
      for (int j = 0; j < 16; ++j) {
        int e = tid + 256 * j, nn = e >> 6, kk = e & 63;
        p.WinT[((size_t)l * NWIN + nt * 64 + nn) * 1024 + kt * 64 + kk] = f2bf(sm[kk * 65 + nn]);
      }
    } else {
      int i2 = it - NW1;
      int l = i2 / 512, r = i2 % 512, nt = r / 32, kt = r % 32;
#pragma unroll
      for (int j = 0; j < 16; ++j) {
        int e = tid + 256 * j, nn = e >> 6, kk = e & 63;
        p.WoutT[((size_t)l * 1024 + nt * 64 + nn) * 2048 + kt * 64 + kk] = f2bf(sm[kk * 65 + nn]);
      }
    }
  };
  for (int it = opq_bid(); it < NW1 + NW2; it += 4 * gridDim.x) {
#pragma unroll
    for (int q = 0; q < 4; ++q) { int itq = it + q * (int)gridDim.x; if (itq < NW1 + NW2) load_tile(itq, smem + q * 4224); }
    __syncthreads();
#pragma unroll
    for (int q = 0; q < 4; ++q) { int itq = it + q * (int)gridDim.x; if (itq < NW1 + NW2) store_tile(itq, smem + q * 4224); }
    __syncthreads();
  }
  for (int it = opq_bid(); it < NW1 + NW2 + NM; it += gridDim.x) {
    if (it < NW1 + NW2) continue;
    {
      int i3 = it - NW1 - NW2;
      int l = i3 / 96, jb = i3 % 96;
      float* sc = smem;
      float* part = smem + 5120;
      for (int e = tid; e < 5120; e += 256) {
        int r = e >> 10, k = e & 1023;
        float v = (r < 4) ? p.c[r * 1024 + k] : p.c_ctx[k];
        sc[e] = silu_f(v);
      }
      __syncthreads();
      int col = tid & 31, kg = tid >> 5;
      float a0 = 0, a1 = 0, a2 = 0, a3 = 0, a4 = 0;
      const float* wp = p.w_mod + ((size_t)l * 1024 + kg * 128) * 3072 + jb * 32 + col;
      for (int k0 = 0; k0 < 128; k0 += 16) {
        float wv[16];
#pragma unroll
        for (int j = 0; j < 16; ++j) wv[j] = wp[(size_t)(k0 + j) * 3072];
#pragma unroll
        for (int j = 0; j < 16; ++j) {
          int k = kg * 128 + k0 + j;
          a0 += sc[k] * wv[j]; a1 += sc[1024 + k] * wv[j]; a2 += sc[2048 + k] * wv[j]; a3 += sc[3072 + k] * wv[j]; a4 += sc[4096 + k] * wv[j];
        }
      }
      part[(kg * 5 + 0) * 32 + col] = a0; part[(kg * 5 + 1) * 32 + col] = a1; part[(kg * 5 + 2) * 32 + col] = a2;
      part[(kg * 5 + 3) * 32 + col] = a3; part[(kg * 5 + 4) * 32 + col] = a4;
      __syncthreads();
      if (tid < 160) {
        int r = tid >> 5, cc = tid & 31;
        float s = 0.f;
#pragma unroll
        for (int g8 = 0; g8 < 8; ++g8) s += part[(g8 * 5 + r) * 32 + cc];
        p.MOD[((size_t)l * 5 + r) * 3072 + jb * 32 + cc] = s + p.b_mod[l * 3072 + jb * 32 + cc];
      }
      if (i3 == 0) {
        for (int e = tid; e < 1024; e += 256) {
          int pos = e >> 4, i = e & 15;
          float inv = powf(10000.f, -(float)i * (1.f / 16.f));
          float ang = (float)pos * inv;
          p.ROPE[2 * e] = cosf(ang); p.ROPE[2 * e + 1] = sinf(ang);
        }
      }
      __syncthreads();
    }
  }
}

__device__ void phase_norm(const Params& p, int layer, int pass) {
  const int lane = opq_tid() & 63;
  const int gw = opq_bid() * 4 + (opq_tid() >> 6), nw = gridDim.x * 4;
  const int b0 = pass * NB;
  for (int row = gw; row < NT; row += nw) {
    const float* src; int mrow;
    if (row < NTL) { src = (layer == 0 ? p.x : p.out) + ((size_t)b0 * SEQ + row) * D; mrow = b0 + row / SEQ; }
    else { src = (layer == 0 ? p.ctx : p.CTX1) + ((size_t)b0 * CTXL + (row - NTL)) * D; mrow = 4; }
    const float* mod = p.MOD + ((size_t)layer * 5 + mrow) * 3072;
    float4 v[4]; float ss = 0.f;
    const bool from_parts = (layer == 1 && row >= NTL);
    if (from_parts) src = p.ctx + ((size_t)b0 * CTXL + (row - NTL)) * D;
#pragma unroll
    for (int i = 0; i < 4; ++i) {
      v[i] = *(const float4*)(src + (i * 64 + lane) * 4);
      if (from_parts) {
        int k = (i * 64 + lane) * 4;
        float4 a = {0.f, 0.f, 0.f, 0.f};
#pragma unroll
        for (int ks = 0; ks < 4; ++ks) {
          float4 q = *(const float4*)(p.PART + ((size_t)ks * NTC + (row - NTL)) * D + k);
          a.x += q.x; a.y += q.y; a.z += q.z; a.w += q.w;
        }
        float4 gt = *(const float4*)(p.MOD + ((size_t)0 * 5 + 4) * 3072 + 2048 + k);
        v[i].x += gt.x * a.x; v[i].y += gt.y * a.y; v[i].z += gt.z * a.z; v[i].w += gt.w * a.w;
      }
      ss += v[i].x * v[i].x + v[i].y * v[i].y + v[i].z * v[i].z + v[i].w * v[i].w;
    }
    ss = wave_sum(ss);
    float rstd = rsqrtf(ss * (1.f / D) + EPS);
#pragma unroll
    for (int i = 0; i < 4; ++i) {
      int k = (i * 64 + lane) * 4;
      float4 nwv = *(const float4*)(p.norm_w + layer * D + k);
      float4 sh = *(const float4*)(mod + k);
      float4 scl = *(const float4*)(mod + 1024 + k);
      bf16x4 o;
      o[0] = (short)f2bf(v[i].x * rstd * nwv.x * (1.f + scl.x) + sh.x);
      o[1] = (short)f2bf(v[i].y * rstd * nwv.y * (1.f + scl.y) + sh.y);
      o[2] = (short)f2bf(v[i].z * rstd * nwv.z * (1.f + scl.z) + sh.z);
      o[3] = (short)f2bf(v[i].w * rstd * nwv.w * (1.f + scl.w) + sh.w);
      *(bf16x4*)(p.H + (size_t)row * D + k) = o;
    }
  }
}

__device__ __forceinline__ void epi_store(const Params& p, int mode, int layer, int pass, int m, int n, float v) {
  if (mode == 0) {
    if (n < 1024) p.PZ[(size_t)m * 1024 + n] = f2bf(v);
    else if (n < 2560) p.PXBC[(size_t)m * 1536 + (n - 1024)] = f2bf(v);
    else if (n < 4608) p.PSC[(size_t)m * 2048 + (n - 2560)] = f2bf(v);
    else if (n < 5888) p.PATT[(size_t)m * 1280 + (n - 4608)] = f2bf(v);
    else if (n < 5920) p.DTRAW[(size_t)m * 32 + (n - 5888)] = v;
  } else {
    const int b0 = pass * NB;
    if (m < NTL) {
      int b = b0 + m / SEQ;
      float g = p.MOD[((size_t)layer * 5 + b) * 3072 + 2048 + n];
      size_t idx = ((size_t)b0 * SEQ + m) * D + n;
      float xo = (layer == 0) ? p.x[idx] : p.out[idx];
      p.out[idx] = xo + g * v;
    } else {
      float g = p.MOD[((size_t)layer * 5 + 4) * 3072 + 2048 + n];
      size_t idx = ((size_t)b0 * CTXL + (m - NTL)) * D + n;
      p.CTX1[idx] = p.ctx[idx] + g * v;
    }
  }
}

__device__ void phase_gemm_naive(const Params& p, int mode, int layer, int pass, float* smem) {
  const int M = (mode == 0) ? NT : (layer == 0 ? NT : NTL);
  const int N = (mode == 0) ? NWIN : 1024;
  const int K = (mode == 0) ? 1024 : 2048;
  const bf16_t* A = (mode == 0) ? p.H : p.Y;
  const bf16_t* Bt = (mode == 0) ? p.WinT + (size_t)layer * NWIN * 1024 : p.WoutT + (size_t)layer * 1024 * 2048;
  const int tm = M / 64, tn = N / 64;
  const int tid = opq_tid(), tx = tid & 15, ty = tid >> 4;
  float* As = smem;
  float* Bs = smem + 16 * 68;
  for (int t = opq_bid(); t < tm * tn; t += gridDim.x) {
    int m0 = (t / tn) * 64, n0 = (t % tn) * 64;
    float acc[4][4];
#pragma unroll
    for (int i = 0; i < 4; ++i)
#pragma unroll
      for (int j = 0; j < 4; ++j) acc[i][j] = 0.f;
    int lr = tid >> 2, kq = (tid & 3) * 4;
    for (int k0 = 0; k0 < K; k0 += 16) {
      bf16x4 av = *(const bf16x4*)(A + (size_t)(m0 + lr) * K + k0 + kq);
      bf16x4 bv = *(const bf16x4*)(Bt + (size_t)(n0 + lr) * K + k0 + kq);
#pragma unroll
      for (int j = 0; j < 4; ++j) {
        As[(kq + j) * 68 + lr] = bf2f((bf16_t)av[j]);
        Bs[(kq + j) * 68 + lr] = bf2f((bf16_t)bv[j]);
      }
      __syncthreads();
#pragma unroll
      for (int kk = 0; kk < 16; ++kk) {
        float4 a4 = *(const float4*)(As + kk * 68 + ty * 4);
        float4 b4 = *(const float4*)(Bs + kk * 68 + tx * 4);
        float a[4] = {a4.x, a4.y, a4.z, a4.w}, b[4] = {b4.x, b4.y, b4.z, b4.w};
#pragma unroll
        for (int i = 0; i < 4; ++i)
#pragma unroll
          for (int j = 0; j < 4; ++j) acc[i][j] += a[i] * b[j];
      }
      __syncthreads();
    }
#pragma unroll
    for (int i = 0; i < 4; ++i)
#pragma unroll
      for (int j = 0; j < 4; ++j) epi_store(p, mode, layer, pass, m0 + ty * 4 + i, n0 + tx * 4 + j, acc[i][j]);
  }
}

__device__ void phase_gemm_mfma(const Params& p, int mode, int layer, int pass, bf16_t* smem) {
  const bool do_split = (mode == 1 && layer == 0);
  const bool ctx_sparse = (mode == 0 && layer == 1);
  const int M = (mode == 0 && !ctx_sparse) ? NT : NTL;
  const int N = (mode == 0) ? NWIN : 1024;
  const int K = (mode == 0) ? 1024 : 2048;
  const bf16_t* A = (mode == 0) ? p.H : p.Y;
  const bf16_t* Bt = (mode == 0) ? p.WinT + (size_t)layer * NWIN * 1024 : p.WoutT + (size_t)layer * 1024 * 2048;
  const int tm = M / 128, tn = N / 128, T_main = tm * tn, T = T_main + (ctx_sparse ? 60 : 0);
  const int tid = opq_tid(), lane = tid & 63, wid = tid >> 6, wm = wid >> 1, wn = wid & 1;
  const int lr = lane & 31, lh = lane >> 5;
  bf16_t* As = smem;
  bf16_t* Bs = smem + 128 * 72;
  float* rsS = (float*)(smem + 2 * 128 * 72);
  const int bid = opq_bid();
  int tstart = 0, tend = T, lb = bid, nbx = gridDim.x;
  if ((gridDim.x & 7) == 0) {
    int xcd = bid & 7; lb = bid >> 3; nbx = gridDim.x >> 3;
    tstart = (int)((long)T * xcd / 8); tend = (int)((long)T * (xcd + 1) / 8);
  }
  const int ng_full = tn / 8, rem = tn % 8, per_group = tm * 8;
  const int nk = K / 64;
  const int sr = tid >> 3, sc = (tid & 7) * 8;
  const int b0 = pass * NB;
  auto tile = [&](const int mi, const int ni, auto split_tag, const int ks) __attribute__((always_inline)) {
    constexpr bool SPLIT = decltype(split_tag)::value;
    const int kt0 = SPLIT ? ks * 8 : 0;
    const int kt1 = SPLIT ? kt0 + 8 : nk;
    const int m0 = mi * 128, n0 = ni * 128;
    f32x16 acc[2][2];
#pragma unroll
    for (int i = 0; i < 2; ++i)
#pragma unroll
      for (int j = 0; j < 2; ++j)
#pragma unroll
        for (int r = 0; r < 16; ++r) acc[i][j][r] = 0.f;
    const bf16_t* ga = A + (size_t)(m0 + sr) * K + sc + kt0 * 64;
    const bf16_t* gb = Bt + (size_t)(n0 + sr) * K + sc + kt0 * 64;
    bf16x8 ra[4], rb[4];
#pragma unroll
    for (int i = 0; i < 4; ++i) { ra[i] = *(const bf16x8*)(ga + (size_t)i * 32 * K); rb[i] = *(const bf16x8*)(gb + (size_t)i * 32 * K); }
    if (mode == 1) {
      int row = m0 + (tid >> 1), grp = tid & 1;
      const float* sp = p.SSQ + (size_t)row * 16 + grp * 8;
      f32x4 s0 = *(const f32x4*)sp, s1 = *(const f32x4*)(sp + 4);
      float ss = s0[0] + s0[1] + s0[2] + s0[3] + s1[0] + s1[1] + s1[2] + s1[3];
      rsS[tid] = rsqrtf(ss * (1.f / 512.f) + EPS);
    }
    if (mode == 1 && !SPLIT) {
      bf16x8 ra2[4], rb2[4];
#pragma unroll
      for (int i = 0; i < 4; ++i) {
        ra2[i] = *(const bf16x8*)(ga + (size_t)i * 32 * K + 64);
        rb2[i] = *(const bf16x8*)(gb + (size_t)i * 32 * K + 64);
      }
      auto mma4 = [&]() __attribute__((always_inline)) {
#pragma unroll
        for (int kk = 0; kk < 4; ++kk) {
          bf16x8 a0 = *(const bf16x8*)(As + (wm * 64 + lr) * 72 + kk * 16 + lh * 8);
          bf16x8 a1 = *(const bf16x8*)(As + (wm * 64 + 32 + lr) * 72 + kk * 16 + lh * 8);
          bf16x8 b0v = *(const bf16x8*)(Bs + (wn * 64 + lr) * 72 + kk * 16 + lh * 8);
          bf16x8 b1v = *(const bf16x8*)(Bs + (wn * 64 + 32 + lr) * 72 + kk * 16 + lh * 8);
          acc[0][0] = __builtin_amdgcn_mfma_f32_32x32x16_bf16(a0, b0v, acc[0][0], 0, 0, 0);
          acc[0][1] = __builtin_amdgcn_mfma_f32_32x32x16_bf16(a0, b1v, acc[0][1], 0, 0, 0);
          acc[1][0] = __builtin_amdgcn_mfma_f32_32x32x16_bf16(a1, b0v, acc[1][0], 0, 0, 0);
          acc[1][1] = __builtin_amdgcn_mfma_f32_32x32x16_bf16(a1, b1v, acc[1][1], 0, 0, 0);
        }
      };
      for (int kt = 0; kt < 32; kt += 2) {
        __syncthreads();
#pragma unroll
        for (int i = 0; i < 4; ++i) {
          *(bf16x8*)(As + (sr + i * 32) * 72 + sc) = ra[i];
          *(bf16x8*)(Bs + (sr + i * 32) * 72 + sc) = rb[i];
        }
        __syncthreads();
        if (kt + 2 < 32) {
#pragma unroll
          for (int i = 0; i < 4; ++i) {
            ra[i] = *(const bf16x8*)(ga + (size_t)i * 32 * K + (kt + 2) * 64);
            rb[i] = *(const bf16x8*)(gb + (size_t)i * 32 * K + (kt + 2) * 64);
          }
        }
        mma4();
        __syncthreads();
#pragma unroll
        for (int i = 0; i < 4; ++i) {
          *(bf16x8*)(As + (sr + i * 32) * 72 + sc) = ra2[i];
          *(bf16x8*)(Bs + (sr + i * 32) * 72 + sc) = rb2[i];
        }
        __syncthreads();
        if (kt + 3 < 32) {
#pragma unroll
          for (int i = 0; i < 4; ++i) {
            ra2[i] = *(const bf16x8*)(ga + (size_t)i * 32 * K + (kt + 3) * 64);
            rb2[i] = *(const bf16x8*)(gb + (size_t)i * 32 * K + (kt + 3) * 64);
          }
        }
        mma4();
        if (kt == 6 || kt == 14) {
#pragma unroll
          for (int i = 0; i < 2; ++i)
#pragma unroll
            for (int r = 0; r < 16; ++r) {
              int lrow = wm * 64 + i * 32 + (r & 3) + 8 * (r >> 2) + 4 * lh;
              float r0 = rsS[lrow * 2], r1 = rsS[lrow * 2 + 1];
              float f = (kt == 6) ? r0 * __builtin_amdgcn_rcpf(r1) : r1;
              acc[i][0][r] *= f; acc[i][1][r] *= f;
            }
        }
      }
    } else
    for (int kt = kt0; kt < kt1; ++kt) {
      __syncthreads();
#pragma unroll
      for (int i = 0; i < 4; ++i) {
        *(bf16x8*)(As + (sr + i * 32) * 72 + sc) = ra[i];
        *(bf16x8*)(Bs + (sr + i * 32) * 72 + sc) = rb[i];
      }
      __syncthreads();
      if (kt + 1 < kt1) {
#pragma unroll
        for (int i = 0; i < 4; ++i) {
          ra[i] = *(const bf16x8*)(ga + (size_t)i * 32 * K + (kt + 1 - kt0) * 64);
          rb[i] = *(const bf16x8*)(gb + (size_t)i * 32 * K + (kt + 1 - kt0) * 64);
        }
      }
#pragma unroll
      for (int kk = 0; kk < 4; ++kk) {
        bf16x8 a0 = *(const bf16x8*)(As + (wm * 64 + lr) * 72 + kk * 16 + lh * 8);
        bf16x8 a1 = *(const bf16x8*)(As + (wm * 64 + 32 + lr) * 72 + kk * 16 + lh * 8);
        bf16x8 b0v = *(const bf16x8*)(Bs + (wn * 64 + lr) * 72 + kk * 16 + lh * 8);
        bf16x8 b1v = *(const bf16x8*)(Bs + (wn * 64 + 32 + lr) * 72 + kk * 16 + lh * 8);
        acc[0][0] = __builtin_amdgcn_mfma_f32_32x32x16_bf16(a0, b0v, acc[0][0], 0, 0, 0);
        acc[0][1] = __builtin_amdgcn_mfma_f32_32x32x16_bf16(a0, b1v, acc[0][1], 0, 0, 0);
        acc[1][0] = __builtin_amdgcn_mfma_f32_32x32x16_bf16(a1, b0v, acc[1][0], 0, 0, 0);
        acc[1][1] = __builtin_amdgcn_mfma_f32_32x32x16_bf16(a1, b1v, acc[1][1], 0, 0, 0);
      }
      if (mode == 1 && !SPLIT && (kt == 7 || kt == 15)) {
#pragma unroll
        for (int i = 0; i < 2; ++i)
#pragma unroll
          for (int r = 0; r < 16; ++r) {
            int lrow = wm * 64 + i * 32 + (r & 3) + 8 * (r >> 2) + 4 * lh;
            float r0 = rsS[lrow * 2], r1 = rsS[lrow * 2 + 1];
            float f = (kt == 7) ? r0 * __builtin_amdgcn_rcpf(r1) : r1;
            acc[i][0][r] *= f; acc[i][1][r] *= f;
          }
      }
    }
    if (mode == 0) {
      if (ni < 46) {
        bf16_t* dst; int ld, cb;
        if (ni < 8) { dst = p.PZ; ld = 1024; cb = ni * 128; }
        else if (ni < 20) { dst = p.PXBC; ld = 1536; cb = (ni - 8) * 128; }
        else if (ni < 36) { dst = p.PSC; ld = 2048; cb = (ni - 20) * 128; }
        else { dst = p.PATT; ld = 1280; cb = (ni - 36) * 128; }
#pragma unroll
        for (int i = 0; i < 2; ++i)
#pragma unroll
          for (int j = 0; j < 2; ++j)
#pragma unroll
            for (int r = 0; r < 16; ++r) {
              int row = m0 + wm * 64 + i * 32 + (r & 3) + 8 * (r >> 2) + 4 * lh;
              int col = cb + wn * 64 + j * 32 + lr;
              dst[(size_t)row * ld + col] = f2bf(acc[i][j][r]);
            }
      } else if (wn == 0) {
#pragma unroll
        for (int i = 0; i < 2; ++i)
#pragma unroll
          for (int r = 0; r < 16; ++r) {
            int row = m0 + wm * 64 + i * 32 + (r & 3) + 8 * (r >> 2) + 4 * lh;
            p.DTRAW[(size_t)row * 32 + lr] = acc[i][0][r];
          }
      }
    } else if (!SPLIT) {
      float* Os = (float*)smem;
      const int ocol4 = (tid & 31) * 4, orow = tid >> 5;
      const int b = b0 + m0 / SEQ;
      const float4 g4 = *(const float4*)(p.MOD + ((size_t)layer * 5 + b) * 3072 + 2048 + n0 + ocol4);
      __syncthreads();
#pragma unroll
      for (int half = 0; half < 2; ++half) {
        if (wm == half) {
#pragma unroll
          for (int i = 0; i < 2; ++i)
#pragma unroll
            for (int j = 0; j < 2; ++j)
#pragma unroll
              for (int r = 0; r < 16; ++r)
                Os[(i * 32 + (r & 3) + 8 * (r >> 2) + 4 * lh) * 132 + wn * 64 + j * 32 + lr] = acc[i][j][r];
        }
        __syncthreads();
#pragma unroll 4
        for (int k = 0; k < 8; ++k) {
          int row = orow + 8 * k;
          float4 v = *(const float4*)(Os + row * 132 + ocol4);
          size_t idx = ((size_t)b0 * SEQ + m0 + half * 64 + row) * D + n0 + ocol4;
          float4 x4 = (layer == 0) ? *(const float4*)(p.x + idx) : *(const float4*)(p.out + idx);
          float4 o = {x4.x + g4.x * v.x, x4.y + g4.y * v.y, x4.z + g4.z * v.z, x4.w + g4.w * v.w};
          *(float4*)(p.out + idx) = o;
        }
        __syncthreads();
      }
    } else {
#pragma unroll
      for (int i = 0; i < 2; ++i)
#pragma unroll
        for (int j = 0; j < 2; ++j)
#pragma unroll
          for (int r = 0; r < 16; ++r) {
            int row = m0 + wm * 64 + i * 32 + (r & 3) + 8 * (r >> 2) + 4 * lh;
            int col = n0 + wn * 64 + j * 32 + lr;
            int lrow = row - m0;
            float f = (ks < 2) ? rsS[lrow * 2 + ks] : 1.f;
            p.PART[((size_t)ks * NTC + (row - NTL)) * D + col] = acc[i][j][r] * f;
          }
    }
  };
  for (int t = tstart + lb; t < tend; t += nbx) {
    int mi, ni;
    if (t >= T_main) { int e = t - T_main, j = e % 15; mi = 64 + e / 15; ni = (j < 12) ? 8 + j : ((j < 14) ? 28 + j : 46); }
    else if (t < ng_full * per_group) { int ng = t / per_group, r = t % per_group; mi = r >> 3; ni = ng * 8 + (r & 7); }
    else { int r = t - ng_full * per_group; mi = r / rem; ni = ng_full * 8 + r % rem; }
    tile(mi, ni, std::integral_constant<bool, false>{}, -1);
  }
  if (do_split) {
    for (int s = bid; s < 128; s += gridDim.x) {
      int ct = s >> 2, ks = s & 3;
      tile(64 + (ct >> 3), ct & 7, std::integral_constant<bool, true>{}, ks);
    }
  }
}

__device__ void phase_gemm_in256(const Params& p, int layer, int pass, bf16_t* smem) {
  constexpr int K = 1024, nk = 16;
  const bf16_t* A = p.H;
  const bf16_t* Bt = p.WinT + (size_t)layer * NWIN * 1024;
  const bool ctx_sparse = (layer == 1);
  const int tm = (ctx_sparse ? NTL : NT) / 256, tn = NWIN / 128, T_main = tm * tn, T = T_main + (ctx_sparse ? 30 : 0);
  const int tid = opq_tid(), lane = tid & 63, wid = tid >> 6, wm = wid >> 1, wn = wid & 1;
  const int lr = lane & 31, lh = lane >> 5;
  bf16_t* As = smem;
  bf16_t* Bs = smem + 256 * 72;
  const int bid = opq_bid();
  int tstart = 0, tend = T, lb = bid, nbx = gridDim.x;
  if ((gridDim.x & 7) == 0) {
    int xcd = bid & 7; lb = bid >> 3; nbx = gridDim.x >> 3;
    tstart = (int)((long)T * xcd / 8); tend = (int)((long)T * (xcd + 1) / 8);
  }
  const int ng_full = tn / 8, rem = tn % 8, per_group = tm * 8;
  const int sr = tid >> 3, sc = (tid & 7) * 8;
  for (int t = tstart + lb; t < tend; t += nbx) {
    int mi, ni;
    if (t >= T_main) { int e = t - T_main, j = e % 15; mi = 32 + e / 15; ni = (j < 12) ? 8 + j : ((j < 14) ? 28 + j : 46); }
    else if (t < ng_full * per_group) { int ng = t / per_group, r = t % per_group; mi = r >> 3; ni = ng * 8 + (r & 7); }
    else { int r = t - ng_full * per_group; mi = r / rem; ni = ng_full * 8 + r % rem; }
    const int m0 = mi * 256, n0 = ni * 128;
    f32x16 acc[4][2];
#pragma unroll
    for (int i = 0; i < 4; ++i)
#pragma unroll
      for (int j = 0; j < 2; ++j)
#pragma unroll
        for (int r = 0; r < 16; ++r) acc[i][j][r] = 0.f;
    const bf16_t* ga = A + (size_t)(m0 + sr) * K + sc;
    const bf16_t* gb = Bt + (size_t)(n0 + sr) * K + sc;
    bf16x8 ra[8], rb[4];
#pragma unroll
    for (int i = 0; i < 8; ++i) ra[i] = *(const bf16x8*)(ga + (size_t)i * 32 * K);
#pragma unroll
    for (int i = 0; i < 4; ++i) rb[i] = *(const bf16x8*)(gb + (size_t)i * 32 * K);
    for (int kt = 0; kt < nk; ++kt) {
      __syncthreads();
#pragma unroll
      for (int i = 0; i < 8; ++i) *(bf16x8*)(As + (sr + i * 32) * 72 + sc) = ra[i];
#pragma unroll
      for (int i = 0; i < 4; ++i) *(bf16x8*)(Bs + (sr + i * 32) * 72 + sc) = rb[i];
      __syncthreads();
      if (kt + 1 < nk) {
#pragma unroll
        for (int i = 0; i < 8; ++i) ra[i] = *(const bf16x8*)(ga + (size_t)i * 32 * K + (kt + 1) * 64);
#pragma unroll
        for (int i = 0; i < 4; ++i) rb[i] = *(const bf16x8*)(gb + (size_t)i * 32 * K + (kt + 1) * 64);
      }
#pragma unroll
      for (int kk = 0; kk < 4; ++kk) {
        bf16x8 b0v = *(const bf16x8*)(Bs + (wn * 64 + lr) * 72 + kk * 16 + lh * 8);
        bf16x8 b1v = *(const bf16x8*)(Bs + (wn * 64 + 32 + lr) * 72 + kk * 16 + lh * 8);
#pragma unroll
        for (int i = 0; i < 4; ++i) {
          bf16x8 av = *(const bf16x8*)(As + (wm * 128 + i * 32 + lr) * 72 + kk * 16 + lh * 8);
          acc[i][0] = __builtin_amdgcn_mfma_f32_32x32x16_bf16(av, b0v, acc[i][0], 0, 0, 0);
          acc[i][1] = __builtin_amdgcn_mfma_f32_32x32x16_bf16(av, b1v, acc[i][1], 0, 0, 0);
        }
      }
    }
    if (ni < 46) {
      bf16_t* dst; int ld, cb;
      if (ni < 8) { dst = p.PZ; ld = 1024; cb = ni * 128; }
      else if (ni < 20) { dst = p.PXBC; ld = 1536; cb = (ni - 8) * 128; }
      else if (ni < 36) { dst = p.PSC; ld = 2048; cb = (ni - 20) * 128; }
      else { dst = p.PATT; ld = 1280; cb = (ni - 36) * 128; }
      bf16_t* Os = smem;
      __syncthreads();
#pragma unroll
      for (int half = 0; half < 2; ++half) {
        if (wm == half) {
          bf16_t* q = Os + (4 * lh) * 136 + wn * 64 + lr;
#pragma unroll
          for (int i = 0; i < 4; ++i)
#pragma unroll
            for (int j = 0; j < 2; ++j)
#pragma unroll
              for (int r = 0; r < 16; ++r) q[(i * 32 + (r & 3) + 8 * (r >> 2)) * 136 + j * 32] = f2bf(acc[i][j][r]);
        }
        __syncthreads();
        {
          const int orow = tid >> 4, ocol = (tid & 15) * 8;
          bf16_t* gd = dst + (size_t)(m0 + half * 128 + orow) * ld + cb + ocol;
#pragma unroll
          for (int k = 0; k < 8; ++k) {
            bf16x8 v = *(const bf16x8*)(Os + (orow + 16 * k) * 136 + ocol);
            *(bf16x8*)(gd + (size_t)(16 * k) * ld) = v;
          }
        }
        __syncthreads();
      }
    } else if (wn == 0) {
#pragma unroll
      for (int i = 0; i < 4; ++i)
#pragma unroll
        for (int r = 0; r < 16; ++r) {
          int row = m0 + wm * 128 + i * 32 + (r & 3) + 8 * (r >> 2) + 4 * lh;
          p.DTRAW[(size_t)row * 32 + lr] = acc[i][0][r];
        }
    }
  }
}

__device__ void phase_prep(const Params& p, int layer, int pass, float* smem) {
  const int tid = opq_tid(), lane = tid & 63;
  const int gw = opq_bid() * 4 + (tid >> 6), nw = gridDim.x * 4;
  for (int gc = opq_bid(); gc < NCH; gc += gridDim.x) {
    float* sda = smem; float* sdt = smem + 4224;
    for (int e = tid; e < 4096; e += 256) {
      int l = e >> 5, dh = e & 31;
      float raw = p.DTRAW[((size_t)gc * 128 + l) * 32 + dh] + p.ssd_dt_bias[layer * 32 + dh];
      float dt = raw > 20.f ? raw : log1pf(expf(raw));
      float A = -expf(p.ssd_a_log[layer * 32 + dh]);
      sdt[l * 33 + dh] = dt;
      sda[l * 33 + dh] = dt * A;
    }
    __syncthreads();
    {
      const int dh = tid & 31, seg = tid >> 5;
      float* segtot = smem + 8448;
      float loc[16]; float s = 0.f;
      if (dh < 16) {
#pragma unroll
        for (int j = 0; j < 16; ++j) { s += sda[(seg * 16 + j) * 33 + dh]; loc[j] = s; }
      } else {
#pragma unroll
        for (int j = 15; j >= 0; --j) { s += sda[(seg * 16 + j) * 33 + dh]; loc[j] = s; }
      }
      segtot[seg * 32 + dh] = s;
      __syncthreads();
      float off = 0.f;
      if (dh < 16) { for (int k = 0; k < seg; ++k) off += segtot[k * 32 + dh]; }
      else { for (int k = 7; k > seg; --k) off += segtot[k * 32 + dh]; }
#pragma unroll
      for (int j = 0; j < 16; ++j) sda[(seg * 16 + j) * 33 + dh] = loc[j] + off;
    }
    __syncthreads();
    for (int e = tid; e < 4096; e += 256) {
      int dh = e >> 7, l = e & 127;
      float cum = sda[l * 33 + dh], dt = sdt[l * 33 + dh];
      float tot = (dh < 16) ? sda[127 * 33 + dh] : sda[dh];
      size_t idx = ((size_t)gc * 32 + dh) * 128 + l;
      p.CUMT[idx] = cum;
      p.VV[idx] = cum - logf(fmaxf(dt, 1e-30f));
      p.EC[idx] = expf(cum);
      p.WW[idx] = dt * expf(tot - cum);
    }
    __syncthreads();
  }
  const int nchc = (layer == 0) ? NCH : 64;
  const int Nb = NCH * 4 * 24, Nc = nchc * 16, Nd = (NT * 40) / 64, Ne = NCH * 16 * 2;
  for (int uu = gw; uu < Nb + Nc + Nd + Ne; uu += nw) {
  if (uu < Nb) {
    const int u = uu;
    int cblk = u % 24, l32 = (u / 24) & 3, gc = u / (24 * 4);
    int c = cblk * 64 + lane;
    bool first, last;
    if (gc < 64) { first = (gc % 32 == 0) && l32 == 0; last = (gc % 32 == 31) && l32 == 3; }
    else { first = ((gc - 64) % 2 == 0) && l32 == 0; last = ((gc - 64) % 2 == 1) && l32 == 3; }
    int t0 = gc * 128 + l32 * 32;
    float w0 = p.ssd_conv_w[((size_t)layer * 3 + 0) * 1536 + c], w1 = p.ssd_conv_w[((size_t)layer * 3 + 1) * 1536 + c],
          w2 = p.ssd_conv_w[((size_t)layer * 3 + 2) * 1536 + c], bs = p.ssd_conv_b[layer * 1536 + c];
    bf16_t raw[34];
#pragma unroll
    for (int i = 0; i < 34; ++i) {
      bool ok = !((i == 0 && first) || (i == 33 && last));
      raw[i] = ok ? p.PXBC[(size_t)(t0 + i - 1) * 1536 + c] : (bf16_t)0;
    }
    bf16x8 o[4];
#pragma unroll
    for (int j = 0; j < 32; ++j)
      o[j >> 3][j & 7] = (short)f2bf(silu_f(w0 * bf2f(raw[j]) + w1 * bf2f(raw[j + 1]) + w2 * bf2f(raw[j + 2]) + bs));
    if (c < 1024) {
#pragma unroll
      for (int k = 0; k < 4; ++k) *(bf16x8*)(p.XT + ((size_t)gc * 1024 + c) * 128 + l32 * 32 + k * 8) = o[k];
    } else if (c < 1280) {
      int n = c - 1024;
#pragma unroll
      for (int k = 0; k < 4; ++k) *(bf16x8*)(p.BT + ((size_t)gc * 256 + n) * 128 + l32 * 32 + k * 8) = o[k];
#pragma unroll
      for (int j = 0; j < 32; ++j) p.BR[(size_t)(t0 + j) * 256 + n] = (bf16_t)o[j >> 3][j & 7];
    } else {
      int n = c - 1280;
#pragma unroll
      for (int j = 0; j < 32; ++j) p.CR[(size_t)(t0 + j) * 256 + n] = (bf16_t)o[j >> 3][j & 7];
    }
  } else if (uu < Nb + Nc) {
    {
      const int u = uu - Nb;
      const int l8 = u & 15, gc = u >> 4;
      const int c0 = lane * 8;
      bool first, last;
      if (gc < 64) { first = (gc % 32 == 0) && l8 == 0; last = (gc % 32 == 31) && l8 == 15; }
      else { first = ((gc - 64) % 2 == 0) && l8 == 0; last = ((gc - 64) % 2 == 1) && l8 == 15; }
      const int t0 = gc * 128 + l8 * 8;
      float w0[8], w1[8], w2[8];
      {
        const float* wp = p.sc_conv_w + (size_t)layer * 3 * 512 + c0;
        f32x4 a0 = *(const f32x4*)wp, a1 = *(const f32x4*)(wp + 4);
        f32x4 b0 = *(const f32x4*)(wp + 512), b1 = *(const f32x4*)(wp + 516);
        f32x4 d0 = *(const f32x4*)(wp + 1024), d1 = *(const f32x4*)(wp + 1028);
#pragma unroll
        for (int k = 0; k < 4; ++k) { w0[k] = a0[k]; w0[4 + k] = a1[k]; w1[k] = b0[k]; w1[4 + k] = b1[k]; w2[k] = d0[k]; w2[4 + k] = d1[k]; }
      }
      float up[10][8];
#pragma unroll
      for (int i = 0; i < 10; ++i) {
        bool ok = !((i == 0 && first) || (i == 9 && last));
        const bf16_t* r = p.PSC + (size_t)(t0 + i - 1) * 2048 + c0;
        bf16x8 v8 = ok ? *(const bf16x8*)r : bf16x8{0, 0, 0, 0, 0, 0, 0, 0};
        bf16x8 g8 = ok ? *(const bf16x8*)(r + 512) : bf16x8{0, 0, 0, 0, 0, 0, 0, 0};
#pragma unroll
        for (int k = 0; k < 8; ++k) up[i][k] = bf2f((bf16_t)v8[k]) * bf2f((bf16_t)g8[k]);
      }
#pragma unroll
      for (int j = 0; j < 8; ++j) {
        const bf16_t* r = p.PSC + (size_t)(t0 + j) * 2048 + c0;
        bf16x8 b8 = *(const bf16x8*)(r + 1024), z8 = *(const bf16x8*)(r + 1536);
        f32x4 lo, hi;
#pragma unroll
        for (int k = 0; k < 8; ++k) {
          float cv = w0[k] * up[j][k] + w1[k] * up[j + 1][k] + w2[k] * up[j + 2][k];
          float o = bf2f((bf16_t)b8[k]) * cv * silu_f(bf2f((bf16_t)z8[k]));
          if (k < 4) lo[k] = o; else hi[k - 4] = o;
        }
        *(bf16x8*)(p.Y + (size_t)(t0 + j) * 2048 + 1024 + c0) = pack8(lo, hi);
      }
    }
  } else if (uu < Nb + Nc + Nd) {
    {
      const int idx = (uu - Nb - Nc) * 64 + lane;
      int row = idx / 40, r = idx % 40;
      int slot = r >> 2, a = (r >> 1) & 1, i0 = (r & 1) * 8;
      const bf16_t* src = p.PATT + (size_t)row * 1280 + (slot < 8 ? slot * 64 : 512 + (slot - 8) * 64) + a * 32 + i0;
      bf16x8 x1 = *(const bf16x8*)src, x2 = *(const bf16x8*)(src + 16);
      bf16x8 o1, o2;
      if (row < NTL) {
        int t = row & (SEQ - 1);
        int pos = (a == 0) ? (t >> 6) : (t & 63);
        const float* tb = p.ROPE + (pos * 16 + i0) * 2;
#pragma unroll
        for (int j = 0; j < 8; ++j) {
          float cs = tb[2 * j], sn = tb[2 * j + 1];
          float a1 = bf2f((bf16_t)x1[j]), a2 = bf2f((bf16_t)x2[j]);
          o1[j] = (short)f2bf(a1 * cs - a2 * sn);
          o2[j] = (short)f2bf(a1 * sn + a2 * cs);
        }
      } else { o1 = x1; o2 = x2; }
      bf16_t* dst = (slot < 8) ? p.QR + (size_t)row * 512 + slot * 64 + a * 32 + i0
                               : p.KR + (size_t)row * 128 + (slot - 8) * 64 + a * 32 + i0;
      *(bf16x8*)dst = o1; *(bf16x8*)(dst + 16) = o2;
    }
  } else {
    const int u = uu - Nb - Nc - Nd;
    int half = u & 1, l8 = (u >> 1) & 15, gc = u >> 5;
    int c = half * 64 + lane;
    int t0 = gc * 128 + l8 * 8;
    bf16x8 o;
#pragma unroll
    for (int j = 0; j < 8; ++j) o[j] = (short)p.PATT[(size_t)(t0 + j) * 1280 + 640 + c];
    *(bf16x8*)(p.VT + ((size_t)gc * 128 + c) * 128 + l8 * 8) = o;
  }
  }
}

__device__ void phase_attn_naive(const Params& p, int layer, int pass) {
  const int lane = opq_tid() & 63;
  const int gw = opq_bid() * 4 + (opq_tid() >> 6), nw = gridDim.x * 4;
  const int nrows = (layer == 0) ? NT : NTL;
  for (int u = gw; u < nrows * 8; u += nw) {
    int h = u & 7, row = u >> 3, kvh = h >> 2;
    float q = bf2f(p.QR[(size_t)row * 512 + h * 64 + lane]);
    float m = p.attn_sink[layer * 8 + h], l = 1.f, o = 0.f;
    int bl, k0 = 0, k1 = 0;
    if (row < NTL) {
      bl = row / SEQ; int t = row % SEQ;
      int lo = t - 128 < 0 ? 0 : t - 128, hi = t + 128 > SEQ - 1 ? SEQ - 1 : t + 128;
      k0 = bl * SEQ + lo; k1 = bl * SEQ + hi + 1;
    } else bl = (row - NTL) / CTXL;
    int nband = k1 - k0;
    for (int kk = 0; kk < nband + CTXL; ++kk) {
      int kr = (kk < nband) ? k0 + kk : NTL + bl * CTXL + (kk - nband);
      float kv = bf2f(p.KR[(size_t)kr * 128 + kvh * 64 + lane]);
      float vv = bf2f(p.VT[((size_t)(kr >> 7) * 128 + kvh * 64 + lane) * 128 + (kr & 127)]);
      float s = wave_sum(q * kv) * 0.125f;
      float mn = fmaxf(m, s);
      float corr = expf(m - mn), pe = expf(s - mn);
      l = l * corr + pe; o = o * corr + pe * vv; m = mn;
    }
    float z = bf2f(p.PATT[(size_t)row * 1280 + 768 + h * 64 + lane]);
    p.Y[(size_t)row * 2048 + 1536 + h * 64 + lane] = f2bf(o / l * silu_f(z));
  }
}

__device__ void phase_attn(const Params& p, int layer, int pass, bf16_t* smem) {
  const int tid = opq_tid(), lane = tid & 63, wid = tid >> 6, lr = lane & 31, lh = lane >> 5;
  const int nqt = ((layer == 0) ? NT : NTL) / 32;
  const int srow = tid >> 3, scol = (tid & 7) * 8;
  for (int u = (opq_bid() + (int)gridDim.x - 64) % (int)gridDim.x; u < nqt * 2; u += gridDim.x) {
    const int kvh = u & 1, qt = u >> 1, h = kvh * 4 + wid;
    const int q0 = qt * 32;
    int bl, nband = 0, tb0 = 0, t0 = 0;
    if (q0 < NTL) {
      bl = q0 >> 12; t0 = q0 & 4095;
      tb0 = (t0 - 128 < 0) ? 0 : ((t0 - 128) >> 6);
      int tb1 = (t0 + 159) >> 6; if (tb1 > 63) tb1 = 63;
      nband = tb1 - tb0 + 1;
    } else bl = (q0 - NTL) >> 8;
    const int ntile = nband + 4;
    bf16x8 qf[4];
    {
      const bf16_t* qp = p.QR + (size_t)(q0 + lr) * 512 + h * 64 + lh * 8;
#pragma unroll
      for (int kk = 0; kk < 4; ++kk) qf[kk] = *(const bf16x8*)(qp + kk * 16);
    }
    float m = p.attn_sink[layer * 8 + h], l = 1.f;
    f32x16 o[2];
#pragma unroll
    for (int r = 0; r < 16; ++r) { o[0][r] = 0.f; o[1][r] = 0.f; }
    const int qpos = t0 + lr;
    bf16x8 rk[2], rv[2];
    auto fetch = [&](int ti) __attribute__((always_inline)) {
      const int kr0 = (ti < nband) ? bl * 4096 + (tb0 + ti) * 64 : NTL + bl * 256 + (ti - nband) * 64;
      const bf16_t* kp = p.KR + (size_t)(kr0 + srow) * 128 + kvh * 64 + scol;
      const bf16_t* vp = p.VT + ((size_t)(kr0 >> 7) * 128 + kvh * 64 + srow) * 128 + (kr0 & 127) + scol;
      rk[0] = *(const bf16x8*)kp; rk[1] = *(const bf16x8*)(kp + 32 * 128);
      rv[0] = *(const bf16x8*)vp; rv[1] = *(const bf16x8*)(vp + 32 * 128);
    };
    auto stash = [&](bf16_t* buf) __attribute__((always_inline)) {
      *(bf16x8*)(buf + srow * 72 + scol) = rk[0];
      *(bf16x8*)(buf + (srow + 32) * 72 + scol) = rk[1];
      *(bf16x8*)(buf + 4608 + srow * 72 + scol) = rv[0];
      *(bf16x8*)(buf + 4608 + (srow + 32) * 72 + scol) = rv[1];
    };
    fetch(0);
    __syncthreads();
    stash(smem);
    if (1 < ntile) fetch(1);
    __syncthreads();
    for (int ti = 0; ti < ntile; ++ti) {
      const bf16_t* Kc = smem + (ti & 1) * 9216;
      const bf16_t* Vc = Kc + 4608;
      if (ti + 1 < ntile) {
        stash(smem + ((ti + 1) & 1) * 9216);
        if (ti + 2 < ntile) fetch(ti + 2);
      }
      f32x16 st[2];
#pragma unroll
      for (int r = 0; r < 16; ++r) { st[0][r] = 0.f; st[1][r] = 0.f; }
#pragma unroll
      for (int kk = 0; kk < 4; ++kk) {
        bf16x8 kf0 = *(const bf16x8*)(Kc + lr * 72 + kk * 16 + lh * 8);
        bf16x8 kf1 = *(const bf16x8*)(Kc + (32 + lr) * 72 + kk * 16 + lh * 8);
        st[0] = __builtin_amdgcn_mfma_f32_32x32x16_bf16(kf0, qf[kk], st[0], 0, 0, 0);
        st[1] = __builtin_amdgcn_mfma_f32_32x32x16_bf16(kf1, qf[kk], st[1], 0, 0, 0);
      }
      float mx = -3.0e38f;
      const bool band = ti < nband;
      const int kbase = (tb0 + ti) * 64 + 4 * lh;
#pragma unroll
      for (int hh = 0; hh < 2; ++hh)
#pragma unroll
        for (int r = 0; r < 16; ++r) {
          float s = st[hh][r] * 0.125f;
          if (band) {
            int dd = qpos - (kbase + hh * 32 + (r & 3) + 8 * (r >> 2));
            if (dd > 128 || dd < -128) s = -1e30f;
          }
          st[hh][r] = s; mx = fmaxf(mx, s);
        }
      mx = fmaxf(mx, __shfl_xor(mx, 32));
      const float mn = fmaxf(m, mx);
      const float corr = __expf(m - mn);
      m = mn;
      float ls = 0.f;
#pragma unroll
      for (int hh = 0; hh < 2; ++hh)
#pragma unroll
        for (int r = 0; r < 16; ++r) { st[hh][r] = __expf(st[hh][r] - mn); ls += st[hh][r]; }
      ls += __shfl_xor(ls, 32);
      l = l * corr + ls;
#pragma unroll
      for (int r = 0; r < 16; ++r) { o[0][r] *= corr; o[1][r] *= corr; }
#pragma unroll
      for (int hh = 0; hh < 2; ++hh)
#pragma unroll
        for (int s2 = 0; s2 < 2; ++s2) {
          f32x4 pa = {st[hh][8 * s2 + 0], st[hh][8 * s2 + 1], st[hh][8 * s2 + 2], st[hh][8 * s2 + 3]};
          f32x4 pb = {st[hh][8 * s2 + 4], st[hh][8 * s2 + 5], st[hh][8 * s2 + 6], st[hh][8 * s2 + 7]};
          bf16x8 pf = pack8(pa, pb);
#pragma unroll
          for (int mt = 0; mt < 2; ++mt) {
            const bf16_t* vp = Vc + (mt * 32 + lr) * 72 + hh * 32 + 16 * s2 + 4 * lh;
            bf16x4 x0 = *(const bf16x4*)vp, x1 = *(const bf16x4*)(vp + 8);
            bf16x8 vfr = {x0[0], x0[1], x0[2], x0[3], x1[0], x1[1], x1[2], x1[3]};
            o[mt] = __builtin_amdgcn_mfma_f32_32x32x16_bf16(vfr, pf, o[mt], 0, 0, 0);
          }
        }
      __syncthreads();
    }
    const float inv = 1.f / l;
    {
      bf16_t* Zw = smem + 2 * 9216 + wid * (32 * 72);
      const int er = lane >> 3, ec = (lane & 7) * 8;
      const bf16_t* zg = p.PATT + (size_t)(q0 + er) * 1280 + 768 + h * 64 + ec;
      bf16x8 zr[4];
#pragma unroll
      for (int i = 0; i < 4; ++i) zr[i] = *(const bf16x8*)(zg + (size_t)i * 8 * 1280);
#pragma unroll
      for (int i = 0; i < 4; ++i) *(bf16x8*)(Zw + (er + 8 * i) * 72 + ec) = zr[i];
#pragma unroll
      for (int mt = 0; mt < 2; ++mt)
#pragma unroll
        for (int qq = 0; qq < 4; ++qq) {
          int d0 = mt * 32 + 8 * qq + 4 * lh;
          bf16x4 z4 = *(const bf16x4*)(Zw + lr * 72 + d0);
          bf16x4 o4;
#pragma unroll
          for (int t = 0; t < 4; ++t) o4[t] = (short)f2bf(o[mt][qq * 4 + t] * inv * silu_f(bf2f((bf16_t)z4[t])));
          *(bf16x4*)(Zw + lr * 72 + d0) = o4;
        }
      bf16_t* yg = p.Y + (size_t)(q0 + er) * 2048 + 1536 + h * 64 + ec;
#pragma unroll
      for (int i = 0; i < 4; ++i) *(bf16x8*)(yg + (size_t)i * 8 * 2048) = *(const bf16x8*)(Zw + (er + 8 * i) * 72 + ec);
    }
  }
}

__device__ void phase_s1(const Params& p, int layer, int pass, bf16_t* smem) {
  const int tid = opq_tid(), lane = tid & 63, nt = tid >> 6, lr = lane & 31, lh = lane >> 5;
  constexpr int RS = 136;
  bf16_t* Xs = smem;
  bf16_t* Bts = smem + 64 * RS;
  float* Ws = (float*)(smem + 192 * RS);
  const int srow = tid >> 4, scol = (tid & 15) * 8;
  for (int u = opq_bid(); u < NCH * 16; u += gridDim.x) {
    const int h = u & 15, gc = u >> 4, g = h >> 3;
    bf16x8 rx[4], rb[8];
    {
      const bf16_t* Xg = p.XT + ((size_t)gc * 1024 + h * 64 + srow) * 128 + scol;
#pragma unroll
      for (int i = 0; i < 4; ++i) rx[i] = *(const bf16x8*)(Xg + i * 2048);
      const bf16_t* Bg = p.BT + ((size_t)gc * 256 + g * 128 + srow) * 128 + scol;
#pragma unroll
      for (int i = 0; i < 8; ++i) rb[i] = *(const bf16x8*)(Bg + i * 2048);
    }
    const float wv = p.WW[((size_t)gc * 32 + (tid >> 7) * 16 + h) * 128 + (tid & 127)];
    __syncthreads();
#pragma unroll
    for (int i = 0; i < 4; ++i) *(bf16x8*)(Xs + (srow + 16 * i) * RS + scol) = rx[i];
#pragma unroll
    for (int i = 0; i < 8; ++i) *(bf16x8*)(Bts + (srow + 16 * i) * RS + scol) = rb[i];
    Ws[tid] = wv;
    __syncthreads();
#pragma unroll 1
    for (int d = 0; d < 2; ++d) {
      f32x16 acc0, acc1;
#pragma unroll
      for (int r = 0; r < 16; ++r) { acc0[r] = 0.f; acc1[r] = 0.f; }
#pragma unroll
      for (int kk = 0; kk < 8; ++kk) {
        bf16x8 bfr = *(const bf16x8*)(Bts + (nt * 32 + lr) * RS + kk * 16 + lh * 8);
        bf16x8 x0 = *(const bf16x8*)(Xs + lr * RS + kk * 16 + lh * 8);
        bf16x8 x1 = *(const bf16x8*)(Xs + (32 + lr) * RS + kk * 16 + lh * 8);
        f32x4 wa = *(const f32x4*)(Ws + d * 128 + kk * 16 + lh * 8), wb = *(const f32x4*)(Ws + d * 128 + kk * 16 + lh * 8 + 4);
        f32x4 a0, a1, c0, c1;
#pragma unroll
        for (int j = 0; j < 4; ++j) {
          a0[j] = bf2f((bf16_t)x0[j]) * wa[j]; a1[j] = bf2f((bf16_t)x0[4 + j]) * wb[j];
          c0[j] = bf2f((bf16_t)x1[j]) * wa[j]; c1[j] = bf2f((bf16_t)x1[4 + j]) * wb[j];
        }
        acc0 = __builtin_amdgcn_mfma_f32_32x32x16_bf16(pack8(a0, a1), bfr, acc0, 0, 0, 0);
        acc1 = __builtin_amdgcn_mfma_f32_32x32x16_bf16(pack8(c0, c1), bfr, acc1, 0, 0, 0);
      }
      float* dst = p.LST + ((((size_t)gc * 16 + h) * 2 + d) * 64) * 128 + nt * 32 + lr;
#pragma unroll
      for (int r = 0; r < 16; ++r) {
        int pp = (r & 3) + 8 * (r >> 2) + 4 * lh;
        dst[(size_t)pp * 128] = acc0[r];
        dst[(size_t)(32 + pp) * 128] = acc1[r];
      }
    }
  }
}

__device__ __forceinline__ int scan_chunk(int ci, int bl, int d) {
  if (ci < 2) return 64 + bl * 2 + (d == 0 ? ci : 1 - ci);
  int cc = ci - 2;
  return bl * 32 + (d == 0 ? cc : 31 - cc);
}
__device__ void phase_s2(const Params& p, int layer, int pass) {
  const int nth = gridDim.x * 256;
  for (int e = opq_bid() * 256 + opq_tid(); e < 64 * 2048; e += nth) {
    int seq = e >> 11, q = e & 2047, pp = q >> 5, n4 = (q & 31) * 4;
    int d = seq & 1, h = (seq >> 1) & 15, bl = seq >> 5;
    f32x4 s = {0.f, 0.f, 0.f, 0.f};
    const size_t eoff = ((size_t)h * 2 + d) * 8192 + (size_t)pp * 128 + n4;
    const int toff = (d == 0) ? h * 128 + 127 : (16 + h) * 128;
#pragma unroll
    for (int half = 0; half < 2; ++half) {
      f32x4 loc[17]; float tot[17];
#pragma unroll
      for (int i = 0; i < 17; ++i) {
        int gc = scan_chunk(half * 17 + i, bl, d);
        loc[i] = *(const f32x4*)(p.LST + (size_t)gc * 262144 + eoff);
        tot[i] = p.CUMT[(size_t)gc * 4096 + toff];
      }
#pragma unroll
      for (int i = 0; i < 17; ++i) {
        int gc = scan_chunk(half * 17 + i, bl, d);
        uint2 o; o.x = pk2(s[0], s[1]); o.y = pk2(s[2], s[3]);
        *(uint2*)(p.SIN + (size_t)gc * 262144 + eoff) = o;
        float dec = expf(tot[i]);
        s = s * dec + loc[i];
      }
    }
  }
}

__device__ void phase_s3(const Params& p, int layer, int pass, bf16_t* smem) {
  const int tid = opq_tid(), lane = tid & 63, w = tid >> 6, lr = lane & 31, lh = lane >> 5;
  const int nch = (layer == 0) ? NCH : 64;
  constexpr int RS = 136;
  bf16_t* Ss = smem;
  bf16_t* Bs = smem;
  bf16_t* Xs = smem + 128 * RS;
  float* Vs = (float*)(smem + 192 * RS);
  bf16_t* Zs = smem + 192 * RS + 1536;
  bf16_t* Os = smem;
  const int srow = tid >> 4, scol = (tid & 15) * 8;
  for (int u = opq_bid(); u < nch * 16; u += gridDim.x) {
    const int h = u & 15, gc = u >> 4, g = h >> 3;
    const int i_own = 32 * w + lr;
    bf16x8 rs[8];
    {
      const bf16_t* Sg = p.SIN + ((size_t)gc * 16 + h) * 16384 + srow * 128 + scol;
#pragma unroll
      for (int i = 0; i < 8; ++i) rs[i] = *(const bf16x8*)(Sg + i * 2048);
    }
    bf16x8 cf[8];
    {
      const bf16_t* crow = p.CR + ((size_t)gc * 128 + i_own) * 256 + g * 128 + lh * 8;
#pragma unroll
      for (int kk = 0; kk < 8; ++kk) cf[kk] = *(const bf16x8*)(crow + kk * 16);
    }
    bf16x8 rz[4];
    {
      const bf16_t* Zg = p.PZ + ((size_t)gc * 128 + (tid >> 3)) * 1024 + h * 64 + (tid & 7) * 8;
#pragma unroll
      for (int i = 0; i < 4; ++i) rz[i] = *(const bf16x8*)(Zg + (size_t)i * 32 * 1024);
    }
    const size_t vidx = ((size_t)gc * 32 + (tid >> 7) * 16 + h) * 128 + (tid & 127);
    const float v_vv = p.VV[vidx], v_ec = p.EC[vidx], v_cu = p.CUMT[vidx];
    __syncthreads();
#pragma unroll
    for (int i = 0; i < 8; ++i) *(bf16x8*)(Ss + (srow + 16 * i) * RS + scol) = rs[i];
    Vs[tid] = v_vv; Vs[256 + tid] = v_ec; Vs[512 + tid] = v_cu;
#pragma unroll
    for (int i = 0; i < 4; ++i) *(bf16x8*)(Zs + ((tid >> 3) + 32 * i) * 72 + (tid & 7) * 8) = rz[i];
    bf16x8 rb[8], rx[4];
    {
      const bf16_t* Bg = p.BR + ((size_t)gc * 128 + srow) * 256 + g * 128 + scol;
#pragma unroll
      for (int i = 0; i < 8; ++i) rb[i] = *(const bf16x8*)(Bg + i * 16 * 256);
      const bf16_t* Xg = p.XT + ((size_t)gc * 1024 + h * 64 + srow) * 128 + scol;
#pragma unroll
      for (int i = 0; i < 4; ++i) rx[i] = *(const bf16x8*)(Xg + i * 2048);
    }
    __syncthreads();
    f32x16 y[2];
#pragma unroll
    for (int r = 0; r < 16; ++r) { y[0][r] = 0.f; y[1][r] = 0.f; }
#pragma unroll
    for (int d = 0; d < 2; ++d) {
      const float* ec = Vs + 256 + d * 128 + 32 * w + 4 * lh;
#pragma unroll
      for (int pt = 0; pt < 2; ++pt) {
        f32x16 tmp;
#pragma unroll
        for (int r = 0; r < 16; ++r) tmp[r] = 0.f;
        const bf16_t* sl = Ss + (d * 64 + pt * 32 + lr) * RS + lh * 8;
#pragma unroll
        for (int kk = 0; kk < 8; ++kk) {
          bf16x8 sf = *(const bf16x8*)(sl + kk * 16);
          tmp = __builtin_amdgcn_mfma_f32_32x32x16_bf16(cf[kk], sf, tmp, 0, 0, 0);
        }
#pragma unroll
        for (int q = 0; q < 4; ++q) {
          f32x4 e4 = *(const f32x4*)(ec + 8 * q);
#pragma unroll
          for (int t = 0; t < 4; ++t) y[pt][q * 4 + t] += tmp[q * 4 + t] * e4[t];
        }
      }
    }
    __syncthreads();
#pragma unroll
    for (int i = 0; i < 8; ++i) *(bf16x8*)(Bs + (srow + 16 * i) * RS + scol) = rb[i];
#pragma unroll
    for (int i = 0; i < 4; ++i) *(bf16x8*)(Xs + (srow + 16 * i) * RS + scol) = rx[i];
    __syncthreads();
    const float cum_f = Vs[512 + i_own];
    const float cum_b = Vs[512 + 128 + i_own];
#pragma unroll 1
    for (int jt = 0; jt < 4; ++jt) {
      f32x16 cb;
#pragma unroll
      for (int r = 0; r < 16; ++r) cb[r] = 0.f;
      const bf16_t* bl_ = Bs + (jt * 32 + lr) * RS + lh * 8;
#pragma unroll
      for (int kk = 0; kk < 8; ++kk) {
        bf16x8 bfr = *(const bf16x8*)(bl_ + kk * 16);
        cb = __builtin_amdgcn_mfma_f32_32x32x16_bf16(bfr, cf[kk], cb, 0, 0, 0);
      }
      bf16x8 xb[2][2];
#pragma unroll
      for (int s = 0; s < 2; ++s)
#pragma unroll
        for (int pt = 0; pt < 2; ++pt) {
          const bf16_t* xp = Xs + (pt * 32 + lr) * RS + jt * 32 + 16 * s + 4 * lh;
          bf16x4 x0 = *(const bf16x4*)xp, x1 = *(const bf16x4*)(xp + 8);
          bf16x8 t8 = {x0[0], x0[1], x0[2], x0[3], x1[0], x1[1], x1[2], x1[3]};
          xb[s][pt] = t8;
        }
#pragma unroll
      for (int d = 0; d < 2; ++d) {
        bool need = (d == 0) ? (jt <= w) : (jt >= w);
        if (!need) continue;
        const float* vv = Vs + d * 128 + jt * 32 + 4 * lh;
        const float ci = (d == 0) ? cum_f : cum_b;
        f32x16 gq;
#pragma unroll
        for (int q = 0; q < 4; ++q) {
          f32x4 v4 = *(const f32x4*)(vv + 8 * q);
#pragma unroll
          for (int t = 0; t < 4; ++t) {
            int j = jt * 32 + 8 * q + 4 * lh + t;
            float val = cb[q * 4 + t] * __expf(ci - v4[t]);
            bool ok = (jt != w) || ((d == 0) ? (j <= i_own) : (j >= i_own));
            gq[q * 4 + t] = ok ? val : 0.f;
          }
        }
#pragma unroll
        for (int s = 0; s < 2; ++s) {
          f32x4 ga = {gq[8 * s + 0], gq[8 * s + 1], gq[8 * s + 2], gq[8 * s + 3]};
          f32x4 gb = {gq[8 * s + 4], gq[8 * s + 5], gq[8 * s + 6], gq[8 * s + 7]};
          bf16x8 afr = pack8(ga, gb);
          y[0] = __builtin_amdgcn_mfma_f32_32x32x16_bf16(afr, xb[s][0], y[0], 0, 0, 0);
          y[1] = __builtin_amdgcn_mfma_f32_32x32x16_bf16(afr, xb[s][1], y[1], 0, 0, 0);
        }
      }
    }
    const float Dh = p.ssd_d[layer * 16 + h];
    float ssq[16];
#pragma unroll
    for (int r = 0; r < 16; ++r) ssq[r] = 0.f;
    __syncthreads();
#pragma unroll
    for (int pt = 0; pt < 2; ++pt)
#pragma unroll
      for (int q = 0; q < 4; ++q) {
        bf16x4 x4 = *(const bf16x4*)(Xs + (pt * 32 + lr) * RS + 32 * w + 8 * q + 4 * lh);
#pragma unroll
        for (int t = 0; t < 4; ++t) {
          int li = 32 * w + 8 * q + 4 * lh + t;
          float yv = y[pt][q * 4 + t] + Dh * bf2f((bf16_t)x4[t]);
          float z = bf2f(Zs[li * 72 + pt * 32 + lr]);
          float gv = yv * silu_f(z);
          ssq[q * 4 + t] += gv * gv;
          Os[li * 72 + pt * 32 + lr] = f2bf(gv);
        }
      }
    __syncthreads();
    {
      bf16_t* Yg = p.Y + ((size_t)gc * 128 + (tid >> 3)) * 2048 + h * 64 + (tid & 7) * 8;
#pragma unroll
      for (int i = 0; i < 4; ++i)
        *(bf16x8*)(Yg + (size_t)i * 32 * 2048) = *(const bf16x8*)(Os + ((tid >> 3) + 32 * i) * 72 + (tid & 7) * 8);
    }
#pragma unroll
    for (int r = 0; r < 16; ++r) {
      float v = ssq[r];
      v += __shfl_xor(v, 1); v += __shfl_xor(v, 2); v += __shfl_xor(v, 4); v += __shfl_xor(v, 8); v += __shfl_xor(v, 16);
      ssq[r] = v;
    }
    if (lr == 0) {
#pragma unroll
      for (int r = 0; r < 16; ++r) {
        int row = gc * 128 + 32 * w + (r & 3) + 8 * (r >> 2) + 4 * lh;
        p.SSQ[(size_t)row * 16 + h] = ssq[r];
      }
    }
  }
}

__device__ void phase_final(const Params& p) {
  const int lane = opq_tid() & 63;
  const int gw = opq_bid() * 4 + (opq_tid() >> 6), nw = gridDim.x * 4;
  float4 w[4];
#pragma unroll
  for (int i = 0; i < 4; ++i) w[i] = *(const float4*)(p.final_norm_w + (i * 64 + lane) * 4);
  for (int row0 = gw; row0 < 4 * SEQ; row0 += 4 * nw) {
    float4 v[4][4];
#pragma unroll
    for (int q = 0; q < 4; ++q) {
      const int row = row0 + q * nw;
      if (row < 4 * SEQ) {
        const float* src = p.out + (size_t)row * D;
#pragma unroll
        for (int i = 0; i < 4; ++i) v[q][i] = *(const float4*)(src + (i * 64 + lane) * 4);
      }
    }
#pragma unroll
    for (int q = 0; q < 4; ++q) {
      const int row = row0 + q * nw;
      if (row < 4 * SEQ) {
        float ss = 0.f;
#pragma unroll
        for (int i = 0; i < 4; ++i) ss += v[q][i].x * v[q][i].x + v[q][i].y * v[q][i].y + v[q][i].z * v[q][i].z + v[q][i].w * v[q][i].w;
        ss = wave_sum(ss);
        const float rstd = rsqrtf(ss * (1.f / D) + EPS);
        float* dst = p.out + (size_t)row * D;
#pragma unroll
        for (int i = 0; i < 4; ++i) {
          float4 o = {v[q][i].x * rstd * w[i].x, v[q][i].y * rstd * w[i].y, v[q][i].z * rstd * w[i].z, v[q][i].w * rstd * w[i].w};
          *(float4*)(dst + (i * 64 + lane) * 4) = o;
        }
      }
    }
  }
}

#ifndef REP_W
#define REP_W 1
#endif
#ifndef REP_GOUT0
#define REP_GOUT0 1
#endif
#ifndef REP_NORM
#define REP_NORM 1
#endif
#ifndef REP_GIN
#define REP_GIN 1
#endif
#ifndef REP_PREP
#define REP_PREP 1
#endif
#ifndef REP_S1
#define REP_S1 1
#endif
#ifndef REP_ATTN
#define REP_ATTN 1
#endif
#ifndef REP_S3
#define REP_S3 1
#endif
__global__ void __launch_bounds__(256, 2) mega(Params p, int lo, int hi) {
  __shared__ __attribute__((aligned(16))) float smem[18432];
  __shared__ uint4 xb_words;
  if (threadIdx.x == 0) xb_words = make_uint4(0u, 0u, 0u, 0u);
  __syncthreads();
  XcdBarrier xb = xcd_barrier_post(p.bar, (volatile LAS unsigned*)&xb_words);
  if (lo < 0) cg::this_grid().sync();
  for (int step = lo; step < hi; ++step) {
    if (step == 0) { for (int rp = 0; rp < REP_W; ++rp) phase_weights(p, smem); }
    else if (step == NSTEP - 1) phase_final(p);
    else {
      int s = step - 1;
      int pass = s / 14, r = s % 14, layer = r / 7, ph = r % 7;
      switch (ph) {
        case ST_NORM: for (int rp = 0; rp < REP_NORM; ++rp) phase_norm(p, layer, pass); break;
        case ST_GIN: for (int rp = 0; rp < REP_GIN; ++rp) phase_gemm_in256(p, layer, pass, (bf16_t*)smem); break;
        case ST_PREP: for (int rp = 0; rp < REP_PREP; ++rp) phase_prep(p, layer, pass, smem); break;
        case ST_MIX:
          for (int rp = 0; rp < REP_S1; ++rp) phase_s1(p, layer, pass, (bf16_t*)smem);
          for (int rp = 0; rp < REP_ATTN; ++rp) phase_attn(p, layer, pass, (bf16_t*)smem);
          break;
        case ST_S2: phase_s2(p, layer, pass); break;
        case ST_S3: for (int rp = 0; rp < REP_S3; ++rp) phase_s3(p, layer, pass, (bf16_t*)smem); break;
        case ST_GOUT: for (int rp = 0; rp < (layer == 0 ? REP_GOUT0 : 1); ++rp) phase_gemm_mfma(p, 1, layer, pass, (bf16_t*)smem); break;
      }
    }
    if (step + 1 < hi) xcd_barrier(xb);
  }
}

extern "C" void kernel_launch(void* const* d_in, const int* in_sizes, int n_in, void* d_out, int out_size, void* d_ws,
                              size_t ws_size, hipStream_t stream) {
  Params p{};
  p.x = (const float*)d_in[0]; p.c = (const float*)d_in[1]; p.ctx = (const float*)d_in[2]; p.c_ctx = (const float*)d_in[3];
  p.norm_w = (const float*)d_in[4]; p.w_mod = (const float*)d_in[5]; p.b_mod = (const float*)d_in[6];
  p.w_in = (const float*)d_in[7]; p.ssd_conv_w = (const float*)d_in[8]; p.ssd_conv_b = (const float*)d_in[9];
  p.ssd_dt_bias = (const float*)d_in[10]; p.ssd_a_log = (const float*)d_in[11]; p.ssd_d = (const float*)d_in[12];
  p.ssd_norm_w = (const float*)d_in[13]; p.sc_conv_w = (const float*)d_in[14]; p.attn_sink = (const float*)d_in[15];
  p.w_out = (const float*)d_in[16]; p.final_norm_w = (const float*)d_in[17];
  p.out = (float*)d_out;
  char* w = (char*)d_ws; size_t off = 0;
  auto take = [&](size_t bytes) { char* r = w + off; off += (bytes + 255) & ~(size_t)255; return r; };
  p.WinT = (bf16_t*)take((size_t)2 * NWIN * 1024 * 2);
  p.WoutT = (bf16_t*)take((size_t)2 * 1024 * 2048 * 2);
  p.MOD = (float*)take((size_t)2 * 5 * 3072 * 4);
  p.CTX1 = (float*)take((size_t)4 * CTXL * D * 4);
  p.ROPE = (float*)take((size_t)64 * 16 * 2 * 4);
  char* big = take((size_t)NT * (1024 + 1536 + 2048) * 2);
  p.H = (bf16_t*)big;
  p.PXBC = (bf16_t*)(big + (size_t)NT * 1024 * 2);
  p.PSC = (bf16_t*)(big + (size_t)NT * (1024 + 1536) * 2);
  p.LST = (float*)big;
  p.PART = (float*)(big + (size_t)24 * 1024 * 1024);
  p.PZ = (bf16_t*)take((size_t)NT * 1024 * 2);
  p.PATT = (bf16_t*)take((size_t)NT * 1280 * 2);
  p.QR = (bf16_t*)take((size_t)NT * 512 * 2);
  p.KR = (bf16_t*)take((size_t)NT * 128 * 2);
  p.VT = (bf16_t*)take((size_t)NT * 128 * 2);
  p.SIN = p.PATT;
  p.DTRAW = (float*)take((size_t)NT * 32 * 4);
  p.CUMT = (float*)take((size_t)NT * 32 * 4);
  p.VV = (float*)take((size_t)NT * 32 * 4);
  p.EC = (float*)take((size_t)NT * 32 * 4);
  p.WW = (float*)take((size_t)NT * 32 * 4);
  p.SSQ = (float*)take((size_t)NT * 16 * 4);
  p.XT = (bf16_t*)take((size_t)NT * 1024 * 2);
  p.BR = (bf16_t*)take((size_t)NT * 256 * 2);
  p.CR = (bf16_t*)take((size_t)NT * 256 * 2);
  p.BT = (bf16_t*)take((size_t)NT * 256 * 2);
  p.Y = (bf16_t*)take((size_t)NT * 2048 * 2);
  p.bar = (unsigned*)take((size_t)XCD_BAR_WORDS * 4);
  if (off > ws_size) { fprintf(stderr, "workspace too small: need %zu have %zu\n", off, ws_size); return; }
  static int grid_blocks = 0;
  if (!grid_blocks) {
    int dev = 0, cus = 0, per_cu = 0;
    hipGetDevice(&dev);
    hipDeviceGetAttribute(&cus, hipDeviceAttributeMultiprocessorCount, dev);
    hipOccupancyMaxActiveBlocksPerMultiprocessor(&per_cu, mega, 256, 0);
    if (per_cu > 2) per_cu = 2;
    if (per_cu < 1) per_cu = 1;
    grid_blocks = cus * per_cu;
  }
  hipMemsetAsync(p.bar, 0, (size_t)XCD_BAR_WORDS * 4, stream);
  int lo = 0, hi = NSTEP;
  void* args[] = {&p, &lo, &hi};
  hipError_t e = hipLaunchCooperativeKernel((void*)mega, dim3(grid_blocks), dim3(256), args, 0, stream);
  if (e != hipSuccess) fprintf(stderr, "cooperative launch failed: %s (grid %d)\n", hipGetErrorString(e), grid_blocks);
}
```

```cpp
#include <hip/hip_runtime.h>
#include <hip/hip_cooperative_groups.h>
#include <cstdio>
#include <type_traits>
namespace cg = cooperative_groups;

typedef unsigned short bf16_t;
typedef __attribute__((ext_vector_type(8))) short bf16x8;
typedef __attribute__((ext_vector_type(4))) short bf16x4;
typedef __attribute__((ext_vector_type(4))) float f32x4;
typedef __attribute__((ext_vector_type(16))) float f32x16;

constexpr int D = 1024, SEQ = 4096, CTXL = 256;
constexpr int NB = 2;
constexpr int NPASS = 2;
constexpr int NTL = NB * SEQ;
constexpr int NTC = NB * CTXL;
constexpr int NT = NTL + NTC;
constexpr int NCH = NT / 128;
constexpr int NWIN = 6016;
constexpr float EPS = 1e-6f;

constexpr int ST_NORM = 0, ST_GIN = 1, ST_PREP = 2, ST_MIX = 3, ST_S2 = 4, ST_S3 = 5, ST_GOUT = 6;
constexpr int NSTEP = 1 + NPASS * 2 * 7 + 1;

struct Params {
  const float *x, *c, *ctx, *c_ctx, *norm_w, *w_mod, *b_mod, *w_in, *ssd_conv_w, *ssd_conv_b, *ssd_dt_bias,
      *ssd_a_log, *ssd_d, *ssd_norm_w, *sc_conv_w, *attn_sink, *w_out, *final_norm_w;
  float* out;
  bf16_t *WinT, *WoutT, *H, *PXBC, *PSC, *PZ, *PATT, *XT, *BR, *CR, *BT, *QR, *KR, *VT, *Y, *SIN;
  float *MOD, *CTX1, *DTRAW, *CUMT, *VV, *EC, *WW, *SSQ, *LST, *ROPE, *PART;
  unsigned* bar;
};

__device__ __forceinline__ int opq_tid() { int t = threadIdx.x; asm volatile("" : "+v"(t)); return t; }
__device__ __forceinline__ int opq_bid() { int b = blockIdx.x; asm volatile("" : "+s"(b)); return b; }
typedef __attribute__((ext_vector_type(2))) __bf16 bfv2;
typedef __attribute__((ext_vector_type(2))) float f32x2;
typedef __attribute__((ext_vector_type(4))) unsigned u32x4;
__device__ __forceinline__ unsigned pk2(float a, float b) {
  f32x2 v = {a, b};
  bfv2 r = __builtin_convertvector(v, bfv2);
  return *(unsigned*)&r;
}
__device__ __forceinline__ bf16_t f2bf(float f) { return (bf16_t)(pk2(f, 0.f) & 0xffffu); }
__device__ __forceinline__ bf16x8 pack8(f32x4 a, f32x4 b) {
  u32x4 u = {pk2(a[0], a[1]), pk2(a[2], a[3]), pk2(b[0], b[1]), pk2(b[2], b[3])};
  return *(bf16x8*)&u;
}
__device__ __forceinline__ float bf2f(bf16_t h) { return __uint_as_float(((unsigned)h) << 16); }
__device__ __forceinline__ float silu_f(float v) { return v * __builtin_amdgcn_rcpf(1.f + __expf(-v)); }
__device__ __forceinline__ float wave_sum(float v) {
#pragma unroll
  for (int o = 32; o > 0; o >>= 1) v += __shfl_xor(v, o);
  return v;
}

#define XB_TMO      128
#define XB_XCNT(j)  (256  + 64 * (j))
#define XB_XSUB(j)  (1280 + 64 * (j))
#define XB_XGEN(j)  (2304 + 64 * (j))
#define XB_TOP      3328
#define XB_TOPGEN   3392
#define XCD_BAR_WORDS 3456
#define XB_SPIN_CAP (1u << 18)
#define LAS __attribute__((address_space(3)))

__device__ __forceinline__ unsigned xb_ld(unsigned* p)              { return __hip_atomic_load(p, __ATOMIC_RELAXED, __HIP_MEMORY_SCOPE_AGENT); }
__device__ __forceinline__ unsigned xb_add(unsigned* p, unsigned v) { return __hip_atomic_fetch_add(p, v, __ATOMIC_RELAXED, __HIP_MEMORY_SCOPE_AGENT); }
__device__ __forceinline__ unsigned xb_xcc_id() { return (unsigned)__builtin_amdgcn_s_getreg((3 << 11) | 20) & 0xFu; }
#define XB_SPIN(cond, bar) do { unsigned _sp = 0; while (cond) { __builtin_amdgcn_s_sleep(1); \
    if ((++_sp & 255u) == 0u) { if (xb_ld(&(bar)[XB_TMO])) break; if (_sp > XB_SPIN_CAP) { atomicAdd(&(bar)[XB_TMO], 1u); break; } } } } while (0)

struct XcdBarrier {
    unsigned* bar; unsigned x;
    volatile LAS unsigned* st;
};

__device__ __forceinline__ XcdBarrier xcd_barrier_post(unsigned* bar, volatile LAS unsigned* st) {
    XcdBarrier b; b.bar = bar; b.x = xb_xcc_id(); b.st = st;
    if (threadIdx.x == 0) (void)xb_add(&bar[XB_XCNT(b.x)], 1u);
    return b;
}
__device__ __forceinline__ void xcd_barrier_complete(unsigned* bar, unsigned x, unsigned& nloc, unsigned& nx) {
    const unsigned G = gridDim.x * gridDim.y * gridDim.z;
    unsigned sum, cnt, mine, sp = 0u;
    for (;;) {
        sum = 0u; cnt = 0u; mine = 0u;
#pragma unroll
        for (unsigned j = 0; j < 16; ++j) { const unsigned c = xb_ld(&bar[XB_XCNT(j)]); sum += c; cnt += (c > 0u) ? 1u : 0u; mine = (j == x) ? c : mine; }
        if (sum == G) break;
        __builtin_amdgcn_s_sleep(1);
        if ((++sp & 255u) == 0u) { if (xb_ld(&bar[XB_TMO])) break; if (sp > XB_SPIN_CAP) { atomicAdd(&bar[XB_TMO], 1u); break; } }
    }
    nloc = mine > 0u ? mine : 1u; nx = cnt > 0u ? cnt : 1u;
}

__device__ __forceinline__ void xcd_barrier(const XcdBarrier& b) {
    asm volatile("s_waitcnt vmcnt(0)" ::: "memory");
    __syncthreads();
    if (threadIdx.x == 0) {
        unsigned* bar = b.bar;
        __builtin_amdgcn_s_waitcnt(0);
        unsigned nloc = b.st[0], nx = b.st[1];
        if (nloc == 0u) { xcd_barrier_complete(bar, b.x, nloc, nx); b.st[0] = nloc; b.st[1] = nx; }
        const unsigned old = xb_add(&bar[XB_XSUB(b.x)], 1u);
        const unsigned gen = old / nloc;
        if (old + 1u == (gen + 1u) * nloc) {
            __builtin_amdgcn_fence(__ATOMIC_RELEASE, "agent");
            asm volatile("s_waitcnt vmcnt(0)" ::: "memory");
            const unsigned og = xb_add(&bar[XB_TOP], 1u);
            const unsigned tg = og / nx;
            if (og + 1u == (tg + 1u) * nx) xb_add(&bar[XB_TOPGEN], 1u);
            else XB_SPIN(xb_ld(&bar[XB_TOPGEN]) == tg, bar);
            __builtin_amdgcn_fence(__ATOMIC_ACQUIRE, "agent");
            xb_add(&bar[XB_XGEN(b.x)], 1u);
            asm volatile("s_waitcnt vmcnt(0)" ::: "memory");
        } else {
            XB_SPIN(xb_ld(&bar[XB_XGEN(b.x)]) == gen, bar);
            __builtin_amdgcn_fence(__ATOMIC_ACQUIRE, "agent");
            asm volatile("s_waitcnt vmcnt(0)" ::: "memory");
        }
    }
    __syncthreads();
}


__device__ void phase_weights(const Params& p, float* smem) {
  const int tid = opq_tid();
  const int NW1 = 2 * 94 * 16, NW2 = 2 * 16 * 32, NM = 192;
  auto load_tile = [&](int it, float* sm) __attribute__((always_inline)) {
    float v[16];
    if (it < NW1) {
      int l = it / (94 * 16), r = it % (94 * 16), nt = r / 16, kt = r % 16;
#pragma unroll
      for (int j = 0; j < 16; ++j) {
        int e = tid + 256 * j, kk = e >> 6, nn = e & 63;
        int n = nt * 64 + nn;
        int oc = (n < 2560) ? n : (n < 5888 ? n + 32 : (n < 5920 ? n - 5888 + 2560 : -1));
        v[j] = (oc >= 0) ? p.w_in[((size_t)l * 1024 + kt * 64 + kk) * 5920 + oc] : 0.f;
      }
    } else {
      int i2 = it - NW1;
      int l = i2 / 512, r = i2 % 512, nt = r / 32, kt = r % 32;
#pragma unroll
      for (int j = 0; j < 16; ++j) {
        int e = tid + 256 * j, kk = e >> 6, nn = e & 63;
        int k = kt * 64 + kk;
        float w = p.w_out[((size_t)l * 2048 + k) * 1024 + nt * 64 + nn];
        v[j] = (k < 1024) ? w * p.ssd_norm_w[l * 1024 + k] : w;
      }
    }
#pragma unroll
    for (int j = 0; j < 16; ++j) { int e = tid + 256 * j; sm[(e >> 6) * 65 + (e & 63)] = v[j]; }
  };
  auto store_tile = [&](int it, const float* sm) __attribute__((always_inline)) {
    if (it < NW1) {
      int l = it / (94 * 16), r = it % (94 * 16), nt = r / 16, kt = r % 16;
#pragma unroll
      for (int j = 0; j < 16; ++j) {
        int e = tid + 256 * j, nn = e >> 6, kk = e & 63;
        p.WinT[((size_t)l * NWIN + nt * 64 + nn) * 1024 + kt * 64 + kk] = f2bf(sm[kk * 65 + nn]);
      }
    } else {
      int i2 = it - NW1;
      int l = i2 / 512, r = i2 % 512, nt = r / 32, kt = r % 32;
#pragma unroll
      for (int j = 0; j < 16; ++j) {
        int e = tid + 256 * j, nn = e >> 6, kk = e & 63;
        p.WoutT[((size_t)l * 1024 + nt * 64 + nn) * 2048 + kt * 64 + kk] = f2bf(sm[kk * 65 + nn]);
      }
    }
  };
  for (int it = opq_bid(); it < NW1 + NW2; it += 4 * gridDim.x) {
#pragma unroll
    for (int q = 0; q < 4; ++q) { int itq = it + q * (int)gridDim.x; if (itq < NW1 + NW2) load_tile(itq, smem + q * 4224); }
    __syncthreads();
#pragma unroll
    for (int q = 0; q < 4; ++q) { int itq = it + q * (int)gridDim.x; if (itq < NW1 + NW2) store_tile(itq, smem + q * 4224); }
    __syncthreads();
  }
  for (int it = opq_bid(); it < NW1 + NW2 + NM; it += gridDim.x) {
    if (it < NW1 + NW2) continue;
    {
      int i3 = it - NW1 - NW2;
      int l = i3 / 96, jb = i3 % 96;
      float* sc = smem;
      float* part = smem + 5120;
      for (int e = tid; e < 5120; e += 256) {
        int r = e >> 10, k = e & 1023;
        float v = (r < 4) ? p.c[r * 1024 + k] : p.c_ctx[k];
        sc[e] = silu_f(v);
      }
      __syncthreads();
      int col = tid & 31, kg = tid >> 5;
      float a0 = 0, a1 = 0, a2 = 0, a3 = 0, a4 = 0;
      const float* wp = p.w_mod + ((size_t)l * 1024 + kg * 128) * 3072 + jb * 32 + col;
      for (int k0 = 0; k0 < 128; k0 += 16) {
        float wv[16];
#pragma unroll
        for (int j = 0; j < 16; ++j) wv[j] = wp[(size_t)(k0 + j) * 3072];
#pragma unroll
        for (int j = 0; j < 16; ++j) {
          int k = kg * 128 + k0 + j;
          a0 += sc[k] * wv[j]; a1 += sc[1024 + k] * wv[j]; a2 += sc[2048 + k] * wv[j]; a3 += sc[3072 + k] * wv[j]; a4 += sc[4096 + k] * wv[j];
        }
      }
      part[(kg * 5 + 0) * 32 + col] = a0; part[(kg * 5 + 1) * 32 + col] = a1; part[(kg * 5 + 2) * 32 + col] = a2;
      part[(kg * 5 + 3) * 32 + col] = a3; part[(kg * 5 + 4) * 32 + col] = a4;
      __syncthreads();
      if (tid < 160) {
        int r = tid >> 5, cc = tid & 31;
        float s = 0.f;
#pragma unroll
        for (int g8 = 0; g8 < 8; ++g8) s += part[(g8 * 5 + r) * 32 + cc];
        p.MOD[((size_t)l * 5 + r) * 3072 + jb * 32 + cc] = s + p.b_mod[l * 3072 + jb * 32 + cc];
      }
      if (i3 == 0) {
        for (int e = tid; e < 1024; e += 256) {
          int pos = e >> 4, i = e & 15;
          float inv = powf(10000.f, -(float)i * (1.f / 16.f));
          float ang = (float)pos * inv;
          p.ROPE[2 * e] = cosf(ang); p.ROPE[2 * e + 1] = sinf(ang);
        }
      }
      __syncthreads();
    }
  }
}

__device__ void phase_norm(const Params& p, int layer, int pass) {
  const int lane = opq_tid() & 63;
  const int gw = opq_bid() * 4 + (opq_tid() >> 6), nw = gridDim.x * 4;
  const int b0 = pass * NB;
  for (int row = gw; row < NT; row += nw) {
    const float* src; int mrow;
    if (row < NTL) { src = (layer == 0 ? p.x : p.out) + ((size_t)b0 * SEQ + row) * D; mrow = b0 + row / SEQ; }
    else { src = (layer == 0 ? p.ctx : p.CTX1) + ((size_t)b0 * CTXL + (row - NTL)) * D; mrow = 4; }
    const float* mod = p.MOD + ((size_t)layer * 5 + mrow) * 3072;
    float4 v[4]; float ss = 0.f;
    const bool from_parts = (layer == 1 && row >= NTL);
    if (from_parts) src = p.ctx + ((size_t)b0 * CTXL + (row - NTL)) * D;
#pragma unroll
    for (int i = 0; i < 4; ++i) {
      v[i] = *(const float4*)(src + (i * 64 + lane) * 4);
      if (from_parts) {
        int k = (i * 64 + lane) * 4;
        float4 a = {0.f, 0.f, 0.f, 0.f};
#pragma unroll
        for (int ks = 0; ks < 4; ++ks) {
          float4 q = *(const float4*)(p.PART + ((size_t)ks * NTC + (row - NTL)) * D + k);
          a.x += q.x; a.y += q.y; a.z += q.z; a.w += q.w;
        }
        float4 gt = *(const float4*)(p.MOD + ((size_t)0 * 5 + 4) * 3072 + 2048 + k);
        v[i].x += gt.x * a.x; v[i].y += gt.y * a.y; v[i].z += gt.z * a.z; v[i].w += gt.w * a.w;
      }
      ss += v[i].x * v[i].x + v[i].y * v[i].y + v[i].z * v[i].z + v[i].w * v[i].w;
    }
    ss = wave_sum(ss);
    float rstd = rsqrtf(ss * (1.f / D) + EPS);
#pragma unroll
    for (int i = 0; i < 4; ++i) {
      int k = (i * 64 + lane) * 4;
      float4 nwv = *(const float4*)(p.norm_w + layer * D + k);
      float4 sh = *(const float4*)(mod + k);
      float4 scl = *(const float4*)(mod + 1024 + k);
      bf16x4 o;
      o[0] = (short)f2bf(v[i].x * rstd * nwv.x * (1.f + scl.x) + sh.x);
      o[1] = (short)f2bf(v[i].y * rstd * nwv.y * (1.f + scl.y) + sh.y);
      o[2] = (short)f2bf(v[i].z * rstd * nwv.z * (1.f + scl.z) + sh.z);
      o[3] = (short)f2bf(v[i].w * rstd * nwv.w * (1.f + scl.w) + sh.w);
      *(bf16x4*)(p.H + (size_t)row * D + k) = o;
    }
  }
}

__device__ __forceinline__ void epi_store(const Params& p, int mode, int layer, int pass, int m, int n, float v) {
  if (mode == 0) {
    if (n < 1024) p.PZ[(size_t)m * 1024 + n] = f2bf(v);
    else if (n < 2560) p.PXBC[(size_t)m * 1536 + (n - 1024)] = f2bf(v);
    else if (n < 4608) p.PSC[(size_t)m * 2048 + (n - 2560)] = f2bf(v);
    else if (n < 5888) p.PATT[(size_t)m * 1280 + (n - 4608)] = f2bf(v);
    else if (n < 5920) p.DTRAW[(size_t)m * 32 + (n - 5888)] = v;
  } else {
    const int b0 = pass * NB;
    if (m < NTL) {
      int b = b0 + m / SEQ;
      float g = p.MOD[((size_t)layer * 5 + b) * 3072 + 2048 + n];
      size_t idx = ((size_t)b0 * SEQ + m) * D + n;
      float xo = (layer == 0) ? p.x[idx] : p.out[idx];
      p.out[idx] = xo + g * v;
    } else {
      float g = p.MOD[((size_t)layer * 5 + 4) * 3072 + 2048 + n];
      size_t idx = ((size_t)b0 * CTXL + (m - NTL)) * D + n;
      p.CTX1[idx] = p.ctx[idx] + g * v;
    }
  }
}

__device__ void phase_gemm_naive(const Params& p, int mode, int layer, int pass, float* smem) {
  const int M = (mode == 0) ? NT : (layer == 0 ? NT : NTL);
  const int N = (mode == 0) ? NWIN : 1024;
  const int K = (mode == 0) ? 1024 : 2048;
  const bf16_t* A = (mode == 0) ? p.H : p.Y;
  const bf16_t* Bt = (mode == 0) ? p.WinT + (size_t)layer * NWIN * 1024 : p.WoutT + (size_t)layer * 1024 * 2048;
  const int tm = M / 64, tn = N / 64;
  const int tid = opq_tid(), tx = tid & 15, ty = tid >> 4;
  float* As = smem;
  float* Bs = smem + 16 * 68;
  for (int t = opq_bid(); t < tm * tn; t += gridDim.x) {
    int m0 = (t / tn) * 64, n0 = (t % tn) * 64;
    float acc[4][4];
#pragma unroll
    for (int i = 0; i < 4; ++i)
#pragma unroll
      for (int j = 0; j < 4; ++j) acc[i][j] = 0.f;
    int lr = tid >> 2, kq = (tid & 3) * 4;
    for (int k0 = 0; k0 < K; k0 += 16) {
      bf16x4 av = *(const bf16x4*)(A + (size_t)(m0 + lr) * K + k0 + kq);
      bf16x4 bv = *(const bf16x4*)(Bt + (size_t)(n0 + lr) * K + k0 + kq);
#pragma unroll
      for (int j = 0; j < 4; ++j) {
        As[(kq + j) * 68 + lr] = bf2f((bf16_t)av[j]);
        Bs[(kq + j) * 68 + lr] = bf2f((bf16_t)bv[j]);
      }
      __syncthreads();
#pragma unroll
      for (int kk = 0; kk < 16; ++kk) {
        float4 a4 = *(const float4*)(As + kk * 68 + ty * 4);
        float4 b4 = *(const float4*)(Bs + kk * 68 + tx * 4);
        float a[4] = {a4.x, a4.y, a4.z, a4.w}, b[4] = {b4.x, b4.y, b4.z, b4.w};
#pragma unroll
        for (int i = 0; i < 4; ++i)
#pragma unroll
          for (int j = 0; j < 4; ++j) acc[i][j] += a[i] * b[j];
      }
      __syncthreads();
    }
#pragma unroll
    for (int i = 0; i < 4; ++i)
#pragma unroll
      for (int j = 0; j < 4; ++j) epi_store(p, mode, layer, pass, m0 + ty * 4 + i, n0 + tx * 4 + j, acc[i][j]);
  }
}

__device__ void phase_gemm_mfma(const Params& p, int mode, int layer, int pass, bf16_t* smem) {
  const bool do_split = (mode == 1 && layer == 0);
  const bool ctx_sparse = (mode == 0 && layer == 1);
  const int M = (mode == 0 && !ctx_sparse) ? NT : NTL;
  const int N = (mode == 0) ? NWIN : 1024;
  const int K = (mode == 0) ? 1024 : 2048;
  const bf16_t* A = (mode == 0) ? p.H : p.Y;
  const bf16_t* Bt = (mode == 0) ? p.WinT + (size_t)layer * NWIN * 1024 : p.WoutT + (size_t)layer * 1024 * 2048;
  const int tm = M / 128, tn = N / 128, T_main = tm * tn, T = T_main + (ctx_sparse ? 60 : 0);
  const int tid = opq_tid(), lane = tid & 63, wid = tid >> 6, wm = wid >> 1, wn = wid & 1;
  const int lr = lane & 31, lh = lane >> 5;
  bf16_t* As = smem;
  bf16_t* Bs = smem + 128 * 72;
  float* rsS = (float*)(smem + 2 * 128 * 72);
  const int bid = opq_bid();
  int tstart = 0, tend = T, lb = bid, nbx = gridDim.x;
  if ((gridDim.x & 7) == 0) {
    int xcd = bid & 7; lb = bid >> 3; nbx = gridDim.x >> 3;
    tstart = (int)((long)T * xcd / 8); tend = (int)((long)T * (xcd + 1) / 8);
  }
  const int ng_full = tn / 8, rem = tn % 8, per_group = tm * 8;
  const int nk = K / 64;
  const int sr = tid >> 3, sc = (tid & 7) * 8;
  const int b0 = pass * NB;
  auto tile = [&](const int mi, const int ni, auto split_tag, const int ks) __attribute__((always_inline)) {
    constexpr bool SPLIT = decltype(split_tag)::value;
    const int kt0 = SPLIT ? ks * 8 : 0;
    const int kt1 = SPLIT ? kt0 + 8 : nk;
    const int m0 = mi * 128, n0 = ni * 128;
    f32x16 acc[2][2];
#pragma unroll
    for (int i = 0; i < 2; ++i)
#pragma unroll
      for (int j = 0; j < 2; ++j)
#pragma unroll
        for (int r = 0; r < 16; ++r) acc[i][j][r] = 0.f;
    const bf16_t* ga = A + (size_t)(m0 + sr) * K + sc + kt0 * 64;
    const bf16_t* gb = Bt + (size_t)(n0 + sr) * K + sc + kt0 * 64;
    bf16x8 ra[4], rb[4];
#pragma unroll
    for (int i = 0; i < 4; ++i) { ra[i] = *(const bf16x8*)(ga + (size_t)i * 32 * K); rb[i] = *(const bf16x8*)(gb + (size_t)i * 32 * K); }
    if (mode == 1) {
      int row = m0 + (tid >> 1), grp = tid & 1;
      const float* sp = p.SSQ + (size_t)row * 16 + grp * 8;
      f32x4 s0 = *(const f32x4*)sp, s1 = *(const f32x4*)(sp + 4);
      float ss = s0[0] + s0[1] + s0[2] + s0[3] + s1[0] + s1[1] + s1[2] + s1[3];
      rsS[tid] = rsqrtf(ss * (1.f / 512.f) + EPS);
    }
    if (mode == 1 && !SPLIT) {
      bf16x8 ra2[4], rb2[4];
#pragma unroll
      for (int i = 0; i < 4; ++i) {
        ra2[i] = *(const bf16x8*)(ga + (size_t)i * 32 * K + 64);
        rb2[i] = *(const bf16x8*)(gb + (size_t)i * 32 * K + 64);
      }
      auto mma4 = [&]() __attribute__((always_inline)) {
#pragma unroll
        for (int kk = 0; kk < 4; ++kk) {
          bf16x8 a0 = *(const bf16x8*)(As + (wm * 64 + lr) * 72 + kk * 16 + lh * 8);
          bf16x8 a1 = *(const bf16x8*)(As + (wm * 64 + 32 + lr) * 72 + kk * 16 + lh * 8);
          bf16x8 b0v = *(const bf16x8*)(Bs + (wn * 64 + lr) * 72 + kk * 16 + lh * 8);
          bf16x8 b1v = *(const bf16x8*)(Bs + (wn * 64 + 32 + lr) * 72 + kk * 16 + lh * 8);
          acc[0][0] = __builtin_amdgcn_mfma_f32_32x32x16_bf16(a0, b0v, acc[0][0], 0, 0, 0);
          acc[0][1] = __builtin_amdgcn_mfma_f32_32x32x16_bf16(a0, b1v, acc[0][1], 0, 0, 0);
          acc[1][0] = __builtin_amdgcn_mfma_f32_32x32x16_bf16(a1, b0v, acc[1][0], 0, 0, 0);
          acc[1][1] = __builtin_amdgcn_mfma_f32_32x32x16_bf16(a1, b1v, acc[1][1], 0, 0, 0);
        }
      };
      for (int kt = 0; kt < 32; kt += 2) {
        __syncthreads();
#pragma unroll
        for (int i = 0; i < 4; ++i) {
          *(bf16x8*)(As + (sr + i * 32) * 72 + sc) = ra[i];
          *(bf16x8*)(Bs + (sr + i * 32) * 72 + sc) = rb[i];
        }
        __syncthreads();
        if (kt + 2 < 32) {
#pragma unroll
          for (int i = 0; i < 4; ++i) {
            ra[i] = *(const bf16x8*)(ga + (size_t)i * 32 * K + (kt + 2) * 64);
            rb[i] = *(const bf16x8*)(gb + (size_t)i * 32 * K + (kt + 2) * 64);
          }
        }
        mma4();
        __syncthreads();
#pragma unroll
        for (int i = 0; i < 4; ++i) {
          *(bf16x8*)(As + (sr + i * 32) * 72 + sc) = ra2[i];
          *(bf16x8*)(Bs + (sr + i * 32) * 72 + sc) = rb2[i];
        }
        __syncthreads();
        if (kt + 3 < 32) {
#pragma unroll
          for (int i = 0; i < 4; ++i) {
            ra2[i] = *(const bf16x8*)(ga + (size_t)i * 32 * K + (kt + 3) * 64);
            rb2[i] = *(const bf16x8*)(gb + (size_t)i * 32 * K + (kt + 3) * 64);
          }
        }
        mma4();
        if (kt == 6 || kt == 14) {
#pragma unroll
          for (int i = 0; i < 2; ++i)
#pragma unroll
            for (int r = 0; r < 16; ++r) {
              int lrow = wm * 64 + i * 32 + (r & 3) + 8 * (r >> 2) + 4 * lh;
              float r0 = rsS[lrow * 2], r1 = rsS[lrow * 2 + 1];
              float f = (kt == 6) ? r0 * __builtin_amdgcn_rcpf(r1) : r1;
              acc[i][0][r] *= f; acc[i][1][r] *= f;
            }
        }
      }
    } else
    for (int kt = kt0; kt < kt1; ++kt) {
      __syncthreads();
#pragma unroll
      for (int i = 0; i < 4; ++i) {
        *(bf16x8*)(As + (sr + i * 32) * 72 + sc) = ra[i];
        *(bf16x8*)(Bs + (sr + i * 32) * 72 + sc) = rb[i];
      }
      __syncthreads();
      if (kt + 1 < kt1) {
#pragma unroll
        for (int i = 0; i < 4; ++i) {
          ra[i] = *(const bf16x8*)(ga + (size_t)i * 32 * K + (kt + 1 - kt0) * 64);
          rb[i] = *(const bf16x8*)(gb + (size_t)i * 32 * K + (kt + 1 - kt0) * 64);
        }
      }
#pragma unroll
      for (int kk = 0; kk < 4; ++kk) {
        bf16x8 a0 = *(const bf16x8*)(As + (wm * 64 + lr) * 72 + kk * 16 + lh * 8);
        bf16x8 a1 = *(const bf16x8*)(As + (wm * 64 + 32 + lr) * 72 + kk * 16 + lh * 8);
        bf16x8 b0v = *(const bf16x8*)(Bs + (wn * 64 + lr) * 72 + kk * 16 + lh * 8);
        bf16x8 b1v = *(const bf16x8*)(Bs + (wn * 64 + 32 + lr) * 72 + kk * 16 + lh * 8);
        acc[0][0] = __builtin_amdgcn_mfma_f32_32x32x16_bf16(a0, b0v, acc[0][0], 0, 0, 0);
        acc[0][1] = __builtin_amdgcn_mfma_f32_32x32x16_bf16(a0, b1v, acc[0][1], 0, 0, 0);
        acc[1][0] = __builtin_amdgcn_mfma_f32_32x32x16_bf16(a1, b0v, acc[1][0], 0, 0, 0);
        acc[1][1] = __builtin_amdgcn_mfma_f32_32x32x16_bf16(a1, b1v, acc[1][1], 0, 0, 0);
      }
      if (mode == 1 && !SPLIT && (kt == 7 || kt == 15)) {
#pragma unroll
        for (int i = 0; i < 2; ++i)
#pragma unroll
          for (int r = 0; r < 16; ++r) {
            int lrow = wm * 64 + i * 32 + (r & 3) + 8 * (r >> 2) + 4 * lh;
            float r0 = rsS[lrow * 2], r1 = rsS[lrow * 2 + 1];
            float f = (kt == 7) ? r0 * __builtin_amdgcn_rcpf(r1) : r1;
            acc[i][0][r] *= f; acc[i][1][r] *= f;
          }
      }
    }
    if (mode == 0) {
      if (ni < 46) {
        bf16_t* dst; int ld, cb;
        if (ni < 8) { dst = p.PZ; ld = 1024; cb = ni * 128; }
        else if (ni < 20) { dst = p.PXBC; ld = 1536; cb = (ni - 8) * 128; }
        else if (ni < 36) { dst = p.PSC; ld = 2048; cb = (ni - 20) * 128; }
        else { dst = p.PATT; ld = 1280; cb = (ni - 36) * 128; }
#pragma unroll
        for (int i = 0; i < 2; ++i)
#pragma unroll
          for (int j = 0; j < 2; ++j)
#pragma unroll
            for (int r = 0; r < 16; ++r) {
              int row = m0 + wm * 64 + i * 32 + (r & 3) + 8 * (r >> 2) + 4 * lh;
              int col = cb + wn * 64 + j * 32 + lr;
              dst[(size_t)row * ld + col] = f2bf(acc[i][j][r]);
            }
      } else if (wn == 0) {
#pragma unroll
        for (int i = 0; i < 2; ++i)
#pragma unroll
          for (int r = 0; r < 16; ++r) {
            int row = m0 + wm * 64 + i * 32 + (r & 3) + 8 * (r >> 2) + 4 * lh;
            p.DTRAW[(size_t)row * 32 + lr] = acc[i][0][r];
          }
      }
    } else if (!SPLIT) {
      float* Os = (float*)smem;
      const int ocol4 = (tid & 31) * 4, orow = tid >> 5;
      const int b = b0 + m0 / SEQ;
      const float4 g4 = *(const float4*)(p.MOD + ((size_t)layer * 5 + b) * 3072 + 2048 + n0 + ocol4);
      __syncthreads();
#pragma unroll
      for (int half = 0; half < 2; ++half) {
        if (wm == half) {
#pragma unroll
          for (int i = 0; i < 2; ++i)
#pragma unroll
            for (int j = 0; j < 2; ++j)
#pragma unroll
              for (int r = 0; r < 16; ++r)
                Os[(i * 32 + (r & 3) + 8 * (r >> 2) + 4 * lh) * 132 + wn * 64 + j * 32 + lr] = acc[i][j][r];
        }
        __syncthreads();
#pragma unroll 4
        for (int k = 0; k < 8; ++k) {
          int row = orow + 8 * k;
          float4 v = *(const float4*)(Os + row * 132 + ocol4);
          size_t idx = ((size_t)b0 * SEQ + m0 + half * 64 + row) * D + n0 + ocol4;
          float4 x4 = (layer == 0) ? *(const float4*)(p.x + idx) : *(const float4*)(p.out + idx);
          float4 o = {x4.x + g4.x * v.x, x4.y + g4.y * v.y, x4.z + g4.z * v.z, x4.w + g4.w * v.w};
          *(float4*)(p.out + idx) = o;
        }
        __syncthreads();
      }
    } else {
#pragma unroll
      for (int i = 0; i < 2; ++i)
#pragma unroll
        for (int j = 0; j < 2; ++j)
#pragma unroll
          for (int r = 0; r < 16; ++r) {
            int row = m0 + wm * 64 + i * 32 + (r & 3) + 8 * (r >> 2) + 4 * lh;
            int col = n0 + wn * 64 + j * 32 + lr;
            int lrow = row - m0;
            float f = (ks < 2) ? rsS[lrow * 2 + ks] : 1.f;
            p.PART[((size_t)ks * NTC + (row - NTL)) * D + col] = acc[i][j][r] * f;
          }
    }
  };
  for (int t = tstart + lb; t < tend; t += nbx) {
    int mi, ni;
    if (t >= T_main) { int e = t - T_main, j = e % 15; mi = 64 + e / 15; ni = (j < 12) ? 8 + j : ((j < 14) ? 28 + j : 46); }
    else if (t < ng_full * per_group) { int ng = t / per_group, r = t % per_group; mi = r >> 3; ni = ng * 8 + (r & 7); }
    else { int r = t - ng_full * per_group; mi = r / rem; ni = ng_full * 8 + r % rem; }
    tile(mi, ni, std::integral_constant<bool, false>{}, -1);
  }
  if (do_split) {
    for (int s = bid; s < 128; s += gridDim.x) {
      int ct = s >> 2, ks = s & 3;
      tile(64 + (ct >> 3), ct & 7, std::integral_constant<bool, true>{}, ks);
    }
  }
}

__device__ void phase_gemm_in256(const Params& p, int layer, int pass, bf16_t* smem) {
  constexpr int K = 1024, nk = 16;
  const bf16_t* A = p.H;
  const bf16_t* Bt = p.WinT + (size_t)layer * NWIN * 1024;
  const bool ctx_sparse = (layer == 1);
  const int tm = (ctx_sparse ? NTL : NT) / 256, tn = NWIN / 128, T_main = tm * tn, T = T_main + (ctx_sparse ? 30 : 0);
  const int tid = opq_tid(), lane = tid & 63, wid = tid >> 6, wm = wid >> 1, wn = wid & 1;
  const int lr = lane & 31, lh = lane >> 5;
  bf16_t* As = smem;
  bf16_t* Bs = smem + 256 * 72;
  const int bid = opq_bid();
  int tstart = 0, tend = T, lb = bid, nbx = gridDim.x;
  if ((gridDim.x & 7) == 0) {
    int xcd = bid & 7; lb = bid >> 3; nbx = gridDim.x >> 3;
    tstart = (int)((long)T * xcd / 8); tend = (int)((long)T * (xcd + 1) / 8);
  }
  const int ng_full = tn / 8, rem = tn % 8, per_group = tm * 8;
  const int sr = tid >> 3, sc = (tid & 7) * 8;
  for (int t = tstart + lb; t < tend; t += nbx) {
    int mi, ni;
    if (t >= T_main) { int e = t - T_main, j = e % 15; mi = 32 + e / 15; ni = (j < 12) ? 8 + j : ((j < 14) ? 28 + j : 46); }
    else if (t < ng_full * per_group) { int ng = t / per_group, r = t % per_group; mi = r >> 3; ni = ng * 8 + (r & 7); }
    else { int r = t - ng_full * per_group; mi = r / rem; ni = ng_full * 8 + r % rem; }
    const int m0 = mi * 256, n0 = ni * 128;
    f32x16 acc[4][2];
#pragma unroll
    for (int i = 0; i < 4; ++i)
#pragma unroll
      for (int j = 0; j < 2; ++j)
#pragma unroll
        for (int r = 0; r < 16; ++r) acc[i][j][r] = 0.f;
    const bf16_t* ga = A + (size_t)(m0 + sr) * K + sc;
    const bf16_t* gb = Bt + (size_t)(n0 + sr) * K + sc;
    bf16x8 ra[8], rb[4];
#pragma unroll
    for (int i = 0; i < 8; ++i) ra[i] = *(const bf16x8*)(ga + (size_t)i * 32 * K);
#pragma unroll
    for (int i = 0; i < 4; ++i) rb[i] = *(const bf16x8*)(gb + (size_t)i * 32 * K);
    for (int kt = 0; kt < nk; ++kt) {
      __syncthreads();
#pragma unroll
      for (int i = 0; i < 8; ++i) *(bf16x8*)(As + (sr + i * 32) * 72 + sc) = ra[i];
#pragma unroll
      for (int i = 0; i < 4; ++i) *(bf16x8*)(Bs + (sr + i * 32) * 72 + sc) = rb[i];
      __syncthreads();
      if (kt + 1 < nk) {
#pragma unroll
        for (int i = 0; i < 8; ++i) ra[i] = *(const bf16x8*)(ga + (size_t)i * 32 * K + (kt + 1) * 64);
#pragma unroll
        for (int i = 0; i < 4; ++i) rb[i] = *(const bf16x8*)(gb + (size_t)i * 32 * K + (kt + 1) * 64);
      }
#pragma unroll
      for (int kk = 0; kk < 4; ++kk) {
        bf16x8 b0v = *(const bf16x8*)(Bs + (wn * 64 + lr) * 72 + kk * 16 + lh * 8);
        bf16x8 b1v = *(const bf16x8*)(Bs + (wn * 64 + 32 + lr) * 72 + kk * 16 + lh * 8);
#pragma unroll
        for (int i = 0; i < 4; ++i) {
          bf16x8 av = *(const bf16x8*)(As + (wm * 128 + i * 32 + lr) * 72 + kk * 16 + lh * 8);
          acc[i][0] = __builtin_amdgcn_mfma_f32_32x32x16_bf16(av, b0v, acc[i][0], 0, 0, 0);
          acc[i][1] = __builtin_amdgcn_mfma_f32_32x32x16_bf16(av, b1v, acc[i][1], 0, 0, 0);
        }
      }
    }
    if (ni < 46) {
      bf16_t* dst; int ld, cb;
      if (ni < 8) { dst = p.PZ; ld = 1024; cb = ni * 128; }
      else if (ni < 20) { dst = p.PXBC; ld = 1536; cb = (ni - 8) * 128; }
      else if (ni < 36) { dst = p.PSC; ld = 2048; cb = (ni - 20) * 128; }
      else { dst = p.PATT; ld = 1280; cb = (ni - 36) * 128; }
      bf16_t* Os = smem;
      __syncthreads();
#pragma unroll
      for (int half = 0; half < 2; ++half) {
        if (wm == half) {
          bf16_t* q = Os + (4 * lh) * 136 + wn * 64 + lr;
#pragma unroll
          for (int i = 0; i < 4; ++i)
#pragma unroll
            for (int j = 0; j < 2; ++j)
#pragma unroll
              for (int r = 0; r < 16; ++r) q[(i * 32 + (r & 3) + 8 * (r >> 2)) * 136 + j * 32] = f2bf(acc[i][j][r]);
        }
        __syncthreads();
        {
          const int orow = tid >> 4, ocol = (tid & 15) * 8;
          bf16_t* gd = dst + (size_t)(m0 + half * 128 + orow) * ld + cb + ocol;
#pragma unroll
          for (int k = 0; k < 8; ++k) {
            bf16x8 v = *(const bf16x8*)(Os + (orow + 16 * k) * 136 + ocol);
            *(bf16x8*)(gd + (size_t)(16 * k) * ld) = v;
          }
        }
        __syncthreads();
      }
    } else if (wn == 0) {
#pragma unroll
      for (int i = 0; i < 4; ++i)
#pragma unroll
        for (int r = 0; r < 16; ++r) {
          int row = m0 + wm * 128 + i * 32 + (r & 3) + 8 * (r >> 2) + 4 * lh;
          p.DTRAW[(size_t)row * 32 + lr] = acc[i][0][r];
        }
    }
  }
}

__device__ void phase_prep(const Params& p, int layer, int pass, float* smem) {
  const int tid = opq_tid(), lane = tid & 63;
  const int gw = opq_bid() * 4 + (tid >> 6), nw = gridDim.x * 4;
  for (int gc = opq_bid(); gc < NCH; gc += gridDim.x) {
    float* sda = smem; float* sdt = smem + 4224;
    for (int e = tid; e < 4096; e += 256) {
      int l = e >> 5, dh = e & 31;
      float raw = p.DTRAW[((size_t)gc * 128 + l) * 32 + dh] + p.ssd_dt_bias[layer * 32 + dh];
      float dt = raw > 20.f ? raw : log1pf(expf(raw));
      float A = -expf(p.ssd_a_log[layer * 32 + dh]);
      sdt[l * 33 + dh] = dt;
      sda[l * 33 + dh] = dt * A;
    }
    __syncthreads();
    {
      const int dh = tid & 31, seg = tid >> 5;
      float* segtot = smem + 8448;
      float loc[16]; float s = 0.f;
      if (dh < 16) {
#pragma unroll
        for (int j = 0; j < 16; ++j) { s += sda[(seg * 16 + j) * 33 + dh]; loc[j] = s; }
      } else {
#pragma unroll
        for (int j = 15; j >= 0; --j) { s += sda[(seg * 16 + j) * 33 + dh]; loc[j] = s; }
      }
      segtot[seg * 32 + dh] = s;
      __syncthreads();
      float off = 0.f;
      if (dh < 16) { for (int k = 0; k < seg; ++k) off += segtot[k * 32 + dh]; }
      else { for (int k = 7; k > seg; --k) off += segtot[k * 32 + dh]; }
#pragma unroll
      for (int j = 0; j < 16; ++j) sda[(seg * 16 + j) * 33 + dh] = loc[j] + off;
    }
    __syncthreads();
    for (int e = tid; e < 4096; e += 256) {
      int dh = e >> 7, l = e & 127;
      float cum = sda[l * 33 + dh], dt = sdt[l * 33 + dh];
      float tot = (dh < 16) ? sda[127 * 33 + dh] : sda[dh];
      size_t idx = ((size_t)gc * 32 + dh) * 128 + l;
      p.CUMT[idx] = cum;
      p.VV[idx] = cum - logf(fmaxf(dt, 1e-30f));
      p.EC[idx] = expf(cum);
      p.WW[idx] = dt * expf(tot - cum);
    }
    __syncthreads();
  }
  const int nchc = (layer == 0) ? NCH : 64;
  const int Nb = NCH * 4 * 24, Nc = nchc * 16, Nd = (NT * 40) / 64, Ne = NCH * 16 * 2;
  for (int uu = gw; uu < Nb + Nc + Nd + Ne; uu += nw) {
  if (uu < Nb) {
    const int u = uu;
    int cblk = u % 24, l32 = (u / 24) & 3, gc = u / (24 * 4);
    int c = cblk * 64 + lane;
    bool first, last;
    if (gc < 64) { first = (gc % 32 == 0) && l32 == 0; last = (gc % 32 == 31) && l32 == 3; }
    else { first = ((gc - 64) % 2 == 0) && l32 == 0; last = ((gc - 64) % 2 == 1) && l32 == 3; }
    int t0 = gc * 128 + l32 * 32;
    float w0 = p.ssd_conv_w[((size_t)layer * 3 + 0) * 1536 + c], w1 = p.ssd_conv_w[((size_t)layer * 3 + 1) * 1536 + c],
          w2 = p.ssd_conv_w[((size_t)layer * 3 + 2) * 1536 + c], bs = p.ssd_conv_b[layer * 1536 + c];
    bf16_t raw[34];
#pragma unroll
    for (int i = 0; i < 34; ++i) {
      bool ok = !((i == 0 && first) || (i == 33 && last));
      raw[i] = ok ? p.PXBC[(size_t)(t0 + i - 1) * 1536 + c] : (bf16_t)0;
    }
    bf16x8 o[4];
#pragma unroll
    for (int j = 0; j < 32; ++j)
      o[j >> 3][j & 7] = (short)f2bf(silu_f(w0 * bf2f(raw[j]) + w1 * bf2f(raw[j + 1]) + w2 * bf2f(raw[j + 2]) + bs));
    if (c < 1024) {
#pragma unroll
      for (int k = 0; k < 4; ++k) *(bf16x8*)(p.XT + ((size_t)gc * 1024 + c) * 128 + l32 * 32 + k * 8) = o[k];
    } else if (c < 1280) {
      int n = c - 1024;
#pragma unroll
      for (int k = 0; k < 4; ++k) *(bf16x8*)(p.BT + ((size_t)gc * 256 + n) * 128 + l32 * 32 + k * 8) = o[k];
#pragma unroll
      for (int j = 0; j < 32; ++j) p.BR[(size_t)(t0 + j) * 256 + n] = (bf16_t)o[j >> 3][j & 7];
    } else {
      int n = c - 1280;
#pragma unroll
      for (int j = 0; j < 32; ++j) p.CR[(size_t)(t0 + j) * 256 + n] = (bf16_t)o[j >> 3][j & 7];
    }
  } else if (uu < Nb + Nc) {
    {
      const int u = uu - Nb;
      const int l8 = u & 15, gc = u >> 4;
      const int c0 = lane * 8;
      bool first, last;
      if (gc < 64) { first = (gc % 32 == 0) && l8 == 0; last = (gc % 32 == 31) && l8 == 15; }
      else { first = ((gc - 64) % 2 == 0) && l8 == 0; last = ((gc - 64) % 2 == 1) && l8 == 15; }
      const int t0 = gc * 128 + l8 * 8;
      float w0[8], w1[8], w2[8];
      {
        const float* wp = p.sc_conv_w + (size_t)layer * 3 * 512 + c0;
        f32x4 a0 = *(const f32x4*)wp, a1 = *(const f32x4*)(wp + 4);
        f32x4 b0 = *(const f32x4*)(wp + 512), b1 = *(const f32x4*)(wp + 516);
        f32x4 d0 = *(const f32x4*)(wp + 1024), d1 = *(const f32x4*)(wp + 1028);
#pragma unroll
        for (int k = 0; k < 4; ++k) { w0[k] = a0[k]; w0[4 + k] = a1[k]; w1[k] = b0[k]; w1[4 + k] = b1[k]; w2[k] = d0[k]; w2[4 + k] = d1[k]; }
      }
      float up[10][8];
#pragma unroll
      for (int i = 0; i < 10; ++i) {
        bool ok = !((i == 0 && first) || (i == 9 && last));
        const bf16_t* r = p.PSC + (size_t)(t0 + i - 1) * 2048 + c0;
        bf16x8 v8 = ok ? *(const bf16x8*)r : bf16x8{0, 0, 0, 0, 0, 0, 0, 0};
        bf16x8 g8 = ok ? *(const bf16x8*)(r + 512) : bf16x8{0, 0, 0, 0, 0, 0, 0, 0};
#pragma unroll
        for (int k = 0; k < 8; ++k) up[i][k] = bf2f((bf16_t)v8[k]) * bf2f((bf16_t)g8[k]);
      }
#pragma unroll
      for (int j = 0; j < 8; ++j) {
        const bf16_t* r = p.PSC + (size_t)(t0 + j) * 2048 + c0;
        bf16x8 b8 = *(const bf16x8*)(r + 1024), z8 = *(const bf16x8*)(r + 1536);
        f32x4 lo, hi;
#pragma unroll
        for (int k = 0; k < 8; ++k) {
          float cv = w0[k] * up[j][k] + w1[k] * up[j + 1][k] + w2[k] * up[j + 2][k];
          float o = bf2f((bf16_t)b8[k]) * cv * silu_f(bf2f((bf16_t)z8[k]));
          if (k < 4) lo[k] = o; else hi[k - 4] = o;
        }
        *(bf16x8*)(p.Y + (size_t)(t0 + j) * 2048 + 1024 + c0) = pack8(lo, hi);
      }
    }
  } else if (uu < Nb + Nc + Nd) {
    {
      const int idx = (uu - Nb - Nc) * 64 + lane;
      int row = idx / 40, r = idx % 40;
      int slot = r >> 2, a = (r >> 1) & 1, i0 = (r & 1) * 8;
      const bf16_t* src = p.PATT + (size_t)row * 1280 + (slot < 8 ? slot * 64 : 512 + (slot - 8) * 64) + a * 32 + i0;
      bf16x8 x1 = *(const bf16x8*)src, x2 = *(const bf16x8*)(src + 16);
      bf16x8 o1, o2;
      if (row < NTL) {
        int t = row & (SEQ - 1);
        int pos = (a == 0) ? (t >> 6) : (t & 63);
        const float* tb = p.ROPE + (pos * 16 + i0) * 2;
#pragma unroll
        for (int j = 0; j < 8; ++j) {
          float cs = tb[2 * j], sn = tb[2 * j + 1];
          float a1 = bf2f((bf16_t)x1[j]), a2 = bf2f((bf16_t)x2[j]);
          o1[j] = (short)f2bf(a1 * cs - a2 * sn);
          o2[j] = (short)f2bf(a1 * sn + a2 * cs);
        }
      } else { o1 = x1; o2 = x2; }
      bf16_t* dst = (slot < 8) ? p.QR + (size_t)row * 512 + slot * 64 + a * 32 + i0
                               : p.KR + (size_t)row * 128 + (slot - 8) * 64 + a * 32 + i0;
      *(bf16x8*)dst = o1; *(bf16x8*)(dst + 16) = o2;
    }
  } else {
    const int u = uu - Nb - Nc - Nd;
    int half = u & 1, l8 = (u >> 1) & 15, gc = u >> 5;
    int c = half * 64 + lane;
    int t0 = gc * 128 + l8 * 8;
    bf16x8 o;
#pragma unroll
    for (int j = 0; j < 8; ++j) o[j] = (short)p.PATT[(size_t)(t0 + j) * 1280 + 640 + c];
    *(bf16x8*)(p.VT + ((size_t)gc * 128 + c) * 128 + l8 * 8) = o;
  }
  }
}

__device__ void phase_attn_naive(const Params& p, int layer, int pass) {
  const int lane = opq_tid() & 63;
  const int gw = opq_bid() * 4 + (opq_tid() >> 6), nw = gridDim.x * 4;
  const int nrows = (layer == 0) ? NT : NTL;
  for (int u = gw; u < nrows * 8; u += nw) {
    int h = u & 7, row = u >> 3, kvh = h >> 2;
    float q = bf2f(p.QR[(size_t)row * 512 + h * 64 + lane]);
    float m = p.attn_sink[layer * 8 + h], l = 1.f, o = 0.f;
    int bl, k0 = 0, k1 = 0;
    if (row < NTL) {
      bl = row / SEQ; int t = row % SEQ;
      int lo = t - 128 < 0 ? 0 : t - 128, hi = t + 128 > SEQ - 1 ? SEQ - 1 : t + 128;
      k0 = bl * SEQ + lo; k1 = bl * SEQ + hi + 1;
    } else bl = (row - NTL) / CTXL;
    int nband = k1 - k0;
    for (int kk = 0; kk < nband + CTXL; ++kk) {
      int kr = (kk < nband) ? k0 + kk : NTL + bl * CTXL + (kk - nband);
      float kv = bf2f(p.KR[(size_t)kr * 128 + kvh * 64 + lane]);
      float vv = bf2f(p.VT[((size_t)(kr >> 7) * 128 + kvh * 64 + lane) * 128 + (kr & 127)]);
      float s = wave_sum(q * kv) * 0.125f;
      float mn = fmaxf(m, s);
      float corr = expf(m - mn), pe = expf(s - mn);
      l = l * corr + pe; o = o * corr + pe * vv; m = mn;
    }
    float z = bf2f(p.PATT[(size_t)row * 1280 + 768 + h * 64 + lane]);
    p.Y[(size_t)row * 2048 + 1536 + h * 64 + lane] = f2bf(o / l * silu_f(z));
  }
}

__device__ void phase_attn(const Params& p, int layer, int pass, bf16_t* smem) {
  const int tid = opq_tid(), lane = tid & 63, wid = tid >> 6, lr = lane & 31, lh = lane >> 5;
  const int nqt = ((layer == 0) ? NT : NTL) / 32;
  const int srow = tid >> 3, scol = (tid & 7) * 8;
  for (int u = (opq_bid() + (int)gridDim.x - 64) % (int)gridDim.x; u < nqt * 2; u += gridDim.x) {
    const int kvh = u & 1, qt = u >> 1, h = kvh * 4 + wid;
    const int q0 = qt * 32;
    int bl, nband = 0, tb0 = 0, t0 = 0;
    if (q0 < NTL) {
      bl = q0 >> 12; t0 = q0 & 4095;
      tb0 = (t0 - 128 < 0) ? 0 : ((t0 - 128) >> 6);
      int tb1 = (t0 + 159) >> 6; if (tb1 > 63) tb1 = 63;
      nband = tb1 - tb0 + 1;
    } else bl = (q0 - NTL) >> 8;
    const int ntile = nband + 4;
    bf16x8 qf[4];
    {
      const bf16_t* qp = p.QR + (size_t)(q0 + lr) * 512 + h * 64 + lh * 8;
#pragma unroll
      for (int kk = 0; kk < 4; ++kk) qf[kk] = *(const bf16x8*)(qp + kk * 16);
    }
    float m = p.attn_sink[layer * 8 + h], l = 1.f;
    f32x16 o[2];
#pragma unroll
    for (int r = 0; r < 16; ++r) { o[0][r] = 0.f; o[1][r] = 0.f; }
    const int qpos = t0 + lr;
    bf16x8 rk[2], rv[2];
    auto fetch = [&](int ti) __attribute__((always_inline)) {
      const int kr0 = (ti < nband) ? bl * 4096 + (tb0 + ti) * 64 : NTL + bl * 256 + (ti - nband) * 64;
      const bf16_t* kp = p.KR + (size_t)(kr0 + srow) * 128 + kvh * 64 + scol;
      const bf16_t* vp = p.VT + ((size_t)(kr0 >> 7) * 128 + kvh * 64 + srow) * 128 + (kr0 & 127) + scol;
      rk[0] = *(const bf16x8*)kp; rk[1] = *(const bf16x8*)(kp + 32 * 128);
      rv[0] = *(const bf16x8*)vp; rv[1] = *(const bf16x8*)(vp + 32 * 128);
    };
    auto stash = [&](bf16_t* buf) __attribute__((always_inline)) {
      *(bf16x8*)(buf + srow * 72 + scol) = rk[0];
      *(bf16x8*)(buf + (srow + 32) * 72 + scol) = rk[1];
      *(bf16x8*)(buf + 4608 + srow * 72 + scol) = rv[0];
      *(bf16x8*)(buf + 4608 + (srow + 32) * 72 + scol) = rv[1];
    };
    fetch(0);
    __syncthreads();
    stash(smem);
    if (1 < ntile) fetch(1);
    __syncthreads();
    for (int ti = 0; ti < ntile; ++ti) {
      const bf16_t* Kc = smem + (ti & 1) * 9216;
      const bf16_t* Vc = Kc + 4608;
      if (ti + 1 < ntile) {
        stash(smem + ((ti + 1) & 1) * 9216);
        if (ti + 2 < ntile) fetch(ti + 2);
      }
      f32x16 st[2];
#pragma unroll
      for (int r = 0; r < 16; ++r) { st[0][r] = 0.f; st[1][r] = 0.f; }
#pragma unroll
      for (int kk = 0; kk < 4; ++kk) {
        bf16x8 kf0 = *(const bf16x8*)(Kc + lr * 72 + kk * 16 + lh * 8);
        bf16x8 kf1 = *(const bf16x8*)(Kc + (32 + lr) * 72 + kk * 16 + lh * 8);
        st[0] = __builtin_amdgcn_mfma_f32_32x32x16_bf16(kf0, qf[kk], st[0], 0, 0, 0);
        st[1] = __builtin_amdgcn_mfma_f32_32x32x16_bf16(kf1, qf[kk], st[1], 0, 0, 0);
      }
      float mx = -3.0e38f;
      const bool band = ti < nband;
      const int kbase = (tb0 + ti) * 64 + 4 * lh;
#pragma unroll
      for (int hh = 0; hh < 2; ++hh)
#pragma unroll
        for (int r = 0; r < 16; ++r) {
          float s = st[hh][r] * 0.125f;
          if (band) {
            int dd = qpos - (kbase + hh * 32 + (r & 3) + 8 * (r >> 2));
            if (dd > 128 || dd < -128) s = -1e30f;
          }
          st[hh][r] = s; mx = fmaxf(mx, s);
        }
      mx = fmaxf(mx, __shfl_xor(mx, 32));
      const float mn = fmaxf(m, mx);
      const float corr = __expf(m - mn);
      m = mn;
      float ls = 0.f;
#pragma unroll
      for (int hh = 0; hh < 2; ++hh)
#pragma unroll
        for (int r = 0; r < 16; ++r) { st[hh][r] = __expf(st[hh][r] - mn); ls += st[hh][r]; }
      ls += __shfl_xor(ls, 32);
      l = l * corr + ls;
#pragma unroll
      for (int r = 0; r < 16; ++r) { o[0][r] *= corr; o[1][r] *= corr; }
#pragma unroll
      for (int hh = 0; hh < 2; ++hh)
#pragma unroll
        for (int s2 = 0; s2 < 2; ++s2) {
          f32x4 pa = {st[hh][8 * s2 + 0], st[hh][8 * s2 + 1], st[hh][8 * s2 + 2], st[hh][8 * s2 + 3]};
          f32x4 pb = {st[hh][8 * s2 + 4], st[hh][8 * s2 + 5], st[hh][8 * s2 + 6], st[hh][8 * s2 + 7]};
          bf16x8 pf = pack8(pa, pb);
#pragma unroll
          for (int mt = 0; mt < 2; ++mt) {
            const bf16_t* vp = Vc + (mt * 32 + lr) * 72 + hh * 32 + 16 * s2 + 4 * lh;
            bf16x4 x0 = *(const bf16x4*)vp, x1 = *(const bf16x4*)(vp + 8);
            bf16x8 vfr = {x0[0], x0[1], x0[2], x0[3], x1[0], x1[1], x1[2], x1[3]};
            o[mt] = __builtin_amdgcn_mfma_f32_32x32x16_bf16(vfr, pf, o[mt], 0, 0, 0);
          }
        }
      __syncthreads();
    }
    const float inv = 1.f / l;
    {
      bf16_t* Zw = smem + 2 * 9216 + wid * (32 * 72);
      const int er = lane >> 3, ec = (lane & 7) * 8;
      const bf16_t* zg = p.PATT + (size_t)(q0 + er) * 1280 + 768 + h * 64 + ec;
      bf16x8 zr[4];
#pragma unroll
      for (int i = 0; i < 4; ++i) zr[i] = *(const bf16x8*)(zg + (size_t)i * 8 * 1280);
#pragma unroll
      for (int i = 0; i < 4; ++i) *(bf16x8*)(Zw + (er + 8 * i) * 72 + ec) = zr[i];
#pragma unroll
      for (int mt = 0; mt < 2; ++mt)
#pragma unroll
        for (int qq = 0; qq < 4; ++qq) {
          int d0 = mt * 32 + 8 * qq + 4 * lh;
          bf16x4 z4 = *(const bf16x4*)(Zw + lr * 72 + d0);
          bf16x4 o4;
#pragma unroll
          for (int t = 0; t < 4; ++t) o4[t] = (short)f2bf(o[mt][qq * 4 + t] * inv * silu_f(bf2f((bf16_t)z4[t])));
          *(bf16x4*)(Zw + lr * 72 + d0) = o4;
        }
      bf16_t* yg = p.Y + (size_t)(q0 + er) * 2048 + 1536 + h * 64 + ec;
#pragma unroll
      for (int i = 0; i < 4; ++i) *(bf16x8*)(yg + (size_t)i * 8 * 2048) = *(const bf16x8*)(Zw + (er + 8 * i) * 72 + ec);
    }
  }
}

__device__ void phase_s1(const Params& p, int layer, int pass, bf16_t* smem) {
  const int tid = opq_tid(), lane = tid & 63, nt = tid >> 6, lr = lane & 31, lh = lane >> 5;
  constexpr int RS = 136;
  bf16_t* Xs = smem;
  bf16_t* Bts = smem + 64 * RS;
  float* Ws = (float*)(smem + 192 * RS);
  const int srow = tid >> 4, scol = (tid & 15) * 8;
  for (int u = opq_bid(); u < NCH * 16; u += gridDim.x) {
    const int h = u & 15, gc = u >> 4, g = h >> 3;
    bf16x8 rx[4], rb[8];
    {
      const bf16_t* Xg = p.XT + ((size_t)gc * 1024 + h * 64 + srow) * 128 + scol;
#pragma unroll
      for (int i = 0; i < 4; ++i) rx[i] = *(const bf16x8*)(Xg + i * 2048);
      const bf16_t* Bg = p.BT + ((size_t)gc * 256 + g * 128 + srow) * 128 + scol;
#pragma unroll
      for (int i = 0; i < 8; ++i) rb[i] = *(const bf16x8*)(Bg + i * 2048);
    }
    const float wv = p.WW[((size_t)gc * 32 + (tid >> 7) * 16 + h) * 128 + (tid & 127)];
    __syncthreads();
#pragma unroll
    for (int i = 0; i < 4; ++i) *(bf16x8*)(Xs + (srow + 16 * i) * RS + scol) = rx[i];
#pragma unroll
    for (int i = 0; i < 8; ++i) *(bf16x8*)(Bts + (srow + 16 * i) * RS + scol) = rb[i];
    Ws[tid] = wv;
    __syncthreads();
#pragma unroll 1
    for (int d = 0; d < 2; ++d) {
      f32x16 acc0, acc1;
#pragma unroll
      for (int r = 0; r < 16; ++r) { acc0[r] = 0.f; acc1[r] = 0.f; }
#pragma unroll
      for (int kk = 0; kk < 8; ++kk) {
        bf16x8 bfr = *(const bf16x8*)(Bts + (nt * 32 + lr) * RS + kk * 16 + lh * 8);
        bf16x8 x0 = *(const bf16x8*)(Xs + lr * RS + kk * 16 + lh * 8);
        bf16x8 x1 = *(const bf16x8*)(Xs + (32 + lr) * RS + kk * 16 + lh * 8);
        f32x4 wa = *(const f32x4*)(Ws + d * 128 + kk * 16 + lh * 8), wb = *(const f32x4*)(Ws + d * 128 + kk * 16 + lh * 8 + 4);
        f32x4 a0, a1, c0, c1;
#pragma unroll
        for (int j = 0; j < 4; ++j) {
          a0[j] = bf2f((bf16_t)x0[j]) * wa[j]; a1[j] = bf2f((bf16_t)x0[4 + j]) * wb[j];
          c0[j] = bf2f((bf16_t)x1[j]) * wa[j]; c1[j] = bf2f((bf16_t)x1[4 + j]) * wb[j];
        }
        acc0 = __builtin_amdgcn_mfma_f32_32x32x16_bf16(pack8(a0, a1), bfr, acc0, 0, 0, 0);
        acc1 = __builtin_amdgcn_mfma_f32_32x32x16_bf16(pack8(c0, c1), bfr, acc1, 0, 0, 0);
      }
      float* dst = p.LST + ((((size_t)gc * 16 + h) * 2 + d) * 64) * 128 + nt * 32 + lr;
#pragma unroll
      for (int r = 0; r < 16; ++r) {
        int pp = (r & 3) + 8 * (r >> 2) + 4 * lh;
        dst[(size_t)pp * 128] = acc0[r];
        dst[(size_t)(32 + pp) * 128] = acc1[r];
      }
    }
  }
}

__device__ __forceinline__ int scan_chunk(int ci, int bl, int d) {
  if (ci < 2) return 64 + bl * 2 + (d == 0 ? ci : 1 - ci);
  int cc = ci - 2;
  return bl * 32 + (d == 0 ? cc : 31 - cc);
}
__device__ void phase_s2(const Params& p, int layer, int pass) {
  const int nth = gridDim.x * 256;
  for (int e = opq_bid() * 256 + opq_tid(); e < 64 * 2048; e += nth) {
    int seq = e >> 11, q = e & 2047, pp = q >> 5, n4 = (q & 31) * 4;
    int d = seq & 1, h = (seq >> 1) & 15, bl = seq >> 5;
    f32x4 s = {0.f, 0.f, 0.f, 0.f};
    const size_t eoff = ((size_t)h * 2 + d) * 8192 + (size_t)pp * 128 + n4;
    const int toff = (d == 0) ? h * 128 + 127 : (16 + h) * 128;
#pragma unroll
    for (int half = 0; half < 2; ++half) {
      f32x4 loc[17]; float tot[17];
#pragma unroll
      for (int i = 0; i < 17; ++i) {
        int gc = scan_chunk(half * 17 + i, bl, d);
        loc[i] = *(const f32x4*)(p.LST + (size_t)gc * 262144 + eoff);
        tot[i] = p.CUMT[(size_t)gc * 4096 + toff];
      }
#pragma unroll
      for (int i = 0; i < 17; ++i) {
        int gc = scan_chunk(half * 17 + i, bl, d);
        uint2 o; o.x = pk2(s[0], s[1]); o.y = pk2(s[2], s[3]);
        *(uint2*)(p.SIN + (size_t)gc * 262144 + eoff) = o;
        float dec = expf(tot[i]);
        s = s * dec + loc[i];
      }
    }
  }
}

__device__ void phase_s3(const Params& p, int layer, int pass, bf16_t* smem) {
  const int tid = opq_tid(), lane = tid & 63, w = tid >> 6, lr = lane & 31, lh = lane >> 5;
  const int nch = (layer == 0) ? NCH : 64;
  constexpr int RS = 136;
  bf16_t* Ss = smem;
  bf16_t* Bs = smem;
  bf16_t* Xs = smem + 128 * RS;
  float* Vs = (float*)(smem + 192 * RS);
  bf16_t* Zs = smem + 192 * RS + 1536;
  bf16_t* Os = smem;
  const int srow = tid >> 4, scol = (tid & 15) * 8;
  for (int u = opq_bid(); u < nch * 16; u += gridDim.x) {
    const int h = u & 15, gc = u >> 4, g = h >> 3;
    const int i_own = 32 * w + lr;
    bf16x8 rs[8];
    {
      const bf16_t* Sg = p.SIN + ((size_t)gc * 16 + h) * 16384 + srow * 128 + scol;
#pragma unroll
      for (int i = 0; i < 8; ++i) rs[i] = *(const bf16x8*)(Sg + i * 2048);
    }
    bf16x8 cf[8];
    {
      const bf16_t* crow = p.CR + ((size_t)gc * 128 + i_own) * 256 + g * 128 + lh * 8;
#pragma unroll
      for (int kk = 0; kk < 8; ++kk) cf[kk] = *(const bf16x8*)(crow + kk * 16);
    }
    bf16x8 rz[4];
    {
      const bf16_t* Zg = p.PZ + ((size_t)gc * 128 + (tid >> 3)) * 1024 + h * 64 + (tid & 7) * 8;
#pragma unroll
      for (int i = 0; i < 4; ++i) rz[i] = *(const bf16x8*)(Zg + (size_t)i * 32 * 1024);
    }
    const size_t vidx = ((size_t)gc * 32 + (tid >> 7) * 16 + h) * 128 + (tid & 127);
    const float v_vv = p.VV[vidx], v_ec = p.EC[vidx], v_cu = p.CUMT[vidx];
    __syncthreads();
#pragma unroll
    for (int i = 0; i < 8; ++i) *(bf16x8*)(Ss + (srow + 16 * i) * RS + scol) = rs[i];
    Vs[tid] = v_vv; Vs[256 + tid] = v_ec; Vs[512 + tid] = v_cu;
#pragma unroll
    for (int i = 0; i < 4; ++i) *(bf16x8*)(Zs + ((tid >> 3) + 32 * i) * 72 + (tid & 7) * 8) = rz[i];
    bf16x8 rb[8], rx[4];
    {
      const bf16_t* Bg = p.BR + ((size_t)gc * 128 + srow) * 256 + g * 128 + scol;
#pragma unroll
      for (int i = 0; i < 8; ++i) rb[i] = *(const bf16x8*)(Bg + i * 16 * 256);
      const bf16_t* Xg = p.XT + ((size_t)gc * 1024 + h * 64 + srow) * 128 + scol;
#pragma unroll
      for (int i = 0; i < 4; ++i) rx[i] = *(const bf16x8*)(Xg + i * 2048);
    }
    __syncthreads();
    f32x16 y[2];
#pragma unroll
    for (int r = 0; r < 16; ++r) { y[0][r] = 0.f; y[1][r] = 0.f; }
#pragma unroll
    for (int d = 0; d < 2; ++d) {
      const float* ec = Vs + 256 + d * 128 + 32 * w + 4 * lh;
#pragma unroll
      for (int pt = 0; pt < 2; ++pt) {
        f32x16 tmp;
#pragma unroll
        for (int r = 0; r < 16; ++r) tmp[r] = 0.f;
        const bf16_t* sl = Ss + (d * 64 + pt * 32 + lr) * RS + lh * 8;
#pragma unroll
        for (int kk = 0; kk < 8; ++kk) {
          bf16x8 sf = *(const bf16x8*)(sl + kk * 16);
          tmp = __builtin_amdgcn_mfma_f32_32x32x16_bf16(cf[kk], sf, tmp, 0, 0, 0);
        }
#pragma unroll
        for (int q = 0; q < 4; ++q) {
          f32x4 e4 = *(const f32x4*)(ec + 8 * q);
#pragma unroll
          for (int t = 0; t < 4; ++t) y[pt][q * 4 + t] += tmp[q * 4 + t] * e4[t];
        }
      }
    }
    __syncthreads();
#pragma unroll
    for (int i = 0; i < 8; ++i) *(bf16x8*)(Bs + (srow + 16 * i) * RS + scol) = rb[i];
#pragma unroll
    for (int i = 0; i < 4; ++i) *(bf16x8*)(Xs + (srow + 16 * i) * RS + scol) = rx[i];
    __syncthreads();
    const float cum_f = Vs[512 + i_own];
    const float cum_b = Vs[512 + 128 + i_own];
#pragma unroll 1
    for (int jt = 0; jt < 4; ++jt) {
      f32x16 cb;
#pragma unroll
      for (int r = 0; r < 16; ++r) cb[r] = 0.f;
      const bf16_t* bl_ = Bs + (jt * 32 + lr) * RS + lh * 8;
#pragma unroll
      for (int kk = 0; kk < 8; ++kk) {
        bf16x8 bfr = *(const bf16x8*)(bl_ + kk * 16);
        cb = __builtin_amdgcn_mfma_f32_32x32x16_bf16(bfr, cf[kk], cb, 0, 0, 0);
      }
      bf16x8 xb[2][2];
#pragma unroll
      for (int s = 0; s < 2; ++s)
#pragma unroll
        for (int pt = 0; pt < 2; ++pt) {
          const bf16_t* xp = Xs + (pt * 32 + lr) * RS + jt * 32 + 16 * s + 4 * lh;
          bf16x4 x0 = *(const bf16x4*)xp, x1 = *(const bf16x4*)(xp + 8);
          bf16x8 t8 = {x0[0], x0[1], x0[2], x0[3], x1[0], x1[1], x1[2], x1[3]};
          xb[s][pt] = t8;
        }
#pragma unroll
      for (int d = 0; d < 2; ++d) {
        bool need = (d == 0) ? (jt <= w) : (jt >= w);
        if (!need) continue;
        const float* vv = Vs + d * 128 + jt * 32 + 4 * lh;
        const float ci = (d == 0) ? cum_f : cum_b;
        f32x16 gq;
#pragma unroll
        for (int q = 0; q < 4; ++q) {
          f32x4 v4 = *(const f32x4*)(vv + 8 * q);
#pragma unroll
          for (int t = 0; t < 4; ++t) {
            int j = jt * 32 + 8 * q + 4 * lh + t;
            float val = cb[q * 4 + t] * __expf(ci - v4[t]);
            bool ok = (jt != w) || ((d == 0) ? (j <= i_own) : (j >= i_own));
            gq[q * 4 + t] = ok ? val : 0.f;
          }
        }
#pragma unroll
        for (int s = 0; s < 2; ++s) {
          f32x4 ga = {gq[8 * s + 0], gq[8 * s + 1], gq[8 * s + 2], gq[8 * s + 3]};
          f32x4 gb = {gq[8 * s + 4], gq[8 * s + 5], gq[8 * s + 6], gq[8 * s + 7]};
          bf16x8 afr = pack8(ga, gb);
          y[0] = __builtin_amdgcn_mfma_f32_32x32x16_bf16(afr, xb[s][0], y[0], 0, 0, 0);
          y[1] = __builtin_amdgcn_mfma_f32_32x32x16_bf16(afr, xb[s][1], y[1], 0, 0, 0);
        }
      }
    }
    const float Dh = p.ssd_d[layer * 16 + h];
    float ssq[16];
#pragma unroll
    for (int r = 0; r < 16; ++r) ssq[r] = 0.f;
    __syncthreads();
#pragma unroll
    for (int pt = 0; pt < 2; ++pt)
#pragma unroll
      for (int q = 0; q < 4; ++q) {
        bf16x4 x4 = *(const bf16x4*)(Xs + (pt * 32 + lr) * RS + 32 * w + 8 * q + 4 * lh);
#pragma unroll
        for (int t = 0; t < 4; ++t) {
          int li = 32 * w + 8 * q + 4 * lh + t;
          float yv = y[pt][q * 4 + t] + Dh * bf2f((bf16_t)x4[t]);
          float z = bf2f(Zs[li * 72 + pt * 32 + lr]);
          float gv = yv * silu_f(z);
          ssq[q * 4 + t] += gv * gv;
          Os[li * 72 + pt * 32 + lr] = f2bf(gv);
        }
      }
    __syncthreads();
    {
      bf16_t* Yg = p.Y + ((size_t)gc * 128 + (tid >> 3)) * 2048 + h * 64 + (tid & 7) * 8;
#pragma unroll
      for (int i = 0; i < 4; ++i)
        *(bf16x8*)(Yg + (size_t)i * 32 * 2048) = *(const bf16x8*)(Os + ((tid >> 3) + 32 * i) * 72 + (tid & 7) * 8);
    }
#pragma unroll
    for (int r = 0; r < 16; ++r) {
      float v = ssq[r];
      v += __shfl_xor(v, 1); v += __shfl_xor(v, 2); v += __shfl_xor(v, 4); v += __shfl_xor(v, 8); v += __shfl_xor(v, 16);
      ssq[r] = v;
    }
    if (lr == 0) {
#pragma unroll
      for (int r = 0; r < 16; ++r) {
        int row = gc * 128 + 32 * w + (r & 3) + 8 * (r >> 2) + 4 * lh;
        p.SSQ[(size_t)row * 16 + h] = ssq[r];
      }
    }
  }
}

__device__ void phase_final(const Params& p) {
  const int lane = opq_tid() & 63;
  const int gw = opq_bid() * 4 + (opq_tid() >> 6), nw = gridDim.x * 4;
  float4 w[4];
#pragma unroll
  for (int i = 0; i < 4; ++i) w[i] = *(const float4*)(p.final_norm_w + (i * 64 + lane) * 4);
  for (int row0 = gw; row0 < 4 * SEQ; row0 += 8 * nw) {
    float4 v[8][4];
#pragma unroll
    for (int q = 0; q < 8; ++q) {
      const int row = row0 + q * nw;
      if (row < 4 * SEQ) {
        const float* src = p.out + (size_t)row * D;
#pragma unroll
        for (int i = 0; i < 4; ++i) v[q][i] = *(const float4*)(src + (i * 64 + lane) * 4);
      }
    }
#pragma unroll
    for (int q = 0; q < 8; ++q) {
      const int row = row0 + q * nw;
      if (row < 4 * SEQ) {
        float ss = 0.f;
#pragma unroll
        for (int i = 0; i < 4; ++i) ss += v[q][i].x * v[q][i].x + v[q][i].y * v[q][i].y + v[q][i].z * v[q][i].z + v[q][i].w * v[q][i].w;
        ss = wave_sum(ss);
        const float rstd = rsqrtf(ss * (1.f / D) + EPS);
        float* dst = p.out + (size_t)row * D;
#pragma unroll
        for (int i = 0; i < 4; ++i) {
          float4 o = {v[q][i].x * rstd * w[i].x, v[q][i].y * rstd * w[i].y, v[q][i].z * rstd * w[i].z, v[q][i].w * rstd * w[i].w};
          *(float4*)(dst + (i * 64 + lane) * 4) = o;
        }
      }
    }
  }
}

#ifndef REP_W
#define REP_W 1
#endif
#ifndef REP_GOUT0
#define REP_GOUT0 1
#endif
#ifndef REP_NORM
#define REP_NORM 1
#endif
#ifndef REP_GIN
#define REP_GIN 1
#endif
#ifndef REP_PREP
#define REP_PREP 1
#endif
#ifndef REP_S1
#define REP_S1 1
#endif
#ifndef REP_ATTN
#define REP_ATTN 1
#endif
#ifndef REP_S3
#define REP_S3 1
#endif
__global__ void __launch_bounds__(256, 2) mega(Params p, int lo, int hi) {
  __shared__ __attribute__((aligned(16))) float smem[18432];
  __shared__ uint4 xb_words;
  if (threadIdx.x == 0) xb_words = make_uint4(0u, 0u, 0u, 0u);
  __syncthreads();
  XcdBarrier xb = xcd_barrier_post(p.bar, (volatile LAS unsigned*)&xb_words);
  if (lo < 0) cg::this_grid().sync();
  for (int step = lo; step < hi; ++step) {
    if (step == 0) { for (int rp = 0; rp < REP_W; ++rp) phase_weights(p, smem); }
    else if (step == NSTEP - 1) phase_final(p);
    else {
      int s = step - 1;
      int pass = s / 14, r = s % 14, layer = r / 7, ph = r % 7;
      switch (ph) {
        case ST_NORM: for (int rp = 0; rp < REP_NORM; ++rp) phase_norm(p, layer, pass); break;
        case ST_GIN: for (int rp = 0; rp < REP_GIN; ++rp) phase_gemm_in256(p, layer, pass, (bf16_t*)smem); break;
        case ST_PREP: for (int rp = 0; rp < REP_PREP; ++rp) phase_prep(p, layer, pass, smem); break;
        case ST_MIX:
          for (int rp = 0; rp < REP_S1; ++rp) phase_s1(p, layer, pass, (bf16_t*)smem);
          for (int rp = 0; rp < REP_ATTN; ++rp) phase_attn(p, layer, pass, (bf16_t*)smem);
          break;
        case ST_S2: phase_s2(p, layer, pass); break;
        case ST_S3: for (int rp = 0; rp < REP_S3; ++rp) phase_s3(p, layer, pass, (bf16_t*)smem); break;
        case ST_GOUT: for (int rp = 0; rp < (layer == 0 ? REP_GOUT0 : 1); ++rp) phase_gemm_mfma(p, 1, layer, pass, (bf16_t*)smem); break;
      }
    }
    if (step + 1 < hi) xcd_barrier(xb);
  }
}

extern "C" void kernel_launch(void* const* d_in, const int* in_sizes, int n_in, void* d_out, int out_size, void* d_ws,
                              size_t ws_size, hipStream_t stream) {
  Params p{};
  p.x = (const float*)d_in[0]; p.c = (const float*)d_in[1]; p.ctx = (const float*)d_in[2]; p.c_ctx = (const float*)d_in[3];
  p.norm_w = (const float*)d_in[4]; p.w_mod = (const float*)d_in[5]; p.b_mod = (const float*)d_in[6];
  p.w_in = (const float*)d_in[7]; p.ssd_conv_w = (const float*)d_in[8]; p.ssd_conv_b = (const float*)d_in[9];
  p.ssd_dt_bias = (const float*)d_in[10]; p.ssd_a_log = (const float*)d_in[11]; p.ssd_d = (const float*)d_in[12];
  p.ssd_norm_w = (const float*)d_in[13]; p.sc_conv_w = (const float*)d_in[14]; p.attn_sink = (const float*)d_in[15];
  p.w_out = (const float*)d_in[16]; p.final_norm_w = (const float*)d_in[17];
  p.out = (float*)d_out;
  char* w = (char*)d_ws; size_t off = 0;
  auto take = [&](size_t bytes) { char* r = w + off; off += (bytes + 255) & ~(size_t)255; return r; };
  p.WinT = (bf16_t*)take((size_t)2 * NWIN * 1024 * 2);
  p.WoutT = (bf16_t*)take((size_t)2 * 1024 * 2048 * 2);
  p.MOD = (float*)take((size_t)2 * 5 * 3072 * 4);
  p.CTX1 = (float*)take((size_t)4 * CTXL * D * 4);
  p.ROPE = (float*)take((size_t)64 * 16 * 2 * 4);
  char* big = take((size_t)NT * (1024 + 1536 + 2048) * 2);
  p.H = (bf16_t*)big;
  p.PXBC = (bf16_t*)(big + (size_t)NT * 1024 * 2);
  p.PSC = (bf16_t*)(big + (size_t)NT * (1024 + 1536) * 2);
  p.LST = (float*)big;
  p.PART = (float*)(big + (size_t)24 * 1024 * 1024);
  p.PZ = (bf16_t*)take((size_t)NT * 1024 * 2);
  p.PATT = (bf16_t*)take((size_t)NT * 1280 * 2);
  p.QR = (bf16_t*)take((size_t)NT * 512 * 2);
  p.KR = (bf16_t*)take((size_t)NT * 128 * 2);
  p.VT = (bf16_t*)take((size_t)NT * 128 * 2);
  p.SIN = p.PATT;
  p.DTRAW = (float*)take((size_t)NT * 32 * 4);
  p.CUMT = (float*)take((size_t)NT * 32 * 4);
  p.VV = (float*)take((size_t)NT * 32 * 4);
  p.EC = (float*)take((size_t)NT * 32 * 4);
  p.WW = (float*)take((size_t)NT * 32 * 4);
  p.SSQ = (float*)take((size_t)NT * 16 * 4);
  p.XT = (bf16_t*)take((size_t)NT * 1024 * 2);
  p.BR = (bf16_t*)take((size_t)NT * 256 * 2);
  p.CR = (bf16_t*)take((size_t)NT * 256 * 2);
  p.BT = (bf16_t*)take((size_t)NT * 256 * 2);
  p.Y = (bf16_t*)take((size_t)NT * 2048 * 2);
  p.bar = (unsigned*)take((size_t)XCD_BAR_WORDS * 4);
  if (off > ws_size) { fprintf(stderr, "workspace too small: need %zu have %zu\n", off, ws_size); return; }
  static int grid_blocks = 0;
  if (!grid_blocks) {
    int dev = 0, cus = 0, per_cu = 0;
    hipGetDevice(&dev);
    hipDeviceGetAttribute(&cus, hipDeviceAttributeMultiprocessorCount, dev);
    hipOccupancyMaxActiveBlocksPerMultiprocessor(&per_cu, mega, 256, 0);
    if (per_cu > 2) per_cu = 2;
    if (per_cu < 1) per_cu = 1;
    grid_blocks = cus * per_cu;
  }
  hipMemsetAsync(p.bar, 0, (size_t)XCD_BAR_WORDS * 4, stream);
  int lo = 0, hi = NSTEP;
  void* args[] = {&p, &lo, &hi};
  hipError_t e = hipLaunchCooperativeKernel((void*)mega, dim3(grid_blocks), dim3(256), args, 0, stream);
  if (e != hipSuccess) fprintf(stderr, "cooperative launch failed: %s (grid %d)\n", hipGetErrorString(e), grid_blocks);
}
```
